# Optimizing an MI355X kernel written in HIP

```python
import math
import jax, jax.numpy as jnp
from jax import lax
import numpy as np

D_MODEL = 1024
BATCH = 16
SEQ = 2048
DEPTH = 1

CHUNK = 64
Q_BLOCK = 128
MLA_HEADS = 8
MLA_Q_RANK = 256
MLA_KV_RANK = 128
MLA_NOPE = 64
MLA_ROPE = 32
MLA_V = 64
ROPE_THETA = 10000.0
DSA_HEADS = 8
DSA_HEAD_DIM = 64
IDX_HEADS = 8
IDX_DIM = 32
IDX_TOPK_MAX = 256
REL_BUCKETS = 32
REL_MAX_DIST = 128
N_GROUPS = 4
EXPERTS_PER_GROUP = 8
N_EXPERTS = N_GROUPS * EXPERTS_PER_GROUP
TOP_K_IN_GROUP = 2
EXPERT_HIDDEN = 256
LN_EPS = 1e-5
RMS_EPS = 1e-6
DEEPNORM_ALPHA = (2.0 * DEPTH) ** 0.25
DEEPNORM_BETA = (8.0 * DEPTH) ** -0.25
NEG = -1e30
IN_SIZES = (MLA_Q_RANK, MLA_KV_RANK, MLA_ROPE, DSA_HEADS * DSA_HEAD_DIM, DSA_HEAD_DIM, DSA_HEAD_DIM, IDX_HEADS * IDX_DIM, IDX_DIM, IDX_HEADS)
IN_WIDTH = MLA_Q_RANK + MLA_KV_RANK + MLA_ROPE + DSA_HEADS * DSA_HEAD_DIM + 2 * DSA_HEAD_DIM + IDX_HEADS * IDX_DIM + IDX_DIM + IDX_HEADS

kernel_name = 'hybrid_mla_dsa_hmoe_block'


def layer_norm(x, g, b):
    xf = x.astype(jnp.float32)
    mu = jnp.mean(xf, axis=-1, keepdims=True)
    var = jnp.mean(jnp.square(xf - mu), axis=-1, keepdims=True)
    return ((xf - mu) * lax.rsqrt(var + LN_EPS) * g + b).astype(x.dtype)


def rms_norm(x, g):
    xf = x.astype(jnp.float32)
    return (xf * lax.rsqrt(jnp.mean(jnp.square(xf), axis=-1, keepdims=True) + RMS_EPS) * g).astype(x.dtype)


def apply_rope(x, pos):
    half = x.shape[-1] // 2
    inv = ROPE_THETA ** (-jnp.arange(half, dtype=jnp.float32) / half)
    ang = pos.astype(jnp.float32)[..., None] * inv
    cos = jnp.cos(ang)[:, :, None, :]
    sin = jnp.sin(ang)[:, :, None, :]
    x1 = x[..., :half].astype(jnp.float32)
    x2 = x[..., half:].astype(jnp.float32)
    return jnp.concatenate([x1 * cos - x2 * sin, x1 * sin + x2 * cos], axis=-1).astype(x.dtype)


def t5_bucket(rel):
    nb = REL_BUCKETS // 2
    max_exact = nb // 2
    ret = jnp.where(rel > 0, nb, 0)
    n = jnp.abs(rel)
    large = max_exact + (jnp.log(jnp.maximum(n, 1).astype(jnp.float32) / max_exact)
                         / math.log(REL_MAX_DIST / max_exact) * (nb - max_exact)).astype(jnp.int32)
    large = jnp.minimum(large, nb - 1)
    return ret + jnp.where(n < max_exact, n, large)


def to_blocks(a):
    B, T = a.shape[:2]
    a = a.reshape((B, T // Q_BLOCK, Q_BLOCK) + a.shape[2:])
    return jnp.swapaxes(a, 0, 1)


def from_blocks(a):
    a = jnp.swapaxes(a, 0, 1)
    return a.reshape((a.shape[0], a.shape[1] * a.shape[2]) + a.shape[3:])


def mla_branch(c_q, c_kv, k_rope_raw, pos, q_norm_g, w_uq, kv_norm_g, w_uk, w_uv):
    B, T = pos.shape
    q = (rms_norm(c_q, q_norm_g) @ w_uq).reshape(B, T, MLA_HEADS, MLA_NOPE + MLA_ROPE)
    q = jnp.concatenate([q[..., :MLA_NOPE], apply_rope(q[..., MLA_NOPE:], pos)], axis=-1)
    ckv = rms_norm(c_kv, kv_norm_g)
    k_nope = (ckv @ w_uk).reshape(B, T, MLA_HEADS, MLA_NOPE)
    v = (ckv @ w_uv).reshape(B, T, MLA_HEADS, MLA_V)
    k_rope = apply_rope(k_rope_raw[:, :, None, :], pos)
    k = jnp.concatenate([k_nope, jnp.broadcast_to(k_rope, (B, T, MLA_HEADS, MLA_ROPE))], axis=-1)
    scale = (MLA_NOPE + MLA_ROPE) ** -0.5
    k_chunk = pos // CHUNK

    def one_block(args):
        qb, pb = args
        s = jnp.einsum('bqhd,bshd->bhqs', qb, k).astype(jnp.float32) * scale
        allowed = k_chunk[:, None, :] <= (pb // CHUNK)[:, :, None]
        s = jnp.where(allowed[:, None], s, NEG)
        p = jax.nn.softmax(s, axis=-1).astype(v.dtype)
        return jnp.einsum('bhqs,bshd->bqhd', p, v)

    o = from_blocks(lax.map(one_block, (to_blocks(q), to_blocks(pos))))
    return o.reshape(B, T, MLA_HEADS * MLA_V)


def dsa_branch(q_b, k_b, v_b, q_idx, k_idx, w_idx, pos, rel_bias):
    B, T = pos.shape
    L = k_b.shape[1]
    topk = min(IDX_TOPK_MAX, L // 4)
    q = q_b.reshape(B, T, DSA_HEADS, DSA_HEAD_DIM)
    qi = q_idx.reshape(B, T, IDX_HEADS, IDX_DIM)
    w = w_idx * IDX_HEADS ** -0.5
    k_chunk = pos // CHUNK

    def one_block(args):
        qb, qib, wb, pb = args
        rel = jax.nn.relu(jnp.einsum('bqhd,bsd->bqhs', qib, k_idx).astype(jnp.float32) * IDX_DIM ** -0.5)
        score = jnp.einsum('bqh,bqhs->bqs', wb.astype(jnp.float32), rel)
        q_chunk = pb // CHUNK
        score = jnp.where(k_chunk[:, None, :] <= q_chunk[:, :, None], score, NEG)
        _, sel = lax.top_k(score, topk)
        k_sel = jax.vmap(lambda a, i: a[i])(k_b, sel)
        v_sel = jax.vmap(lambda a, i: a[i])(v_b, sel)
        pos_sel = jax.vmap(lambda a, i: a[i])(pos, sel)
        valid = (pos_sel // CHUNK) <= q_chunk[:, :, None]
        bias = jnp.transpose(rel_bias[t5_bucket(pos_sel - pb[:, :, None])], (0, 3, 1, 2))
        s = jnp.einsum('bqhd,bqkd->bhqk', qb, k_sel).astype(jnp.float32) * DSA_HEAD_DIM ** -0.5 + bias
        s = jnp.where(valid[:, None], s, NEG)
        p = jax.nn.softmax(s, axis=-1).astype(v_sel.dtype)
        return jnp.einsum('bhqk,bqkd->bqhd', p, v_sel)

    o = from_blocks(lax.map(one_block, (to_blocks(q), to_blocks(qi), to_blocks(w), to_blocks(pos))))
    return o.reshape(B, T, DSA_HEADS * DSA_HEAD_DIM)


def hierarchical_moe(h, w_grp, b_grp, w_rt, b_rt, w_eg, w_eu, w_ed):
    B, T, _ = h.shape
    g_logits = (h @ w_grp).astype(jnp.float32) + b_grp
    p_grp = jax.nn.softmax(g_logits, axis=-1)
    g_sel = jnp.argmax(g_logits, axis=-1)
    g_w = jnp.take_along_axis(p_grp, g_sel[..., None], axis=-1)
    e_logits = ((h @ w_rt).astype(jnp.float32) + b_rt).reshape(B, T, N_GROUPS, EXPERTS_PER_GROUP)
    e_logits = jnp.take_along_axis(e_logits, g_sel[..., None, None], axis=2)[:, :, 0, :]
    p_e = jax.nn.softmax(e_logits, axis=-1)
    top_v, top_i = lax.top_k(p_e, TOP_K_IN_GROUP)
    top_v = top_v / jnp.sum(top_v, axis=-1, keepdims=True)
    expert_id = g_sel[..., None] * EXPERTS_PER_GROUP + top_i
    comb = jnp.sum(jax.nn.one_hot(expert_id, N_EXPERTS, dtype=jnp.float32) * (g_w * top_v)[..., None], axis=-2)
    comb = comb.astype(h.dtype)

    def per_row(args):
        hr, cr = args
        a = jnp.einsum('td,edf->tef', hr, w_eg)
        u = jnp.einsum('td,edf->tef', hr, w_eu)
        hid = jax.nn.silu(a) * u * cr[..., None]
        return jnp.einsum('tef,efd->td', hid, w_ed)

    return lax.map(per_row, (h, comb))


def setup_inputs(seed: int = 0) -> dict:
    key = jax.random.key(seed)
    ks = jax.random.split(key, 32)
    f32 = jnp.float32
    D = D_MODEL
    nrm = lambda k, shape, s: jax.random.normal(k, shape, f32) * s
    gain = lambda k, shape: 1.0 + 0.02 * jax.random.normal(k, shape, f32)
    x = jax.random.normal(ks[0], (BATCH, SEQ, D), f32)
    start = jax.random.randint(ks[1], (BATCH, 1), 0, 64, dtype=jnp.int32) * CHUNK
    positions = (start + jnp.arange(SEQ, dtype=jnp.int32)[None, :]).astype(jnp.int32)
    offs = np.cumsum((0,) + IN_SIZES)
    v_off = int(offs[5])
    col_scale = jnp.concatenate([jnp.ones((v_off,), f32), jnp.full((DSA_HEAD_DIM,), DEEPNORM_BETA, f32),
                                 jnp.ones((IN_WIDTH - v_off - DSA_HEAD_DIM,), f32)])
    L = DEPTH
    beta = DEEPNORM_BETA
    return {
        'x': x,
        'positions': positions,
        'ln0_g': gain(ks[2], (D,)),
        'ln0_b': nrm(ks[3], (D,), 0.02),
        'w_in': nrm(ks[4], (L, D, IN_WIDTH), D ** -0.5) * col_scale,
        'q_norm_g': gain(ks[5], (L, MLA_Q_RANK)),
        'w_uq': nrm(ks[6], (L, MLA_Q_RANK, MLA_HEADS * (MLA_NOPE + MLA_ROPE)), MLA_Q_RANK ** -0.5),
        'kv_norm_g': gain(ks[7], (L, MLA_KV_RANK)),
        'w_uk': nrm(ks[8], (L, MLA_KV_RANK, MLA_HEADS * MLA_NOPE), MLA_KV_RANK ** -0.5),
        'w_uv': nrm(ks[9], (L, MLA_KV_RANK, MLA_HEADS * MLA_V), beta * MLA_KV_RANK ** -0.5),
        'rel_bias': nrm(ks[10], (REL_BUCKETS, DSA_HEADS), 0.2),
        'w_up_a': nrm(ks[11], (L, MLA_HEADS * MLA_V, D), beta * (MLA_HEADS * MLA_V) ** -0.5),
        'w_up_b': nrm(ks[12], (L, DSA_HEADS * DSA_HEAD_DIM, D), beta * (DSA_HEADS * DSA_HEAD_DIM) ** -0.5),
        'w_gate': nrm(ks[13], (L, D, 2 * D), D ** -0.5),
        'b_gate': nrm(ks[14], (L, 2 * D), 0.02),
        'w_o': nrm(ks[15], (L, D, D), beta * D ** -0.5),
        'ln1_g': gain(ks[16], (L, D)),
        'ln1_b': nrm(ks[17], (L, D), 0.02),
        'w_grp': nrm(ks[18], (L, D, N_GROUPS), D ** -0.5),
        'b_grp': nrm(ks[19], (L, N_GROUPS), 0.01),
        'w_rt': nrm(ks[20], (L, D, N_EXPERTS), D ** -0.5),
        'b_rt': nrm(ks[21], (L, N_EXPERTS), 0.01),
        'w_exp_gate': nrm(ks[22], (L, N_EXPERTS, D, EXPERT_HIDDEN), D ** -0.5),
        'w_exp_up': nrm(ks[23], (L, N_EXPERTS, D, EXPERT_HIDDEN), D ** -0.5),
        'w_exp_down': nrm(ks[24], (L, N_EXPERTS, EXPERT_HIDDEN, D), beta * EXPERT_HIDDEN ** -0.5),
        'ln2_g': gain(ks[25], (L, D)),
        'ln2_b': nrm(ks[26], (L, D), 0.02),
    }


def reference(x, positions, ln0_g, ln0_b, w_in, q_norm_g, w_uq, kv_norm_g, w_uk, w_uv, rel_bias,
              w_up_a, w_up_b, w_gate, b_gate, w_o, ln1_g, ln1_b, w_grp, b_grp, w_rt, b_rt,
              w_exp_gate, w_exp_up, w_exp_down, ln2_g, ln2_b):
    split_at = [int(o) for o in np.cumsum(IN_SIZES)[:-1]]
    x = layer_norm(x, ln0_g, ln0_b)
    for l in range(DEPTH):
        proj = x @ w_in[l]
        c_q, c_kv, k_rope, q_b, k_b, v_b, q_idx, k_idx, w_idx = jnp.split(proj, split_at, axis=-1)
        o_a = mla_branch(c_q, c_kv, k_rope, positions, q_norm_g[l], w_uq[l], kv_norm_g[l], w_uk[l], w_uv[l])
        o_b = dsa_branch(q_b, k_b, v_b, q_idx, k_idx, w_idx, positions, rel_bias)
        gates = jax.nn.sigmoid(x @ w_gate[l] + b_gate[l])
        g_a, g_b = jnp.split(gates, 2, axis=-1)
        mixed = (g_a * (o_a @ w_up_a[l]) + g_b * (o_b @ w_up_b[l])) @ w_o[l]
        h = layer_norm(DEEPNORM_ALPHA * x + mixed, ln1_g[l], ln1_b[l])
        ffn = hierarchical_moe(h, w_grp[l], b_grp[l], w_rt[l], b_rt[l], w_exp_gate[l], w_exp_up[l], w_exp_down[l])
        x = layer_norm(DEEPNORM_ALPHA * h + ffn, ln2_g[l], ln2_b[l])
    return x
```

```cpp
#include <hip/hip_runtime.h>
#include <cstdio>
#include <cstdint>

#ifndef N_LAUNCH_MODE
#define N_LAUNCH_MODE 1
#endif
#ifndef DBG_STAGE
#define DBG_STAGE 2
#endif

#define LAS __attribute__((address_space(3)))
#define GAS __attribute__((address_space(1)))
typedef unsigned short bf16_t;
typedef short bf16x8 __attribute__((ext_vector_type(8)));
typedef short s16x4 __attribute__((ext_vector_type(4)));
typedef float f32x2 __attribute__((ext_vector_type(2)));
typedef float f32x4 __attribute__((ext_vector_type(4)));
typedef float f32x16 __attribute__((ext_vector_type(16)));
typedef unsigned u32x2 __attribute__((ext_vector_type(2)));
typedef unsigned u32x4 __attribute__((ext_vector_type(4)));
typedef int i32x4 __attribute__((ext_vector_type(4)));
typedef __bf16 bf16x2_t __attribute__((ext_vector_type(2)));
#define DI __device__ __forceinline__

constexpr int BATCH = 16, SEQ = 2048, D = 1024, M = BATCH * SEQ;
constexpr int NW1 = 3584;
constexpr int NSEG = 64;
constexpr int MAXTILES = 320;
constexpr float LN_EPS = 1e-5f, RMS_EPS = 1e-6f;
constexpr float ALPHA = 1.189207115002721f;
constexpr float LOG2E = 1.4426950408889634f;
constexpr float NEGF = -1e30f;

constexpr size_t MiB = 1u << 20;
constexpr size_t WS_CTL = 0, CTL_ZERO_BYTES = 1 * MiB;
constexpr size_t WS_WT1 = 1 * MiB;
constexpr size_t WS_WUQT = 8 * MiB;
constexpr size_t WS_WUKVT = WS_WUQT + 768 * 256 * 2;
constexpr size_t WS_WRT = WS_WUKVT + 1024 * 128 * 2;
constexpr size_t WS_WUPT = 9 * MiB;
constexpr size_t WS_WOT = 11 * MiB;
constexpr size_t WS_WEGUT = 13 * MiB;
constexpr size_t WS_WEDT = 45 * MiB;
constexpr size_t WS_STATS0 = 61 * MiB;
constexpr size_t WS_SSQ = WS_STATS0 + (size_t)M * 8;
constexpr size_t WS_TSTAT = WS_SSQ + (size_t)M * 32;
constexpr size_t WS_TOKINFO = 63 * MiB;
constexpr size_t WS_A = 64 * MiB;
constexpr size_t WS_B = 192 * MiB;
constexpr size_t WS_C = 256 * MiB;
constexpr size_t WS_Dr = 384 * MiB;
constexpr size_t WS_END = 512 * MiB;
constexpr size_t WS_QB = WS_C, WS_QI = WS_QB + 32 * MiB, WS_CQ = WS_QI + 16 * MiB, WS_CKV = WS_CQ + 16 * MiB, WS_KB = WS_CKV + 8 * MiB, WS_VB = WS_KB + 4 * MiB,
                 WS_KR = WS_VB + 4 * MiB, WS_KI = WS_KR + 2 * MiB, WS_WI = WS_KI + 2 * MiB;
constexpr size_t WS_H = WS_C;
constexpr size_t WS_QM = WS_Dr, WS_KN = WS_QM + 48 * MiB, WS_VM = WS_KN + 32 * MiB;
constexpr size_t WS_MIXPRE = WS_Dr;
constexpr size_t WS_HID = WS_Dr + 64 * MiB;
constexpr size_t WS_LIST = WS_Dr + 104 * MiB;
constexpr size_t WS_LISTW = WS_Dr + 112 * MiB;
constexpr size_t WS_ROPE = WS_Dr + 120 * MiB;
constexpr int CW_BAR = 4096;
constexpr int CW_CNT = 16384;

DI unsigned pk2(float lo, float hi) { f32x2 v = {lo, hi}; bf16x2_t r = __builtin_convertvector(v, bf16x2_t); return __builtin_bit_cast(unsigned, r); }
DI float bf2f(unsigned short b) { return __uint_as_float((unsigned)b << 16); }
DI float wave_sum(float v) {
#pragma unroll
    for (int o = 1; o < 64; o <<= 1) v += __shfl_xor(v, o);
    return v;
}
DI int wave_min_i(int v) {
#pragma unroll
    for (int o = 1; o < 64; o <<= 1) { const int t = __shfl_xor(v, o); v = t < v ? t : v; }
    return v;
}
DI int wave_max_i(int v) {
#pragma unroll
    for (int o = 1; o < 64; o <<= 1) { const int t = __shfl_xor(v, o); v = t > v ? t : v; }
    return v;
}
DI int lane_id() { int l; asm volatile("v_mbcnt_lo_u32_b32 %0, -1, 0\n\tv_mbcnt_hi_u32_b32 %0, -1, %0" : "=v"(l)); return l; }
DI float fast_exp2(float x) { return __builtin_amdgcn_exp2f(x); }
DI float fast_rcp(float x) { return __builtin_amdgcn_rcpf(x); }
DI float sigmoidf_fast(float v) { return fast_rcp(1.0f + fast_exp2(-v * LOG2E)); }
DI void rope_sincos(int pos, int j, float& sn, float& cs) {
    const double invd[16] = {1.0, 0.5623413251903491, 0.31622776601683794, 0.1778279410038923, 0.1, 0.05623413251903491, 0.03162277660168379, 0.01778279410038923,
                             0.01, 0.005623413251903491, 0.0031622776601683794, 0.001778279410038923, 0.001, 0.0005623413251903491, 0.00031622776601683794, 0.0001778279410038923};
    double inv = invd[0];
#pragma unroll
    for (int t = 1; t < 16; ++t) inv = (j == t) ? invd[t] : inv;
    const double rev = (double)pos * (double)(float)inv * 0.15915494309189535;
    const float fr = (float)(rev - __builtin_floor(rev));
    sn = __builtin_amdgcn_sinf(fr); cs = __builtin_amdgcn_cosf(fr);
}

#define XB_TMO      128
#define XB_XCNT(j)  (256  + 64 * (j))
#define XB_XSUB(j)  (1280 + 64 * (j))
#define XB_XGEN(j)  (2304 + 64 * (j))
#define XB_TOP      3328
#define XB_TOPGEN   3392
#define XCD_BAR_WORDS 3456
#define XB_SPIN_CAP (1u << 18)
DI unsigned xb_ld(unsigned* p)              { return __hip_atomic_load(p, __ATOMIC_RELAXED, __HIP_MEMORY_SCOPE_AGENT); }
DI unsigned xb_add(unsigned* p, unsigned v) { return __hip_atomic_fetch_add(p, v, __ATOMIC_RELAXED, __HIP_MEMORY_SCOPE_AGENT); }
DI unsigned xb_xcc_id() { return (unsigned)__builtin_amdgcn_s_getreg((3 << 11) | 20) & 0xFu; }
#define XB_SPIN(cond, bar) do { unsigned _sp = 0; while (cond) { __builtin_amdgcn_s_sleep(1); \
    if ((++_sp & 255u) == 0u) { if (xb_ld(&(bar)[XB_TMO])) break; if (_sp > XB_SPIN_CAP) { atomicAdd(&(bar)[XB_TMO], 1u); break; } } } } while (0)
struct XcdBarrier { unsigned* bar; unsigned x; volatile LAS unsigned* st; };
DI XcdBarrier xcd_barrier_post(unsigned* bar, volatile LAS unsigned* st) {
    XcdBarrier b; b.bar = bar; b.x = xb_xcc_id(); b.st = st;
    if (threadIdx.x == 0) (void)xb_add(&bar[XB_XCNT(b.x)], 1u);
    return b;
}
DI void xcd_barrier_complete(unsigned* bar, unsigned x, unsigned& nloc, unsigned& nx) {
    const unsigned G = gridDim.x * gridDim.y * gridDim.z;
    unsigned sum, cnt, mine, sp = 0u;
    for (;;) {
        sum = 0u; cnt = 0u; mine = 0u;
#pragma unroll
        for (unsigned j = 0; j < 16; ++j) { const unsigned c = xb_ld(&bar[XB_XCNT(j)]); sum += c; cnt += (c > 0u) ? 1u : 0u; mine = (j == x) ? c : mine; }
        if (sum == G) break;
        __builtin_amdgcn_s_sleep(1);
        if ((++sp & 255u) == 0u) { if (xb_ld(&bar[XB_TMO])) break; if (sp > XB_SPIN_CAP) { atomicAdd(&bar[XB_TMO], 1u); break; } }
    }
    nloc = mine > 0u ? mine : 1u; nx = cnt > 0u ? cnt : 1u;
}
DI void xcd_barrier(const XcdBarrier& b) {
    asm volatile("s_waitcnt vmcnt(0)" ::: "memory");
    __syncthreads();
    if (threadIdx.x == 0) {
        unsigned* bar = b.bar;
        __builtin_amdgcn_s_waitcnt(0);
        unsigned nloc = b.st[0], nx = b.st[1];
        if (nloc == 0u) { xcd_barrier_complete(bar, b.x, nloc, nx); b.st[0] = nloc; b.st[1] = nx; }
        const unsigned old = xb_add(&bar[XB_XSUB(b.x)], 1u);
        const unsigned gen = old / nloc;
        if (old + 1u == (gen + 1u) * nloc) {
            __builtin_amdgcn_fence(__ATOMIC_RELEASE, "agent");
            asm volatile("s_waitcnt vmcnt(0)" ::: "memory");
            const unsigned og = xb_add(&bar[XB_TOP], 1u);
            const unsigned tg = og / nx;
            if (og + 1u == (tg + 1u) * nx) xb_add(&bar[XB_TOPGEN], 1u);
            else XB_SPIN(xb_ld(&bar[XB_TOPGEN]) == tg, bar);
            __builtin_amdgcn_fence(__ATOMIC_ACQUIRE, "agent");
            xb_add(&bar[XB_XGEN(b.x)], 1u);
            asm volatile("s_waitcnt vmcnt(0)" ::: "memory");
        } else {
            XB_SPIN(xb_ld(&bar[XB_XGEN(b.x)]) == gen, bar);
            __builtin_amdgcn_fence(__ATOMIC_ACQUIRE, "agent");
            asm volatile("s_waitcnt vmcnt(0)" ::: "memory");
        }
    }
    __syncthreads();
}

namespace pg8 {
constexpr int BM = 256, BK = 64, HALF = 128, HTB = HALF * BK * 2, STAGE_BYTES = 8 * HTB, NXCD = 8, WGM = 8;
__host__ __device__ __forceinline__ int lds_byte(int r, int c) { const int st = (r >> 4) * 2 + (c >> 5), rr = r & 15, cc = c & 31, ob = rr * 64 + cc * 2; return st * 1024 + (ob ^ (((ob >> 9) & 1) << 5)); }
__host__ __device__ __forceinline__ void stage_rc(int b, int& R, int& C) { const int st = b / 1024, sb = b % 1024, swz = sb ^ (((sb >> 9) & 1) << 5); R = (st >> 1) * 16 + swz / 64; C = (st & 1) * 32 + (swz % 64) / 2; }
__host__ __device__ __forceinline__ int perm32(int rho) { const int n = rho >> 4, i = rho & 15; return 8 * (i >> 2) + 4 * n + (i & 3); }
struct Unit { int pm, pn, a0, a1; };
struct Gemm { const bf16_t* A; const bf16_t* Bt; int K; };

DI void tile_of(int L, int nM, int nN, int& pm, int& pn) {
    const int nwg = nM * nN; int wgid = L;
    { const int q = nwg / NXCD, r = nwg % NXCD, xcd = wgid % NXCD, off = wgid / NXCD; wgid = (xcd < r ? xcd * (q + 1) : r * (q + 1) + (xcd - r) * q) + off; }
    const int nig = WGM * nN, gid = wgid / nig, fm = gid * WGM, gsz = (nM - fm) < WGM ? (nM - fm) : WGM;
    pm = fm + ((wgid % nig) % gsz); pn = (wgid % nig) / gsz;
}
struct StaticOrder {
    int nM, nN, nwg, G, c;
    DI void init(int Mrows, int N, int G_, int c_) { nM = Mrows / BM; nN = N / BM; nwg = nM * nN; G = G_; c = c_; }
    DI bool next(int i, Unit& u) const {
        const long L = (long)i * G + c; if (L >= nwg) return false;
        tile_of((int)L, nM, nN, u.pm, u.pn); u.a0 = 0; u.a1 = 0; return true;
    }
    DI unsigned arow(const Unit&, int) const { return 0u; }
};

template <class Epi, class Sched, bool ALIGN_EPI, bool GATHER>
DI void gemm_phase(LAS unsigned char* lds, const Gemm g, const Sched& S, const Epi& E, int wid) {
    const int lane = lane_id(), tid = wid * 64 + lane, wr = wid >> 2, wc = wid & 3, fr = lane & 15, fq = lane >> 4;
    int K = g.K; asm volatile("" : "+s"(K));
    const int nt = K / BK;
    unsigned voffA[2], voffB[2]; int RA[2];
#pragma unroll
    for (int i = 0; i < 2; ++i) { int R, C; stage_rc(tid * 16 + i * 8192, R, C); const int Rb = Epi::PERM ? ((R & ~31) + perm32(R & 31)) : R;
        voffA[i] = GATHER ? (unsigned)(C * 2) : (unsigned)(R * K + C) * 2u; voffB[i] = (unsigned)(Rb * K + C) * 2u; RA[i] = R; }
    const size_t kstep = (size_t)(BK * 2);
    const size_t hstep = (size_t)HALF * K * 2;
    const size_t tstep = 2 * hstep;
    const unsigned ldsw = (unsigned)wid * 1024u;
    const int aoff = lds_byte(wr * 64 + fr, fq * 8), boff = lds_byte(wc * 32 + fr, fq * 8);
#define PG8_SA(b, h) (((b) * 2 + (h)) * HTB)
#define PG8_SB(b, h) ((4 + (b) * 2 + (h)) * HTB)
#define PG8_STAGE(bufoff, gbase, voff) do { _Pragma("unroll") for (int _i = 0; _i < 2; ++_i) \
        __builtin_amdgcn_global_load_lds((const unsigned*)((const char*)(gbase) + (voff)[_i]), (LAS unsigned*)(lds + (bufoff) + ldsw + _i * 8192), 16, 0, 0); } while (0)
#define PG8_STAGE_A(bufoff, plainptr, hh, kptr, go) do { if constexpr (GATHER) { _Pragma("unroll") for (int _i = 0; _i < 2; ++_i) \
        __builtin_amdgcn_global_load_lds((const unsigned*)((kptr) + (go)[hh][_i]), (LAS unsigned*)(lds + (bufoff) + ldsw + _i * 8192), 16, 0, 0); } \
        else { PG8_STAGE(bufoff, (plainptr) + (hh) * hstep, voffA); } } while (0)
#define PG8_LDA(dst, b, h) do { _Pragma("unroll") for (int m = 0; m < 4; ++m) _Pragma("unroll") for (int k = 0; k < 2; ++k) dst[m][k] = *(const LAS bf16x8*)(lds + PG8_SA(b, h) + aoff + m * 2048 + k * 1024); } while (0)
#define PG8_LDB(dst, b, h) do { _Pragma("unroll") for (int n = 0; n < 2; ++n) _Pragma("unroll") for (int k = 0; k < 2; ++k) dst[n][k] = *(const LAS bf16x8*)(lds + PG8_SB(b, h) + boff + n * 2048 + k * 1024); } while (0)
#define PG8_MMA(ai, bj, At, Bt) do { __builtin_amdgcn_s_setprio(1); _Pragma("unroll") for (int m = 0; m < 4; ++m) _Pragma("unroll") for (int n = 0; n < 2; ++n) _Pragma("unroll") for (int k = 0; k < 2; ++k) \
        acc[ai][bj][m][n] = __builtin_amdgcn_mfma_f32_16x16x32_bf16(Bt[n][k], At[m][k], acc[ai][bj][m][n], 0, 0, 0); __builtin_amdgcn_s_setprio(0); } while (0)
#define PG8_WAIT_V(n) asm volatile("s_waitcnt vmcnt(" #n ")" ::: "memory")
#define PG8_WAIT_L(n) asm volatile("s_waitcnt lgkmcnt(" #n ")" ::: "memory")
#define PG8_BAR __builtin_amdgcn_s_barrier()
#define PG8_SCHED __builtin_amdgcn_sched_barrier(0)
    Unit cur, nxt; int ui = 0;
    if (!S.next(0, cur)) return;
    f32x4 acc[2][2][4][2];
#pragma unroll
    for (int a = 0; a < 2; ++a)
#pragma unroll
        for (int b = 0; b < 2; ++b)
#pragma unroll
            for (int m = 0; m < 4; ++m)
#pragma unroll
                for (int n = 0; n < 2; ++n) acc[a][b][m][n] = (f32x4){0.f, 0.f, 0.f, 0.f};
    bf16x8 At[4][2], B0[2][2], B1[2][2];
    const char* A0 = (const char*)g.A;
    const char* cA = A0 + (GATHER ? (size_t)0 : (size_t)cur.pm * tstep); const char* cB = (const char*)g.Bt + (size_t)cur.pn * tstep;
    unsigned gc[2][2], gn[2][2];
#pragma unroll
    for (int hh = 0; hh < 2; ++hh)
#pragma unroll
        for (int i = 0; i < 2; ++i) { gc[hh][i] = GATHER ? S.arow(cur, hh * HALF + RA[i]) + voffA[i] : 0u; gn[hh][i] = gc[hh][i]; }
    PG8_STAGE(PG8_SB(0, 0), cB, voffB); PG8_STAGE(PG8_SB(0, 1), cB + hstep, voffB); PG8_STAGE_A(PG8_SA(0, 0), cA, 0, A0, gc); PG8_STAGE_A(PG8_SA(0, 1), cA, 1, A0, gc);
    if (wr == 1) PG8_BAR;
    PG8_WAIT_V(2); PG8_BAR;
    PG8_STAGE(PG8_SB(1, 0), cB + kstep, voffB); PG8_STAGE_A(PG8_SA(1, 0), cA + kstep, 0, A0 + kstep, gc); PG8_STAGE(PG8_SB(1, 1), cB + hstep + kstep, voffB);
    PG8_WAIT_V(6); PG8_BAR;
    for (;;) {
        const bool has_next = S.next(ui + 1, nxt);
        const char* nA = has_next ? A0 + (GATHER ? (size_t)0 : (size_t)nxt.pm * tstep) : cA; const char* nB = has_next ? (const char*)g.Bt + (size_t)nxt.pn * tstep : cB;
        if constexpr (GATHER) {
#pragma unroll
            for (int hh = 0; hh < 2; ++hh)
#pragma unroll
                for (int i = 0; i < 2; ++i) gn[hh][i] = has_next ? S.arow(nxt, hh * HALF + RA[i]) + voffA[i] : gc[hh][i];
        }
        for (int t = 0; t < nt; t += 2) {
            const bool last = (t == nt - 2);
            const char* a1 = cA + (size_t)(t + 1) * kstep;
            const char* a2 = last ? nA : cA + (size_t)(t + 2) * kstep; const char* b2 = last ? nB : cB + (size_t)(t + 2) * kstep;
            const char* a3 = a2 + kstep; const char* b3 = b2 + kstep;
            const char* k1 = A0 + (size_t)(t + 1) * kstep; const char* k2 = A0 + (last ? (size_t)0 : (size_t)(t + 2) * kstep); const char* k3 = k2 + kstep;
            unsigned g2[2][2];
#pragma unroll
            for (int hh = 0; hh < 2; ++hh)
#pragma unroll
                for (int i = 0; i < 2; ++i) g2[hh][i] = last ? gn[hh][i] : gc[hh][i];
            PG8_LDB(B0, 0, 0); PG8_LDB(B1, 0, 1); PG8_SCHED; PG8_LDA(At, 0, 0); PG8_STAGE_A(PG8_SA(1, 1), a1, 1, k1, gc);
            PG8_WAIT_V(8); PG8_WAIT_L(0); PG8_BAR; PG8_MMA(0, 0, At, B0); PG8_MMA(0, 1, At, B1); PG8_BAR; PG8_SCHED;
            PG8_LDA(At, 0, 1); PG8_STAGE(PG8_SB(0, 0), b2, voffB); PG8_STAGE(PG8_SB(0, 1), b2 + hstep, voffB); PG8_STAGE_A(PG8_SA(0, 0), a2, 0, k2, g2);
            PG8_WAIT_V(8); PG8_WAIT_L(0); PG8_BAR; PG8_MMA(1, 0, At, B0); PG8_MMA(1, 1, At, B1); PG8_BAR; PG8_SCHED;
            PG8_LDB(B0, 1, 0); PG8_LDB(B1, 1, 1); PG8_SCHED; PG8_LDA(At, 1, 0); PG8_STAGE_A(PG8_SA(0, 1), a2, 1, k2, g2);
            PG8_WAIT_V(8); PG8_WAIT_L(0); PG8_BAR; PG8_MMA(0, 0, At, B0); PG8_MMA(0, 1, At, B1); PG8_BAR; PG8_SCHED;
            PG8_LDA(At, 1, 1); PG8_STAGE(PG8_SB(1, 0), b3, voffB); PG8_STAGE(PG8_SB(1, 1), b3 + hstep, voffB); PG8_STAGE_A(PG8_SA(1, 0), a3, 0, k3, g2);
            PG8_WAIT_V(8); PG8_WAIT_L(0); PG8_BAR; PG8_MMA(1, 0, At, B0); PG8_MMA(1, 1, At, B1); PG8_BAR; PG8_SCHED;
        }
        if constexpr (ALIGN_EPI) { if (wr == 0) PG8_BAR; }
        { const int l2 = lane_id(); E(acc, cur, wr, wc, l2 & 15, l2 >> 4); }
        if (!has_next) break;
#pragma unroll
        for (int a = 0; a < 2; ++a)
#pragma unroll
            for (int b = 0; b < 2; ++b)
#pragma unroll
                for (int m = 0; m < 4; ++m)
#pragma unroll
                    for (int n = 0; n < 2; ++n) acc[a][b][m][n] = (f32x4){0.f, 0.f, 0.f, 0.f};
        cur = nxt; cA = nA; cB = nB; ++ui;
#pragma unroll
        for (int hh = 0; hh < 2; ++hh)
#pragma unroll
            for (int i = 0; i < 2; ++i) gc[hh][i] = gn[hh][i];
        if constexpr (ALIGN_EPI) { if (wr == 1) PG8_BAR; }
    }
    PG8_WAIT_V(0);
    if constexpr (!ALIGN_EPI) { if (wr == 0) PG8_BAR; }
    PG8_BAR;
#undef PG8_SA
#undef PG8_SB
#undef PG8_STAGE
#undef PG8_STAGE_A
#undef PG8_LDA
#undef PG8_LDB
#undef PG8_MMA
#undef PG8_WAIT_V
#undef PG8_WAIT_L
#undef PG8_BAR
#undef PG8_SCHED
}
}
using pg8::Unit;

struct Args { const void* in[27]; float* out; unsigned char* ws; int ph_lo, ph_hi; };
struct Ctx {
    const float *x, *ln0_g, *ln0_b, *w_in, *q_norm_g, *w_uq, *kv_norm_g, *w_uk, *w_uv, *rel_bias, *w_up_a, *w_up_b, *w_gate, *b_gate, *w_o, *ln1_g, *ln1_b,
                *w_grp, *b_grp, *w_rt, *b_rt, *w_eg, *w_eu, *w_ed, *ln2_g, *ln2_b;
    const int* pos;
    float* out; unsigned char* ws;
    LAS unsigned char* lds;
    int G, bid, wid;
};
constexpr int LDS_RING = 131072;
constexpr int LDS_MISC = LDS_RING;
constexpr int LDS_LG = LDS_RING + 4096;
constexpr int LDS_BYTES = LDS_RING + 4096 + 8192;
template <class T> DI T* wsp(const Ctx& X, size_t off) { return (T*)(X.ws + off); }

DI void tr_item(const float* W, int ld, int K, int ncols, bf16_t* WT, const float* scale, LAS float* scr, int item, int lane) {
    const int nblk = (ncols + 31) >> 5, kb = item / nblk, nb = item - kb * nblk, k0 = 64 * kb, n0 = 32 * nb;
#pragma unroll 8
    for (int i = 0; i < 32; ++i) { const int kk = 2 * i + (lane >> 5), n = n0 + (lane & 31); float v = (n < ncols) ? W[(size_t)(k0 + kk) * ld + n] : 0.f; if (scale) v *= scale[k0 + kk]; scr[kk * 33 + (lane & 31)] = v; }
    asm volatile("s_waitcnt lgkmcnt(0)" ::: "memory");
    const int c = lane & 7;
#pragma unroll
    for (int j = 0; j < 4; ++j) { const int n = (lane >> 3) + 8 * j; const LAS float* s = scr + (8 * c) * 33 + n;
        u32x4 o; o.x = pk2(s[0 * 33], s[1 * 33]); o.y = pk2(s[2 * 33], s[3 * 33]); o.z = pk2(s[4 * 33], s[5 * 33]); o.w = pk2(s[6 * 33], s[7 * 33]);
        if (n0 + n < ncols) *(u32x4*)(WT + (size_t)(n0 + n) * K + k0 + 8 * c) = o; }
    asm volatile("s_waitcnt lgkmcnt(0)" ::: "memory");
}
DI int tr_items(int K, int ncols) { return (K / 64) * ((ncols + 31) / 32); }

DI void p0_prologue(const Ctx& X) {
    const int lane = lane_id(), wave = X.wid, tid = wave * 64 + lane;
    LAS float* scr = (LAS float*)(X.lds + wave * 16384);
    const int gw = X.bid * 8 + wave, NGW = X.G * 8;
    bf16_t* WT1 = wsp<bf16_t>(X, WS_WT1);
    {
        const int seg_c0[9] = {0, 256, 384, 1312, 928, 416, 1056, 992, 1344};
        const int seg_nc[9] = {256, 128, 32, 32, 64, 512, 256, 64, 8};
        const int seg_d0[9] = {0, 256, 384, 416, 448, 512, 1024, 1280, 1344};
        int base = 0;
#pragma unroll
        for (int s = 0; s < 9; ++s) { const int n = tr_items(1024, seg_nc[s]);
            for (int it = gw; it < n; it += NGW) tr_item(X.w_in + seg_c0[s], 1352, 1024, seg_nc[s], WT1 + (size_t)seg_d0[s] * 1024, nullptr, scr, it, lane);
            base += n; }
        (void)base;
        for (int it = gw; it < tr_items(1024, 2048); it += NGW) tr_item(X.w_gate, 2048, 1024, 2048, WT1 + (size_t)1536 * 1024, nullptr, scr, it, lane);
        for (int it = gw; it < tr_items(256, 768); it += NGW) tr_item(X.w_uq, 768, 256, 768, wsp<bf16_t>(X, WS_WUQT), X.q_norm_g, scr, it, lane);
        for (int it = gw; it < tr_items(128, 512); it += NGW) tr_item(X.w_uk, 512, 128, 512, wsp<bf16_t>(X, WS_WUKVT), X.kv_norm_g, scr, it, lane);
        for (int it = gw; it < tr_items(128, 512); it += NGW) tr_item(X.w_uv, 512, 128, 512, wsp<bf16_t>(X, WS_WUKVT) + 512 * 128, X.kv_norm_g, scr, it, lane);
        for (int it = gw; it < tr_items(512, 1024); it += NGW) tr_item(X.w_up_a, 1024, 512, 1024, wsp<bf16_t>(X, WS_WUPT), nullptr, scr, it, lane);
        for (int it = gw; it < tr_items(512, 1024); it += NGW) tr_item(X.w_up_b, 1024, 512, 1024, wsp<bf16_t>(X, WS_WUPT) + 1024 * 512, nullptr, scr, it, lane);
        for (int it = gw; it < tr_items(1024, 1024); it += NGW) tr_item(X.w_o, 1024, 1024, 1024, wsp<bf16_t>(X, WS_WOT), nullptr, scr, it, lane);
        { const int per = tr_items(1024, 128);
          for (int it = gw; it < 128 * per; it += NGW) { const int job = it / per, r = it - job * per, e = job >> 2, pn = (job >> 1) & 1, bj = job & 1;
              tr_item((bj ? X.w_eu : X.w_eg) + (size_t)e * 1024 * 256 + 128 * pn, 256, 1024, 128, wsp<bf16_t>(X, WS_WEGUT) + ((size_t)e * 512 + 256 * pn + 128 * bj) * 1024, nullptr, scr, r, lane); } }
        { const int per = tr_items(256, 1024);
          for (int it = gw; it < 32 * per; it += NGW) { const int e = it / per, r = it - e * per;
              tr_item(X.w_ed + (size_t)e * 256 * 1024, 1024, 256, 1024, wsp<bf16_t>(X, WS_WEDT) + (size_t)e * 1024 * 256, nullptr, scr, r, lane); } }
    }
    { const int gt = X.bid * 512 + tid, NT = X.G * 512; u32x4 z = {0u, 0u, 0u, 0u};
      for (int i = gt; i < 184 * 1024 / 8; i += NT) *(u32x4*)(WT1 + (size_t)1352 * 1024 + (size_t)i * 8) = z; }
    { const int gt = X.bid * 512 + tid, NT = X.G * 512; bf16_t* WR = wsp<bf16_t>(X, WS_WRT);
      for (int i = gt; i < 64 * 1024; i += NT) { const int j = i >> 10, k = i & 1023;
          const float v = (j < 4) ? X.w_grp[k * 4 + j] : (j < 36 ? X.w_rt[k * 32 + (j - 4)] : 0.f);
          const unsigned hi = pk2(v, 0.f) & 0xffffu; const float lo = v - bf2f((unsigned short)hi);
          WR[(size_t)j * 1024 + k] = (bf16_t)hi; WR[(size_t)(64 + j) * 1024 + k] = (bf16_t)(pk2(lo, 0.f) & 0xffffu); } }
    { const int gt = X.bid * 512 + tid, NT = X.G * 512; float* RT = wsp<float>(X, WS_ROPE);
      for (int i = gt; i < M * 16; i += NT) { const int row = i >> 4, j = i & 15; float sn, cs; rope_sincos(X.pos[row], j, sn, cs); RT[(size_t)row * 32 + j] = cs; RT[(size_t)row * 32 + 16 + j] = sn; } }
    { int* TS = wsp<int>(X, WS_TSTAT);
      for (int t = gw; t < M / 64; t += NGW) { const int p = X.pos[t * 64 + lane]; const int pmin = wave_min_i(p), pmax = wave_max_i(p);
          if (lane == 0) { TS[t * 4 + 0] = pmin >> 6; TS[t * 4 + 1] = pmax >> 6; TS[t * 4 + 2] = pmin; TS[t * 4 + 3] = pmax; } } }
    { bf16_t* XN = wsp<bf16_t>(X, WS_B); float* ST = wsp<float>(X, WS_STATS0);
#if DBG_STAGE == 1
      float* Y1 = wsp<float>(X, WS_A);
#endif
      f32x4 gv[4], bv[4];
#pragma unroll
      for (int j = 0; j < 4; ++j) { gv[j] = *(const f32x4*)(X.ln0_g + 4 * lane + 256 * j); bv[j] = *(const f32x4*)(X.ln0_b + 4 * lane + 256 * j); }
      for (int m = gw; m < M; m += NGW) {
          const f32x4* xr = (const f32x4*)(X.x + (size_t)m * D) + lane;
          f32x4 v[4]; float s = 0.f;
#pragma unroll
          for (int j = 0; j < 4; ++j) { v[j] = xr[64 * j]; s += (v[j].x + v[j].y) + (v[j].z + v[j].w); }
          const float mean = wave_sum(s) * (1.f / D); float s2 = 0.f;
#pragma unroll
          for (int j = 0; j < 4; ++j) { v[j] = v[j] - mean; s2 += (v[j].x * v[j].x + v[j].y * v[j].y) + (v[j].z * v[j].z + v[j].w * v[j].w); }
          const float rstd = 1.f / sqrtf(wave_sum(s2) * (1.f / D) + LN_EPS);
          if (lane == 0) { ST[2 * m] = mean; ST[2 * m + 1] = rstd; }
          u32x2* o8 = (u32x2*)(XN + (size_t)m * D) + lane;
#pragma unroll
          for (int j = 0; j < 4; ++j) { const f32x4 y = v[j] * rstd * gv[j] + bv[j]; u32x2 o; o.x = pk2(y.x, y.y); o.y = pk2(y.z, y.w); o8[64 * j] = o;
#if DBG_STAGE == 1
              *((f32x4*)(Y1 + (size_t)m * D) + lane + 64 * j) = y * ALPHA;
#endif
          }
      } }
}

DI void store8(bf16_t* p, const f32x4& a, const f32x4& b) { u32x4 w; w.x = pk2(a[0], a[1]); w.y = pk2(a[2], a[3]); w.z = pk2(b[0], b[1]); w.w = pk2(b[2], b[3]); *(u32x4*)p = w; }
DI void rope8(f32x4& v0, f32x4& v1, const float* tab, int fq) {
    const float sg = (fq < 2) ? -1.f : 1.f; const int j0 = 8 * (fq & 1);
    const f32x4 c0 = *(const f32x4*)(tab + j0), c1 = *(const f32x4*)(tab + j0 + 4), s0 = *(const f32x4*)(tab + 16 + j0), s1 = *(const f32x4*)(tab + 16 + j0 + 4);
#pragma unroll
    for (int e = 0; e < 4; ++e) {
        const float o0 = __shfl_xor(v0[e], 32), o1 = __shfl_xor(v1[e], 32);
        v0[e] = v0[e] * c0[e] + sg * o0 * s0[e];
        v1[e] = v1[e] * c1[e] + sg * o1 * s1[e];
    }
}
struct Epi1 {
    static constexpr bool PERM = true;
    bf16_t *CQ, *CKV, *KR, *KI, *KB, *VB, *QB, *QI, *G; float *WI, *SSQ; const float* rope; const float* bgate;
    DI void operator()(const f32x4 (&acc)[2][2][4][2], const Unit& u, int wr, int wc, int fr_, int fq_) const {
        int fr = fr_, fq = fq_; asm volatile("" : "+v"(fr), "+v"(fq));
        const int pn = u.pn; const int row0 = u.pm * 256 + wr * 64 + fr;
        if (pn >= 6) {
            const int gc0 = (pn - 6) * 256 + 32 * wc + 8 * fq;
#pragma unroll
            for (int bj = 0; bj < 2; ++bj) { const f32x4 b0 = *(const f32x4*)(bgate + gc0 + 128 * bj), b1 = *(const f32x4*)(bgate + gc0 + 128 * bj + 4);
#pragma unroll
                for (int ai = 0; ai < 2; ++ai)
#pragma unroll
                    for (int m = 0; m < 4; ++m) { f32x4 v0 = acc[ai][bj][m][0] + b0, v1 = acc[ai][bj][m][1] + b1;
#pragma unroll
                        for (int e = 0; e < 4; ++e) { v0[e] = sigmoidf_fast(v0[e]); v1[e] = sigmoidf_fast(v1[e]); }
                        store8(G + (size_t)(row0 + ai * 128 + m * 16) * 2048 + gc0 + 128 * bj, v0, v1); } }
        } else if (pn == 0 || pn == 4) {
            bf16_t* O = pn == 0 ? CQ : QI;
#pragma unroll
            for (int ai = 0; ai < 2; ++ai)
#pragma unroll
                for (int m = 0; m < 4; ++m) { const int row = row0 + ai * 128 + m * 16; float s = 0.f;
#pragma unroll
                    for (int bj = 0; bj < 2; ++bj) { const f32x4 v0 = acc[ai][bj][m][0], v1 = acc[ai][bj][m][1];
                        store8(O + (size_t)row * 256 + 128 * bj + 32 * wc + 8 * fq, v0, v1);
                        s += (v0[0] * v0[0] + v0[1] * v0[1]) + (v0[2] * v0[2] + v0[3] * v0[3]) + (v1[0] * v1[0] + v1[1] * v1[1]) + (v1[2] * v1[2] + v1[3] * v1[3]); }
                    if (pn == 0) { s += __shfl_xor(s, 16); s += __shfl_xor(s, 32); if (fq == 0) SSQ[(size_t)row * 8 + wc] = s; } }
        } else if (pn == 2 || pn == 3) {
            const float sc = 0.125f * LOG2E;
#pragma unroll
            for (int ai = 0; ai < 2; ++ai)
#pragma unroll
                for (int m = 0; m < 4; ++m) { const int row = row0 + ai * 128 + m * 16;
#pragma unroll
                    for (int bj = 0; bj < 2; ++bj) store8(QB + (size_t)row * 512 + (pn - 2) * 256 + 128 * bj + 32 * wc + 8 * fq, acc[ai][bj][m][0] * sc, acc[ai][bj][m][1] * sc); }
        } else if (pn == 1) {
#pragma unroll
            for (int ai = 0; ai < 2; ++ai)
#pragma unroll
                for (int m = 0; m < 4; ++m) { const int row = row0 + ai * 128 + m * 16;
                    { const f32x4 v0 = acc[ai][0][m][0], v1 = acc[ai][0][m][1];
                      store8(CKV + (size_t)row * 128 + 32 * wc + 8 * fq, v0, v1);
                      float s = (v0[0] * v0[0] + v0[1] * v0[1]) + (v0[2] * v0[2] + v0[3] * v0[3]) + (v1[0] * v1[0] + v1[1] * v1[1]) + (v1[2] * v1[2] + v1[3] * v1[3]);
                      s += __shfl_xor(s, 16); s += __shfl_xor(s, 32); if (fq == 0) SSQ[(size_t)row * 8 + 4 + wc] = s; }
                    f32x4 v0 = acc[ai][1][m][0], v1 = acc[ai][1][m][1];
                    if (wc == 0) { rope8(v0, v1, rope + (size_t)row * 32, fq); store8(KR + (size_t)row * 32 + 8 * fq, v0, v1); }
                    else if (wc == 1) store8(KI + (size_t)row * 32 + 8 * fq, v0, v1);
                    else store8(KB + (size_t)row * 64 + 32 * (wc - 2) + 8 * fq, v0, v1); }
        } else {
            const float wsc = 0.35355339059327373f * 0.17677669529663687f;
#pragma unroll
            for (int ai = 0; ai < 2; ++ai)
#pragma unroll
                for (int m = 0; m < 4; ++m) { const int row = row0 + ai * 128 + m * 16;
                    if (wc < 2) store8(VB + (size_t)row * 64 + 32 * wc + 8 * fq, acc[ai][0][m][0], acc[ai][0][m][1]);
                    else if (wc == 2 && fq == 0) { *(f32x4*)(WI + (size_t)row * 8) = acc[ai][0][m][0] * wsc; *(f32x4*)(WI + (size_t)row * 8 + 4) = acc[ai][0][m][1] * wsc; } }
        }
    }
};
struct Epi2 {
    static constexpr bool PERM = true;
    bf16_t* QM; const float* SSQ; const float* rope;
    DI void operator()(const f32x4 (&acc)[2][2][4][2], const Unit& u, int wr, int wc, int fr_, int fq_) const {
        int fr = fr_, fq = fq_; asm volatile("" : "+v"(fr), "+v"(fq));
        const int row0 = u.pm * 256 + wr * 64 + fr; const float sc = 0.10206207261596575f * LOG2E;
#pragma unroll
        for (int ai = 0; ai < 2; ++ai)
#pragma unroll
            for (int m = 0; m < 4; ++m) { const int row = row0 + ai * 128 + m * 16;
                const f32x4 q4 = *(const f32x4*)(SSQ + (size_t)row * 8); const float rs = sc / sqrtf(((q4[0] + q4[1]) + (q4[2] + q4[3])) * (1.f / 256.f) + RMS_EPS);
#pragma unroll
                for (int bj = 0; bj < 2; ++bj) { const int g32 = 8 * u.pn + 4 * bj + wc; f32x4 v0 = acc[ai][bj][m][0] * rs, v1 = acc[ai][bj][m][1] * rs;
                    if (g32 % 3 == 2) rope8(v0, v1, rope + (size_t)row * 32, fq);
                    store8(QM + (size_t)row * 768 + 32 * g32 + 8 * fq, v0, v1); } }
    }
};
struct Epi3 {
    static constexpr bool PERM = true;
    bf16_t *KN, *VM; const float* SSQ;
    DI void operator()(const f32x4 (&acc)[2][2][4][2], const Unit& u, int wr, int wc, int fr_, int fq_) const {
        int fr = fr_, fq = fq_; asm volatile("" : "+v"(fr), "+v"(fq));
        const int row0 = u.pm * 256 + wr * 64 + fr; bf16_t* O = u.pn < 2 ? KN : VM; const int c0 = (u.pn & 1) * 256 + 32 * wc + 8 * fq;
#pragma unroll
        for (int ai = 0; ai < 2; ++ai)
#pragma unroll
            for (int m = 0; m < 4; ++m) { const int row = row0 + ai * 128 + m * 16;
                const f32x4 q4 = *(const f32x4*)(SSQ + (size_t)row * 8 + 4); const float rs = 1.f / sqrtf(((q4[0] + q4[1]) + (q4[2] + q4[3])) * (1.f / 128.f) + RMS_EPS);
#pragma unroll
                for (int bj = 0; bj < 2; ++bj) store8(O + (size_t)row * 512 + c0 + 128 * bj, acc[ai][bj][m][0] * rs, acc[ai][bj][m][1] * rs); }
    }
};
struct PairOrder {
    int G, c;
    DI bool next(int i, Unit& u) const { const int ii = i >> 1, z = i & 1; const long L = (long)ii * G + c; if (L >= 512) return false;
        int pm, pn; pg8::tile_of((int)L, 128, 4, pm, pn); u.pm = pm + 128 * z; u.pn = pn + 4 * z; u.a0 = z; u.a1 = 0; return true; }
    DI unsigned arow(const Unit&, int) const { return 0u; }
};
struct Epi4 {
    static constexpr bool PERM = true;
    bf16_t* MIX; const bf16_t* G;
    DI void operator()(const f32x4 (&acc)[2][2][4][2], const Unit& u, int wr, int wc, int fr_, int fq_) const {
        int fr = fr_, fq = fq_; asm volatile("" : "+v"(fr), "+v"(fq));
        const int z = u.a0, row0 = (u.pm & 127) * 256 + wr * 64 + fr, c0 = (u.pn & 3) * 256 + 32 * wc + 8 * fq;
#pragma unroll
        for (int ai = 0; ai < 2; ++ai)
#pragma unroll
            for (int m = 0; m < 4; ++m) { const int row = row0 + ai * 128 + m * 16;
#pragma unroll
                for (int bj = 0; bj < 2; ++bj) { const int c = c0 + 128 * bj;
                    const u32x4 gw = *(const u32x4*)(G + (size_t)row * 2048 + z * 1024 + c);
                    f32x4 v0 = acc[ai][bj][m][0], v1 = acc[ai][bj][m][1];
                    v0[0] *= __uint_as_float(gw.x << 16); v0[1] *= __uint_as_float(gw.x & 0xffff0000u); v0[2] *= __uint_as_float(gw.y << 16); v0[3] *= __uint_as_float(gw.y & 0xffff0000u);
                    v1[0] *= __uint_as_float(gw.z << 16); v1[1] *= __uint_as_float(gw.z & 0xffff0000u); v1[2] *= __uint_as_float(gw.w << 16); v1[3] *= __uint_as_float(gw.w & 0xffff0000u);
                    bf16_t* o = MIX + (size_t)row * 1024 + c;
                    if (z) { const u32x4 pw = *(const u32x4*)o;
                        v0[0] += __uint_as_float(pw.x << 16); v0[1] += __uint_as_float(pw.x & 0xffff0000u); v0[2] += __uint_as_float(pw.y << 16); v0[3] += __uint_as_float(pw.y & 0xffff0000u);
                        v1[0] += __uint_as_float(pw.z << 16); v1[1] += __uint_as_float(pw.z & 0xffff0000u); v1[2] += __uint_as_float(pw.w << 16); v1[3] += __uint_as_float(pw.w & 0xffff0000u); }
                    store8(o, v0, v1); } }
    }
};
struct Epi5 {
    static constexpr bool PERM = false;
    float* Y1; const float *x, *ST, *g0, *b0;
    DI void operator()(const f32x4 (&acc)[2][2][4][2], const Unit& u, int wr, int wc, int fr_, int fq_) const {
        int fr = fr_, fq = fq_; asm volatile("" : "+v"(fr), "+v"(fq));
        const int row0 = u.pm * 256 + wr * 64 + fr, c0 = u.pn * 256 + 32 * wc + 4 * fq;
        f32x4 gv[2][2], bv[2][2];
#pragma unroll
        for (int bj = 0; bj < 2; ++bj)
#pragma unroll
            for (int n = 0; n < 2; ++n) { gv[bj][n] = *(const f32x4*)(g0 + c0 + 128 * bj + 16 * n) * ALPHA; bv[bj][n] = *(const f32x4*)(b0 + c0 + 128 * bj + 16 * n) * ALPHA; }
#pragma unroll
        for (int ai = 0; ai < 2; ++ai)
#pragma unroll
            for (int m = 0; m < 4; ++m) { const int row = row0 + ai * 128 + m * 16; const float mean = ST[2 * row], rstd = ST[2 * row + 1];
#pragma unroll
                for (int bj = 0; bj < 2; ++bj)
#pragma unroll
                    for (int n = 0; n < 2; ++n) { const size_t off = (size_t)row * 1024 + c0 + 128 * bj + 16 * n;
                        const f32x4 xv = *(const f32x4*)(x + off);
                        *(f32x4*)(Y1 + off) = (xv - mean) * rstd * gv[bj][n] + bv[bj][n] + acc[ai][bj][m][n]; } }
    }
};
struct MoeOrder {
    const LAS int* tstart;
    const LAS int* scnt;
    const int* LIST; int K2;
    int NT, G, c, ntiles;
    DI bool next(int i, Unit& u) const {
        const long L = (long)i * G + c; if (L >= (long)ntiles * NT) return false;
        const int tile = (int)(L / NT), pn = (int)(L - (long)tile * NT);
        int lo = 0, hi = NSEG;
#pragma unroll
        for (int s = 0; s < 6; ++s) { const int mid = (lo + hi) >> 1; if (tstart[mid] <= tile) lo = mid; else hi = mid; }
        const int ts = tstart[lo];
        u.pm = tile; u.pn = __builtin_amdgcn_readfirstlane((lo & 31) * NT + pn); u.a0 = __builtin_amdgcn_readfirstlane(lo); u.a1 = __builtin_amdgcn_readfirstlane(tile - ts); return true;
    }
    DI unsigned arow(const Unit& u, int r) const { const int idx = u.a1 * 256 + r; const int tok = LIST[(size_t)u.a0 * M + (idx < scnt[u.a0] ? idx : 0)]; return (unsigned)tok * (unsigned)K2; }
};
struct Epi7 {
    static constexpr bool PERM = true;
    bf16_t* HID; const float* LISTW; const LAS int* scnt;
    DI void operator()(const f32x4 (&acc)[2][2][4][2], const Unit& u, int wr, int wc, int fr_, int fq_) const {
        int fr = fr_, fq = fq_; asm volatile("" : "+v"(fr), "+v"(fq));
        const int c0 = (u.pn & 1) * 128 + 32 * wc + 8 * fq, cnt = scnt[u.a0];
#pragma unroll
        for (int ai = 0; ai < 2; ++ai)
#pragma unroll
            for (int m = 0; m < 4; ++m) { const int r = ai * 128 + wr * 64 + m * 16 + fr, idx = u.a1 * 256 + r;
                const float w = idx < cnt ? LISTW[(size_t)u.a0 * M + idx] : 0.f;
                f32x4 v0, v1;
#pragma unroll
                for (int e = 0; e < 4; ++e) { const float a0 = acc[ai][0][m][0][e], a1 = acc[ai][0][m][1][e];
                    v0[e] = a0 * sigmoidf_fast(a0) * acc[ai][1][m][0][e] * w; v1[e] = a1 * sigmoidf_fast(a1) * acc[ai][1][m][1][e] * w; }
                store8(HID + ((size_t)u.pm * 256 + r) * 256 + c0, v0, v1); }
    }
};
struct Epi8 {
    static constexpr bool PERM = true;
    bf16_t* PP; const int* LIST; const LAS int* scnt;
    DI void operator()(const f32x4 (&acc)[2][2][4][2], const Unit& u, int wr, int wc, int fr_, int fq_) const {
        int fr = fr_, fq = fq_; asm volatile("" : "+v"(fr), "+v"(fq));
        const int c0 = (u.pn & 3) * 256 + 32 * wc + 8 * fq, cnt = scnt[u.a0]; bf16_t* O = PP + (size_t)(u.a0 >> 5) * M * 1024;
#pragma unroll
        for (int ai = 0; ai < 2; ++ai)
#pragma unroll
            for (int m = 0; m < 4; ++m) { const int r = ai * 128 + wr * 64 + m * 16 + fr, idx = u.a1 * 256 + r;
                if (idx < cnt) { const int tok = LIST[(size_t)u.a0 * M + idx];
#pragma unroll
                    for (int bj = 0; bj < 2; ++bj) store8(O + (size_t)tok * 1024 + c0 + 128 * bj, acc[ai][bj][m][0], acc[ai][bj][m][1]); }
                asm volatile("" ::: "memory"); }
    }
};


DI void p6_ln1_router(const Ctx& X) {
    const int lane = lane_id(), wave = X.wid, tid = wave * 64 + lane, r = lane & 31, hh = lane >> 5;
    LAS unsigned char* HI = X.lds; LAS unsigned char* LO = X.lds + 65536;
    LAS float* LG = (LAS float*)(X.lds + LDS_LG);
    const float* Y1 = wsp<float>(X, WS_A); float* H = wsp<float>(X, WS_H); bf16_t* HB = wsp<bf16_t>(X, WS_B);
    const bf16_t* WR = wsp<bf16_t>(X, WS_WRT);
    unsigned* CNT = wsp<unsigned>(X, WS_CTL) + CW_CNT; int* LIST = wsp<int>(X, WS_LIST); float* LISTW = wsp<float>(X, WS_LISTW);
    f32x4 gv[4], bv[4];
#pragma unroll
    for (int j = 0; j < 4; ++j) { gv[j] = *(const f32x4*)(X.ln1_g + 4 * lane + 256 * j); bv[j] = *(const f32x4*)(X.ln1_b + 4 * lane + 256 * j); }
    for (int unit = X.bid; unit < M / 32; unit += X.G) {
        *(LAS f32x4*)(LG + tid * 4) = (f32x4){0.f, 0.f, 0.f, 0.f};
#pragma unroll 1
        for (int rr = 0; rr < 4; ++rr) {
            const int rl = wave * 4 + rr, m = unit * 32 + rl;
            const f32x4* yr = (const f32x4*)(Y1 + (size_t)m * D) + lane;
            f32x4 v[4]; float s = 0.f;
#pragma unroll
            for (int j = 0; j < 4; ++j) { v[j] = yr[64 * j]; s += (v[j].x + v[j].y) + (v[j].z + v[j].w); }
            const float mean = wave_sum(s) * (1.f / D); float s2 = 0.f;
#pragma unroll
            for (int j = 0; j < 4; ++j) { v[j] = v[j] - mean; s2 += (v[j].x * v[j].x + v[j].y * v[j].y) + (v[j].z * v[j].z + v[j].w * v[j].w); }
            const float rstd = 1.f / sqrtf(wave_sum(s2) * (1.f / D) + LN_EPS);
#pragma unroll
            for (int j = 0; j < 4; ++j) {
                const f32x4 y = v[j] * rstd * gv[j] + bv[j];
                *((f32x4*)(H + (size_t)m * D) + lane + 64 * j) = y;
                u32x2 hi; hi.x = pk2(y.x, y.y); hi.y = pk2(y.z, y.w);
                *((u32x2*)(HB + (size_t)m * D) + lane + 64 * j) = hi;
                const float l0 = y.x - __uint_as_float(hi.x << 16), l1 = y.y - __uint_as_float(hi.x & 0xffff0000u), l2 = y.z - __uint_as_float(hi.y << 16), l3 = y.w - __uint_as_float(hi.y & 0xffff0000u);
                u32x2 lo; lo.x = pk2(l0, l1); lo.y = pk2(l2, l3);
                const int chunk = (lane >> 1) + 32 * j; const unsigned byte = (unsigned)rl * 2048u + (unsigned)((chunk ^ (rl & 15)) * 16) + 8u * (lane & 1);
                *(LAS u32x2*)(HI + byte) = hi; *(LAS u32x2*)(LO + byte) = lo;
            }
        }
        __syncthreads();
        {
            f32x16 a0, a1;
#pragma unroll
            for (int e = 0; e < 16; ++e) { a0[e] = 0.f; a1[e] = 0.f; }
#pragma unroll
            for (int ks = 0; ks < 8; ++ks) {
                const int ch = 16 * wave + 2 * ks + hh; const unsigned byte = (unsigned)r * 2048u + (unsigned)((ch ^ (r & 15)) * 16);
                const bf16x8 ahi = *(const LAS bf16x8*)(HI + byte), alo = *(const LAS bf16x8*)(LO + byte);
                const size_t ko = (size_t)(128 * wave + 16 * ks + 8 * hh);
                const bf16x8 bh0 = *(const bf16x8*)(WR + (size_t)r * 1024 + ko), bh1 = *(const bf16x8*)(WR + (size_t)(32 + r) * 1024 + ko);
                const bf16x8 bl0 = *(const bf16x8*)(WR + (size_t)(64 + r) * 1024 + ko), bl1 = *(const bf16x8*)(WR + (size_t)(96 + r) * 1024 + ko);
                a0 = __builtin_amdgcn_mfma_f32_32x32x16_bf16(ahi, bh0, a0, 0, 0, 0); a0 = __builtin_amdgcn_mfma_f32_32x32x16_bf16(ahi, bl0, a0, 0, 0, 0); a0 = __builtin_amdgcn_mfma_f32_32x32x16_bf16(alo, bh0, a0, 0, 0, 0);
                a1 = __builtin_amdgcn_mfma_f32_32x32x16_bf16(ahi, bh1, a1, 0, 0, 0); a1 = __builtin_amdgcn_mfma_f32_32x32x16_bf16(ahi, bl1, a1, 0, 0, 0); a1 = __builtin_amdgcn_mfma_f32_32x32x16_bf16(alo, bh1, a1, 0, 0, 0);
            }
#pragma unroll
            for (int e = 0; e < 16; ++e) { const int row = (e & 3) + 8 * (e >> 2) + 4 * hh;
                __hip_atomic_fetch_add(LG + row * 64 + r, a0[e], __ATOMIC_RELAXED, __HIP_MEMORY_SCOPE_WORKGROUP);
                if (r < 4) __hip_atomic_fetch_add(LG + row * 64 + 32 + r, a1[e], __ATOMIC_RELAXED, __HIP_MEMORY_SCOPE_WORKGROUP); }
        }
        __syncthreads();
        if (tid < 32) {
            const LAS float* lg = LG + tid * 64; const int token = unit * 32 + tid;
            float gl[4]; float gmax = -3.4e38f; int gsel = 0;
#pragma unroll
            for (int j = 0; j < 4; ++j) { gl[j] = lg[j] + X.b_grp[j]; if (gl[j] > gmax) { gmax = gl[j]; gsel = j; } }
            float gz = 0.f;
#pragma unroll
            for (int j = 0; j < 4; ++j) gz += expf(gl[j] - gmax);
            const float gw = 1.f / gz;
            float e0 = -3.4e38f, e1 = -3.4e38f; int i0 = 0, i1 = 0;
#pragma unroll
            for (int j = 0; j < 8; ++j) { const float v = lg[4 + gsel * 8 + j] + X.b_rt[gsel * 8 + j];
                if (v > e0) { e1 = e0; i1 = i0; e0 = v; i0 = j; } else if (v > e1) { e1 = v; i1 = j; } }
            const float t = expf(e1 - e0), c0 = gw / (1.f + t), c1 = gw * t / (1.f + t);
            const int s0 = gsel * 8 + i0, s1 = 32 + gsel * 8 + i1;
            const unsigned p0 = __hip_atomic_fetch_add(CNT + s0, 1u, __ATOMIC_RELAXED, __HIP_MEMORY_SCOPE_AGENT);
            const unsigned p1 = __hip_atomic_fetch_add(CNT + s1, 1u, __ATOMIC_RELAXED, __HIP_MEMORY_SCOPE_AGENT);
            LIST[(size_t)s0 * M + p0] = token; LISTW[(size_t)s0 * M + p0] = c0;
            LIST[(size_t)s1 * M + p1] = token; LISTW[(size_t)s1 * M + p1] = c1;
        }
        __syncthreads();
    }
}

DI void moe_prep(const Ctx& X) {
    const int tid = X.wid * 64 + lane_id();
    LAS int* tstart = (LAS int*)(X.lds + LDS_MISC + 64); LAS int* scnt = (LAS int*)(X.lds + LDS_MISC + 512);
    unsigned* CNT = wsp<unsigned>(X, WS_CTL) + CW_CNT;
    if (tid < NSEG) scnt[tid] = (int)__hip_atomic_load(CNT + tid, __ATOMIC_RELAXED, __HIP_MEMORY_SCOPE_AGENT);
    __syncthreads();
    if (tid == 0) { int a = 0; for (int s = 0; s < NSEG; ++s) { tstart[s] = a; a += (scnt[s] + 255) >> 8; } tstart[NSEG] = a; }
    __syncthreads();
}

DI void p9_ln2(const Ctx& X) {
    const int lane = lane_id(), wave = X.wid;
    const int gw = X.bid * 8 + wave, NGW = X.G * 8;
    const float* H = wsp<float>(X, WS_H); const bf16_t* PP0 = wsp<bf16_t>(X, WS_A); const bf16_t* PP1 = PP0 + (size_t)M * 1024;
    f32x4 gv[4], bv[4];
#pragma unroll
    for (int j = 0; j < 4; ++j) { gv[j] = *(const f32x4*)(X.ln2_g + 4 * lane + 256 * j); bv[j] = *(const f32x4*)(X.ln2_b + 4 * lane + 256 * j); }
    for (int m = gw; m < M; m += NGW) {
        f32x4 v[4]; float s = 0.f;
#pragma unroll
        for (int j = 0; j < 4; ++j) {
            const f32x4 hv = *((const f32x4*)(H + (size_t)m * D) + lane + 64 * j);
            const u32x2 a = *((const u32x2*)(PP0 + (size_t)m * D) + lane + 64 * j), b = *((const u32x2*)(PP1 + (size_t)m * D) + lane + 64 * j);
            f32x4 y = hv * ALPHA;
            y.x += __uint_as_float(a.x << 16) + __uint_as_float(b.x << 16); y.y += __uint_as_float(a.x & 0xffff0000u) + __uint_as_float(b.x & 0xffff0000u);
            y.z += __uint_as_float(a.y << 16) + __uint_as_float(b.y << 16); y.w += __uint_as_float(a.y & 0xffff0000u) + __uint_as_float(b.y & 0xffff0000u);
            v[j] = y; s += (y.x + y.y) + (y.z + y.w);
        }
        const float mean = wave_sum(s) * (1.f / D); float s2 = 0.f;
#pragma unroll
        for (int j = 0; j < 4; ++j) { v[j] = v[j] - mean; s2 += (v[j].x * v[j].x + v[j].y * v[j].y) + (v[j].z * v[j].z + v[j].w * v[j].w); }
        const float rstd = 1.f / sqrtf(wave_sum(s2) * (1.f / D) + LN_EPS);
#pragma unroll
        for (int j = 0; j < 4; ++j) *((f32x4*)(X.out + (size_t)m * D) + lane + 64 * j) = v[j] * rstd * gv[j] + bv[j];
    }
}

#define MFMA32(a, b, c) __builtin_amdgcn_mfma_f32_32x32x16_bf16((a), (b), (c), 0, 0, 0)
DI bf16x8 pack8(const f32x16& x, int s) {
    u32x4 p; p.x = pk2(x[8 * s + 0], x[8 * s + 1]); p.y = pk2(x[8 * s + 2], x[8 * s + 3]); p.z = pk2(x[8 * s + 4], x[8 * s + 5]); p.w = pk2(x[8 * s + 6], x[8 * s + 7]);
    return __builtin_bit_cast(bf16x8, p);
}
DI void tr_read8(unsigned addr, bf16x8 (&vf)[4]) {
    s16x4 t0, t1, t2, t3, t4, t5, t6, t7;
    asm volatile("ds_read_b64_tr_b16 %0, %8\n\tds_read_b64_tr_b16 %1, %8 offset:1024\n\tds_read_b64_tr_b16 %2, %8 offset:2048\n\tds_read_b64_tr_b16 %3, %8 offset:3072\n\t"
                 "ds_read_b64_tr_b16 %4, %8 offset:4096\n\tds_read_b64_tr_b16 %5, %8 offset:5120\n\tds_read_b64_tr_b16 %6, %8 offset:6144\n\tds_read_b64_tr_b16 %7, %8 offset:7168\n\ts_waitcnt lgkmcnt(0)"
                 : "=&v"(t0), "=&v"(t1), "=&v"(t2), "=&v"(t3), "=&v"(t4), "=&v"(t5), "=&v"(t6), "=&v"(t7) : "v"(addr) : "memory");
    vf[0] = __builtin_shufflevector(t0, t1, 0, 1, 2, 3, 4, 5, 6, 7); vf[1] = __builtin_shufflevector(t2, t3, 0, 1, 2, 3, 4, 5, 6, 7);
    vf[2] = __builtin_shufflevector(t4, t5, 0, 1, 2, 3, 4, 5, 6, 7); vf[3] = __builtin_shufflevector(t6, t7, 0, 1, 2, 3, 4, 5, 6, 7);
}
DI void softmax_tile(f32x16& s0, f32x16& s1, float& mrun, float& lrun, f32x16& o0, f32x16& o1, bf16x8 (&pf)[4]) {
    float mx = s0[0];
#pragma unroll
    for (int e = 1; e < 16; ++e) mx = fmaxf(mx, s0[e]);
#pragma unroll
    for (int e = 0; e < 16; ++e) mx = fmaxf(mx, s1[e]);
    mx = fmaxf(mx, __shfl_xor(mx, 32));
    const float mn = fmaxf(mrun, mx), alpha = fast_exp2(mrun - mn); mrun = mn;
    float ls = 0.f;
#pragma unroll
    for (int e = 0; e < 16; ++e) { s0[e] = fast_exp2(s0[e] - mn); s1[e] = fast_exp2(s1[e] - mn); ls += s0[e] + s1[e]; }
    lrun = lrun * alpha + ls;
#pragma unroll
    for (int e = 0; e < 16; ++e) { o0[e] *= alpha; o1[e] *= alpha; }
    pf[0] = pack8(s0, 0); pf[1] = pack8(s0, 1); pf[2] = pack8(s1, 0); pf[3] = pack8(s1, 1);
}
DI int next_tile(const int* TS, int j, int qmax) { for (++j; j < 32; ++j) if (TS[j * 4] <= qmax) break; return j; }

DI void mla_unit(const Ctx& X, int b, int h, int qb) {
    const int lane = lane_id(), w = X.wid, tid = w * 64 + lane, r = lane & 31, hh = lane >> 5;
    LAS unsigned char* lds = X.lds; const unsigned ldsb = (unsigned)(uintptr_t)lds;
    const int tok0 = b * SEQ;
    const bf16_t* QM = wsp<bf16_t>(X, WS_QM); const bf16_t* KN = wsp<bf16_t>(X, WS_KN); const bf16_t* VM = wsp<bf16_t>(X, WS_VM); const bf16_t* KR = wsp<bf16_t>(X, WS_KR);
    bf16_t* OA = wsp<bf16_t>(X, WS_B);
    const int* TS = wsp<int>(X, WS_TSTAT) + (size_t)b * 32 * 4;
    const int qrow = tok0 + qb * 256 + w * 32 + r;
    bf16x8 qf[6];
#pragma unroll
    for (int s = 0; s < 6; ++s) qf[s] = *(const bf16x8*)(QM + (size_t)qrow * 768 + h * 96 + 16 * s + 8 * hh);
    const int qc = X.pos[qrow] >> 6;
    int qmin = 0x7fffffff, qmax = -0x7fffffff - 1;
#pragma unroll
    for (int t = 0; t < 4; ++t) { const int a = TS[(qb * 4 + t) * 4], c = TS[(qb * 4 + t) * 4 + 1]; qmin = a < qmin ? a : qmin; qmax = c > qmax ? c : qmax; }
    f32x16 o0, o1;
#pragma unroll
    for (int e = 0; e < 16; ++e) { o0[e] = 0.f; o1[e] = 0.f; }
    float mrun = NEGF, lrun = 0.f;
    const int key_a = tid >> 3, ch_a = tid & 7, key_r = (tid >> 2) & 63, ch_r = tid & 3;
    const unsigned kdst = 192u * key_a + 16u * (ch_a ^ ((key_a >> 2) & 3)), vdst = 12288u + 128u * key_a + 16u * (ch_a ^ (((key_a >> 1) & 1) << 2));
    const unsigned rdst = 192u * key_r + 16u * ((8 + ch_r) ^ ((key_r >> 2) & 3));
    constexpr unsigned BUFB = 20736u;
    const int q4 = (lane & 15) >> 2, p4 = lane & 3, blk = (lane >> 4) & 1, sw = (q4 >> 1) & 1;
    const unsigned vbase = ldsb + 12288u + 128u * (4 * hh + q4) + 16u * (2 * blk + (p4 >> 1)) + 8u * (p4 & 1);
    const unsigned va0 = vbase + 64u * sw, va1 = vbase + 64u * (1 - sw);
    u32x4 rk, rv, rr = {0u, 0u, 0u, 0u}; int rkc = 0;
#define MLA_LOAD(j) do { const size_t t0_ = (size_t)tok0 + (size_t)(j) * 64; rk = *(const u32x4*)(KN + (t0_ + key_a) * 512 + h * 64 + ch_a * 8); rv = *(const u32x4*)(VM + (t0_ + key_a) * 512 + h * 64 + ch_a * 8); \
        if (tid < 256) rr = *(const u32x4*)(KR + (t0_ + key_r) * 32 + ch_r * 8); if (tid < 64) rkc = X.pos[t0_ + tid] >> 6; } while (0)
#define MLA_STORE(bo) do { *(LAS u32x4*)(lds + (bo) + kdst) = rk; *(LAS u32x4*)(lds + (bo) + vdst) = rv; if (tid < 256) *(LAS u32x4*)(lds + (bo) + rdst) = rr; if (tid < 64) *(LAS int*)(lds + (bo) + 20480u + 4u * tid) = rkc; } while (0)
    int j = next_tile(TS, -1, qmax);
    unsigned cur = 0;
    if (j < 32) { MLA_LOAD(j); MLA_STORE(0u); }
    __syncthreads();
    while (j < 32) {
        const int jn = next_tile(TS, j, qmax);
        if (jn < 32) MLA_LOAD(jn);
        const unsigned bo = cur * BUFB;
        f32x16 s0, s1;
#pragma unroll
        for (int e = 0; e < 16; ++e) { s0[e] = 0.f; s1[e] = 0.f; }
#pragma unroll
        for (int ks = 0; ks < 6; ++ks) {
            const unsigned ko = 192u * r + 16u * ((2 * ks + hh) ^ ((r >> 2) & 3));
            const bf16x8 a0 = *(const LAS bf16x8*)(lds + bo + ko), a1 = *(const LAS bf16x8*)(lds + bo + ko + 192u * 32u);
            s0 = MFMA32(a0, qf[ks], s0); s1 = MFMA32(a1, qf[ks], s1);
        }
        if (TS[j * 4 + 1] > qmin) {
#pragma unroll
            for (int g = 0; g < 4; ++g) {
                const i32x4 c0 = *(const LAS i32x4*)(lds + bo + 20480u + 4u * (8 * g + 4 * hh)), c1 = *(const LAS i32x4*)(lds + bo + 20480u + 4u * (32 + 8 * g + 4 * hh));
#pragma unroll
                for (int e = 0; e < 4; ++e) { if (c0[e] > qc) s0[4 * g + e] = NEGF; if (c1[e] > qc) s1[4 * g + e] = NEGF; }
            }
        }
        bf16x8 pf[4];
        softmax_tile(s0, s1, mrun, lrun, o0, o1, pf);
        { bf16x8 vf[4]; tr_read8(va0 + bo, vf);
#pragma unroll
          for (int k = 0; k < 4; ++k) o0 = MFMA32(vf[k], pf[k], o0);
          tr_read8(va1 + bo, vf);
#pragma unroll
          for (int k = 0; k < 4; ++k) o1 = MFMA32(vf[k], pf[k], o1); }
        if (jn < 32) MLA_STORE((cur ^ 1u) * BUFB);
        __syncthreads();
        cur ^= 1u; j = jn;
    }
#undef MLA_LOAD
#undef MLA_STORE
    const float inv = 1.f / (lrun + __shfl_xor(lrun, 32));
    bf16_t* op = OA + (size_t)qrow * 512 + h * 64 + 4 * hh;
#pragma unroll
    for (int g = 0; g < 4; ++g) {
        u32x2 a, c; a.x = pk2(o0[4 * g] * inv, o0[4 * g + 1] * inv); a.y = pk2(o0[4 * g + 2] * inv, o0[4 * g + 3] * inv);
        c.x = pk2(o1[4 * g] * inv, o1[4 * g + 1] * inv); c.y = pk2(o1[4 * g + 2] * inv, o1[4 * g + 3] * inv);
        *(u32x2*)(op + 8 * g) = a; *(u32x2*)(op + 32 + 8 * g) = c;
    }
}

DI int t5_bucket(int rel) { const int n = rel < 0 ? -rel : rel;
    const int large = 8 + (n >= 12) + (n >= 16) + (n >= 23) + (n >= 32) + (n >= 46) + (n >= 64) + (n >= 91);
    return (rel > 0 ? 16 : 0) + (n < 8 ? n : large); }
DI void dsa_attend(const Ctx& X, int b, int qt, int tid, unsigned proc);
DI void dsa_unit(const Ctx& X, int b, int qt) {
    const int lane = lane_id(), w = X.wid, tid = w * 64 + lane, r = lane & 31, hh = lane >> 5;
    LAS unsigned char* lds = X.lds; const unsigned ldsb = (unsigned)(uintptr_t)lds;
    constexpr unsigned L_QIT = 0u  , L_HIST = 17408u, L_MSK = 50176u, L_PRE = 58368u, L_NEED = 58496u, L_BT = 58624u, L_KV = 67072u, KVB = 16640u;
    const int tok0 = b * SEQ, q0 = tok0 + qt * 32;
    const bf16_t* QI = wsp<bf16_t>(X, WS_QI); const bf16_t* KI = wsp<bf16_t>(X, WS_KI); const bf16_t* QB = wsp<bf16_t>(X, WS_QB);
    const bf16_t* KB = wsp<bf16_t>(X, WS_KB); const bf16_t* VB = wsp<bf16_t>(X, WS_VB); const float* WI = wsp<float>(X, WS_WI);
    bf16_t* OB = wsp<bf16_t>(X, WS_B) + (size_t)M * 512;
    const int* TS = wsp<int>(X, WS_TSTAT) + (size_t)b * 32 * 4;
    const int qmax = TS[(qt >> 1) * 4 + 1], posmin_q = TS[(qt >> 1) * 4 + 2];
    unsigned proc = 0u;
    for (int j = 0; j < 32; ++j) proc |= (TS[j * 4] <= qmax ? 1u : 0u) << j;
#pragma unroll
    for (int i = 0; i < 2; ++i) { const int c = tid + 512 * i, row = c >> 5, ch = c & 31;
        *(LAS u32x4*)(lds + L_QIT + row * 528 + ch * 16) = *(const u32x4*)(QI + (size_t)(q0 + row) * 256 + ch * 8); }
    if (tid < 257) { const int bk = t5_bucket(tid - 128);
#pragma unroll
        for (int hd = 0; hd < 8; ++hd) *(LAS float*)(lds + L_BT + 4u * (hd * 260 + tid)) = LOG2E * (X.rel_bias[bk * 8 + hd] - X.rel_bias[15 * 8 + hd]); }
    if (tid < 32) { *(LAS unsigned*)(lds + L_PRE + 4u * tid) = 0u; *(LAS unsigned*)(lds + L_NEED + 4u * tid) = 256u; }
    const int pos_q = X.pos[q0 + r], qc = pos_q >> 6;
    float wq[8];
    { const f32x4 wa = *(const f32x4*)(WI + (size_t)(q0 + r) * 8), wb = *(const f32x4*)(WI + (size_t)(q0 + r) * 8 + 4);
      wq[0] = wa[0]; wq[1] = wa[1]; wq[2] = wa[2]; wq[3] = wa[3]; wq[4] = wb[0]; wq[5] = wb[1]; wq[6] = wb[2]; wq[7] = wb[3]; }
    __syncthreads();
    unsigned keys[8][16];
#pragma unroll
    for (int i = 0; i < 8; ++i) {
        const int jt = w + 8 * i;
        if ((proc >> (jt >> 1)) & 1u) {
            const size_t krow = (size_t)tok0 + jt * 32;
            const bf16x8 ka0 = *(const bf16x8*)(KI + (krow + r) * 32 + 8 * hh), ka1 = *(const bf16x8*)(KI + (krow + r) * 32 + 16 + 8 * hh);
            f32x16 sc;
#pragma unroll
            for (int e = 0; e < 16; ++e) sc[e] = 0.f;
#pragma unroll
            for (int hd = 0; hd < 8; ++hd) {
                f32x16 S;
#pragma unroll
                for (int e = 0; e < 16; ++e) S[e] = 0.f;
                const bf16x8 b0 = *(const LAS bf16x8*)(lds + L_QIT + r * 528 + hh * 16 + hd * 64), b1 = *(const LAS bf16x8*)(lds + L_QIT + r * 528 + hh * 16 + hd * 64 + 32);
                S = MFMA32(ka0, b0, S); S = MFMA32(ka1, b1, S);
#pragma unroll
                for (int e = 0; e < 16; ++e) sc[e] += wq[hd] * fmaxf(S[e], 0.f);
                asm volatile("" : "+v"(sc));
            }
#pragma unroll
            for (int g = 0; g < 4; ++g) {
                const i32x4 pk = *(const i32x4*)(X.pos + krow + 8 * g + 4 * hh);
#pragma unroll
                for (int e = 0; e < 4; ++e) { const int sidx = jt * 32 + 8 * g + 4 * hh + e; const unsigned u = __float_as_uint(sc[4 * g + e]);
                    const unsigned srt = u ^ ((unsigned)((int)u >> 31) | 0x80000000u);
                    keys[i][4 * g + e] = ((pk[e] >> 6) <= qc) ? ((srt & 0xFFFFF800u) | (unsigned)(2047 - sidx)) : 0u; }
            }
        } else {
#pragma unroll
            for (int e = 0; e < 16; ++e) keys[i][e] = 0u;
        }
        asm volatile("" ::: "memory"); __builtin_amdgcn_sched_barrier(0);
    }
#pragma unroll 1
    for (int p = 0; p < 4; ++p) {
        const int shift = 24 - 8 * p;
#pragma unroll
        for (int i = 0; i < 4; ++i) *(LAS u32x4*)(lds + L_HIST + 16u * (tid + 512 * i)) = (u32x4){0u, 0u, 0u, 0u};
        __syncthreads();
        const unsigned pre = *(const LAS unsigned*)(lds + L_PRE + 4u * r);
#pragma unroll
        for (int i = 0; i < 8; ++i) {
            if ((proc >> ((w + 8 * i) >> 1)) & 1u) {
#pragma unroll
                for (int e = 0; e < 16; ++e) { const unsigned k = keys[i][e];
                    const bool c = k != 0u && (p == 0 || (k >> (shift + 8)) == pre);
                    if (c) __hip_atomic_fetch_add((LAS unsigned*)(lds + L_HIST + 4u * (((k >> shift) & 255u) * 32u + r)), 1u, __ATOMIC_RELAXED, __HIP_MEMORY_SCOPE_WORKGROUP); }
            }
        }
        __syncthreads();
        {
            const int ql = lane >> 4, part = lane & 15, q = 4 * w + ql;
            unsigned c[16]; unsigned sum = 0u;
#pragma unroll
            for (int t = 0; t < 16; ++t) { c[t] = *(const LAS unsigned*)(lds + L_HIST + 4u * ((16 * part + t) * 32 + q)); sum += c[t]; }
            unsigned sfx = sum;
#pragma unroll
            for (int d = 1; d < 16; d <<= 1) { const unsigned t = __shfl_down(sfx, d, 16); if (part + d < 16) sfx += t; }
            const unsigned total = __shfl(sfx, lane & ~15);
            const unsigned nd = *(const LAS unsigned*)(lds + L_NEED + 4u * q), pold = *(const LAS unsigned*)(lds + L_PRE + 4u * q);
            const unsigned excl = sfx - sum;
            if (nd != 0u) {
                if (total < nd) { if (part == 0) { *(LAS unsigned*)(lds + L_NEED + 4u * q) = 0u; *(LAS unsigned*)(lds + L_PRE + 4u * q) = 0xFFFFFFFFu; } }
                else if (excl < nd && nd <= sfx) {
                    unsigned run = excl, bsel = 0u, ndn = 0u; bool found = false;
#pragma unroll
                    for (int t = 15; t >= 0; --t) { if (!found && run + c[t] >= nd) { found = true; bsel = (unsigned)(16 * part + t); ndn = nd - run; } if (!found) run += c[t]; }
                    *(LAS unsigned*)(lds + L_PRE + 4u * q) = (p == 0 ? 0u : (pold << 8)) | bsel; *(LAS unsigned*)(lds + L_NEED + 4u * q) = ndn;
                }
            }
        }
        __syncthreads();
    }
    {
        const unsigned nd = *(const LAS unsigned*)(lds + L_NEED + 4u * r), pr = *(const LAS unsigned*)(lds + L_PRE + 4u * r);
        const unsigned T = nd == 0u ? 0u : pr, thr = T > 2048u ? T : 2048u;
#pragma unroll
        for (int i = 0; i < 8; ++i) { const int jt = w + 8 * i; unsigned bits = 0u;
#pragma unroll
            for (int e = 0; e < 16; ++e) bits |= (keys[i][e] >= thr ? 1u : 0u) << e;
            *(LAS unsigned short*)(lds + L_MSK + 2u * ((jt * 2 + hh) * 32 + r)) = (unsigned short)bits; }
    }
    __syncthreads();
    dsa_attend(X, b, qt, X.wid * 64 + lane_id(), proc);
}
DI void dsa_attend(const Ctx& X, int b, int qt, int tid, unsigned proc) {
    const int lane = tid & 63, w = X.wid, r = lane & 31, hh = lane >> 5;
    LAS unsigned char* lds = X.lds; const unsigned ldsb = (unsigned)(uintptr_t)lds;
    constexpr unsigned L_MSK = 50176u, L_BT = 58624u, L_KV = 67072u, KVB = 16640u;
    const int tok0 = b * SEQ, q0 = tok0 + qt * 32;
    const bf16_t* QB = wsp<bf16_t>(X, WS_QB); const bf16_t* KB = wsp<bf16_t>(X, WS_KB); const bf16_t* VB = wsp<bf16_t>(X, WS_VB);
    bf16_t* OB = wsp<bf16_t>(X, WS_B) + (size_t)M * 512;
    const int* TS = wsp<int>(X, WS_TSTAT) + (size_t)b * 32 * 4;
    const int qmax = TS[(qt >> 1) * 4 + 1], posmin_q = TS[(qt >> 1) * 4 + 2];
    const int pos_q = X.pos[q0 + r];
    (void)proc;
    bf16x8 qf[4];
#pragma unroll
    for (int s = 0; s < 4; ++s) qf[s] = *(const bf16x8*)(QB + (size_t)(q0 + r) * 512 + w * 64 + 16 * s + 8 * hh);
    f32x16 o0, o1;
#pragma unroll
    for (int e = 0; e < 16; ++e) { o0[e] = 0.f; o1[e] = 0.f; }
    float mrun = NEGF, lrun = 0.f;
    const int key_a = tid >> 3, ch_a = tid & 7;
    const unsigned kdst = 128u * key_a + 16u * (ch_a ^ ((key_a >> 1) & 7)), vdst = 8192u + 128u * key_a + 16u * (ch_a ^ (((key_a >> 1) & 1) << 2));
    const int q4 = (lane & 15) >> 2, p4 = lane & 3, blk = (lane >> 4) & 1, sw = (q4 >> 1) & 1;
    const unsigned vbase = ldsb + L_KV + 8192u + 128u * (4 * hh + q4) + 16u * (2 * blk + (p4 >> 1)) + 8u * (p4 & 1);
    const unsigned va0 = vbase + 64u * sw, va1 = vbase + 64u * (1 - sw);
    u32x4 rk, rv; int rp = 0;
#define DSA_LOAD(j) do { const size_t t0_ = (size_t)tok0 + (size_t)(j) * 64; rk = *(const u32x4*)(KB + (t0_ + key_a) * 64 + ch_a * 8); rv = *(const u32x4*)(VB + (t0_ + key_a) * 64 + ch_a * 8); \
        if (tid < 64) rp = X.pos[t0_ + tid]; } while (0)
#define DSA_STORE(bo) do { *(LAS u32x4*)(lds + L_KV + (bo) + kdst) = rk; *(LAS u32x4*)(lds + L_KV + (bo) + vdst) = rv; if (tid < 64) *(LAS int*)(lds + L_KV + (bo) + 16384u + 4u * tid) = rp; } while (0)
    int j = next_tile(TS, -1, qmax);
    unsigned cur = 0;
    if (j < 32) { DSA_LOAD(j); DSA_STORE(0u); }
    __syncthreads();
    while (j < 32) {
        const int jn = next_tile(TS, j, qmax);
        if (jn < 32) DSA_LOAD(jn);
        const unsigned bo = cur * KVB;
        f32x16 s0, s1;
#pragma unroll
        for (int e = 0; e < 16; ++e) { s0[e] = 0.f; s1[e] = 0.f; }
#pragma unroll
        for (int ks = 0; ks < 4; ++ks) {
            const unsigned ko = 128u * r + 16u * ((2 * ks + hh) ^ ((r >> 1) & 7));
            const bf16x8 a0 = *(const LAS bf16x8*)(lds + L_KV + bo + ko), a1 = *(const LAS bf16x8*)(lds + L_KV + bo + ko + 128u * 32u);
            s0 = MFMA32(a0, qf[ks], s0); s1 = MFMA32(a1, qf[ks], s1);
        }
        if (TS[j * 4 + 3] - posmin_q > -128) {
#pragma unroll
            for (int g = 0; g < 4; ++g) {
                const i32x4 c0 = *(const LAS i32x4*)(lds + L_KV + bo + 16384u + 4u * (8 * g + 4 * hh)), c1 = *(const LAS i32x4*)(lds + L_KV + bo + 16384u + 4u * (32 + 8 * g + 4 * hh));
#pragma unroll
                for (int e = 0; e < 4; ++e) {
                    int d0 = c0[e] - pos_q, d1 = c1[e] - pos_q; d0 = d0 < -128 ? -128 : (d0 > 128 ? 128 : d0); d1 = d1 < -128 ? -128 : (d1 > 128 ? 128 : d1);
                    s0[4 * g + e] += *(const LAS float*)(lds + L_BT + 4u * (w * 260 + d0 + 128)); s1[4 * g + e] += *(const LAS float*)(lds + L_BT + 4u * (w * 260 + d1 + 128));
                }
            }
        }
        {
            const unsigned m0 = *(const LAS unsigned short*)(lds + L_MSK + 2u * (((2 * j) * 2 + hh) * 32 + r)), m1 = *(const LAS unsigned short*)(lds + L_MSK + 2u * (((2 * j + 1) * 2 + hh) * 32 + r));
#pragma unroll
            for (int e = 0; e < 16; ++e) { if (!((m0 >> e) & 1u)) s0[e] = NEGF; if (!((m1 >> e) & 1u)) s1[e] = NEGF; }
        }
        bf16x8 pf[4];
        softmax_tile(s0, s1, mrun, lrun, o0, o1, pf);
        { bf16x8 vf[4]; tr_read8(va0 + bo, vf);
#pragma unroll
          for (int k = 0; k < 4; ++k) o0 = MFMA32(vf[k], pf[k], o0);
          tr_read8(va1 + bo, vf);
#pragma unroll
          for (int k = 0; k < 4; ++k) o1 = MFMA32(vf[k], pf[k], o1); }
        if (jn < 32) DSA_STORE((cur ^ 1u) * KVB);
        __syncthreads();
        cur ^= 1u; j = jn;
    }
#undef DSA_LOAD
#undef DSA_STORE
    const float inv = 1.f / (lrun + __shfl_xor(lrun, 32));
    bf16_t* op = OB + (size_t)(q0 + r) * 512 + w * 64 + 4 * hh;
#pragma unroll
    for (int g = 0; g < 4; ++g) {
        u32x2 a, c; a.x = pk2(o0[4 * g] * inv, o0[4 * g + 1] * inv); a.y = pk2(o0[4 * g + 2] * inv, o0[4 * g + 3] * inv);
        c.x = pk2(o1[4 * g] * inv, o1[4 * g + 1] * inv); c.y = pk2(o1[4 * g + 2] * inv, o1[4 * g + 3] * inv);
        *(u32x2*)(op + 8 * g) = a; *(u32x2*)(op + 32 + 8 * g) = c;
    }
    __syncthreads();
}

constexpr int N_PHASES = 10;
template <int PHM>
__global__ void __launch_bounds__(512, 2) fwd_kernel(Args args) {
    extern __shared__ __attribute__((aligned(16))) unsigned char lds_raw[];
    Ctx X;
    X.x = (const float*)args.in[0]; X.pos = (const int*)args.in[1]; X.ln0_g = (const float*)args.in[2]; X.ln0_b = (const float*)args.in[3]; X.w_in = (const float*)args.in[4];
    X.q_norm_g = (const float*)args.in[5]; X.w_uq = (const float*)args.in[6]; X.kv_norm_g = (const float*)args.in[7]; X.w_uk = (const float*)args.in[8]; X.w_uv = (const float*)args.in[9];
    X.rel_bias = (const float*)args.in[10]; X.w_up_a = (const float*)args.in[11]; X.w_up_b = (const float*)args.in[12]; X.w_gate = (const float*)args.in[13]; X.b_gate = (const float*)args.in[14];
    X.w_o = (const float*)args.in[15]; X.ln1_g = (const float*)args.in[16]; X.ln1_b = (const float*)args.in[17]; X.w_grp = (const float*)args.in[18]; X.b_grp = (const float*)args.in[19];
    X.w_rt = (const float*)args.in[20]; X.b_rt = (const float*)args.in[21]; X.w_eg = (const float*)args.in[22]; X.w_eu = (const float*)args.in[23]; X.w_ed = (const float*)args.in[24];
    X.ln2_g = (const float*)args.in[25]; X.ln2_b = (const float*)args.in[26];
    X.out = args.out; X.ws = args.ws; X.lds = (LAS unsigned char*)lds_raw; X.G = gridDim.x; X.bid = blockIdx.x; X.wid = __builtin_amdgcn_readfirstlane((int)(threadIdx.x >> 6));
    if (threadIdx.x < 16) ((LAS unsigned*)(X.lds + LDS_MISC))[threadIdx.x] = 0u;
    __syncthreads();
    const int lo = args.ph_lo, hi = args.ph_hi;
    XcdBarrier bar; bar.bar = wsp<unsigned>(X, WS_CTL) + CW_BAR; bar.x = 0; bar.st = nullptr;
    if (hi - lo > 1) bar = xcd_barrier_post(wsp<unsigned>(X, WS_CTL) + CW_BAR, (volatile LAS unsigned*)(X.lds + LDS_MISC));
#define IN(k) (((PHM >> (k)) & 1) && lo <= (k) && (k) < hi)
#define SEAM(k) do { if (IN(k) && IN((k) + 1)) xcd_barrier(bar); } while (0)

    if (IN(0)) { p0_prologue(X); }
    SEAM(0);
#if DBG_STAGE >= 2
    if (IN(1)) {
        pg8::Gemm g{wsp<bf16_t>(X, WS_B), wsp<bf16_t>(X, WS_WT1), 1024}; pg8::StaticOrder S; S.init(M, NW1, X.G, X.bid);
        Epi1 E{wsp<bf16_t>(X, WS_CQ), wsp<bf16_t>(X, WS_CKV), wsp<bf16_t>(X, WS_KR), wsp<bf16_t>(X, WS_KI), wsp<bf16_t>(X, WS_KB), wsp<bf16_t>(X, WS_VB), wsp<bf16_t>(X, WS_QB), wsp<bf16_t>(X, WS_QI),
               wsp<bf16_t>(X, WS_A), wsp<float>(X, WS_WI), wsp<float>(X, WS_SSQ), wsp<float>(X, WS_ROPE), X.b_gate};
        pg8::gemm_phase<Epi1, pg8::StaticOrder, true, false>(X.lds, g, S, E, X.wid);
    }
    SEAM(1);
    if (IN(2)) {
        { pg8::Gemm g{wsp<bf16_t>(X, WS_CKV), wsp<bf16_t>(X, WS_WUKVT), 128}; pg8::StaticOrder S; S.init(M, 1024, X.G, X.bid);
          Epi3 E{wsp<bf16_t>(X, WS_KN), wsp<bf16_t>(X, WS_VM), wsp<float>(X, WS_SSQ)};
          pg8::gemm_phase<Epi3, pg8::StaticOrder, true, false>(X.lds, g, S, E, X.wid); }
        { pg8::Gemm g{wsp<bf16_t>(X, WS_CQ), wsp<bf16_t>(X, WS_WUQT), 256}; pg8::StaticOrder S; S.init(M, 768, X.G, X.bid);
          Epi2 E{wsp<bf16_t>(X, WS_QM), wsp<float>(X, WS_SSQ), wsp<float>(X, WS_ROPE)};
          pg8::gemm_phase<Epi2, pg8::StaticOrder, true, false>(X.lds, g, S, E, X.wid); }
    }
    SEAM(2);
    if (IN(3)) {
        for (int i = 0;; ++i) { const long L = (long)i * X.G + X.bid; if (L >= 1024) break; const int c = (int)(L & 255), ii = (int)(L >> 8);
            const int bh = c >> 1; const int tab[2][4] = {{7, 0, 5, 2}, {6, 1, 4, 3}}; int qb = tab[0][0];
#pragma unroll
            for (int a = 0; a < 2; ++a)
#pragma unroll
                for (int t = 0; t < 4; ++t) if (a == (c & 1) && t == ii) qb = tab[a][t];
#ifndef NO_MLA
            mla_unit(X, bh >> 3, bh & 7, qb);
#endif
        }
        for (int i = 0;; ++i) { const long L = (long)i * X.G + X.bid; if (L >= 1024) break; const int c = (int)(L & 255), ii = (int)(L >> 8);
            const int b = c >> 4, idx = c & 15; const int qt = ii == 0 ? 63 - idx : (ii == 1 ? idx : (ii == 2 ? 47 - idx : 16 + idx));
#ifndef NO_DSA
            dsa_unit(X, b, qt);
#endif
        }
    }
    SEAM(3);
    if (IN(4)) {
        pg8::Gemm g{wsp<bf16_t>(X, WS_B), wsp<bf16_t>(X, WS_WUPT), 512}; PairOrder S{X.G, X.bid};
        Epi4 E{wsp<bf16_t>(X, WS_MIXPRE), wsp<bf16_t>(X, WS_A)};
        pg8::gemm_phase<Epi4, PairOrder, true, false>(X.lds, g, S, E, X.wid);
    }
    SEAM(4);
    if (IN(5)) {
        pg8::Gemm g{wsp<bf16_t>(X, WS_MIXPRE), wsp<bf16_t>(X, WS_WOT), 1024}; pg8::StaticOrder S; S.init(M, 1024, X.G, X.bid);
        Epi5 E{wsp<float>(X, WS_A), X.x, wsp<float>(X, WS_STATS0), X.ln0_g, X.ln0_b};
        pg8::gemm_phase<Epi5, pg8::StaticOrder, true, false>(X.lds, g, S, E, X.wid);
    }
    SEAM(5);
#endif
    if (IN(6)) { p6_ln1_router(X); }
    SEAM(6);
    if (IN(7)) {
        moe_prep(X);
        const LAS int* tstart = (const LAS int*)(X.lds + LDS_MISC + 64); const LAS int* scnt = (const LAS int*)(X.lds + LDS_MISC + 512);
        pg8::Gemm g{wsp<bf16_t>(X, WS_B), wsp<bf16_t>(X, WS_WEGUT), 1024}; MoeOrder S{tstart, scnt, wsp<int>(X, WS_LIST), 2048, 2, X.G, X.bid, __builtin_amdgcn_readfirstlane(tstart[NSEG])};
        Epi7 E{wsp<bf16_t>(X, WS_HID), wsp<float>(X, WS_LISTW), scnt};
        pg8::gemm_phase<Epi7, MoeOrder, true, true>(X.lds, g, S, E, X.wid);
    }
    SEAM(7);
    if (IN(8)) {
        moe_prep(X);
        const LAS int* tstart = (const LAS int*)(X.lds + LDS_MISC + 64); const LAS int* scnt = (const LAS int*)(X.lds + LDS_MISC + 512);
        pg8::Gemm g{wsp<bf16_t>(X, WS_HID), wsp<bf16_t>(X, WS_WEDT), 256}; MoeOrder S{tstart, scnt, wsp<int>(X, WS_LIST), 0, 4, X.G, X.bid, __builtin_amdgcn_readfirstlane(tstart[NSEG])};
        Epi8 E{wsp<bf16_t>(X, WS_A), wsp<int>(X, WS_LIST), scnt};
        pg8::gemm_phase<Epi8, MoeOrder, true, false>(X.lds, g, S, E, X.wid);
    }
    SEAM(8);
    if (IN(9)) { p9_ln2(X); }
#undef IN
#undef SEAM
}

#ifndef PH_MASK
#define PH_MASK 0x3ff
#endif
template <int PHM> static bool setup_kernel(int& per_cu) {
    if (hipFuncSetAttribute((const void*)fwd_kernel<PHM>, hipFuncAttributeMaxDynamicSharedMemorySize, LDS_BYTES) != hipSuccess) return false;
    if (hipOccupancyMaxActiveBlocksPerMultiprocessor(&per_cu, (const void*)fwd_kernel<PHM>, 512, LDS_BYTES) != hipSuccess) per_cu = 0;
    (void)hipGetLastError(); return true;
}
template <int P> static void launch_phase(int grid, hipStream_t stream, Args a) {
    if (!((PH_MASK >> P) & 1)) return;
    a.ph_lo = P; a.ph_hi = P + 1;
    hipLaunchKernelGGL(fwd_kernel<(1 << P)>, dim3(grid), dim3(512), LDS_BYTES, stream, a);
}
extern "C" void kernel_launch(void* const* d_in, const int* in_sizes, int n_in, void* d_out, int out_size, void* d_ws, size_t ws_size, hipStream_t stream) {
    static int grid = 0;
    if (grid == 0) {
        if (n_in != 27 || in_sizes[0] != M * D || out_size != M * D || ws_size < WS_END) { fprintf(stderr, "kernel_launch: unexpected shapes (n_in %d, ws %zu); nothing launched\n", n_in, ws_size); grid = -1; return; }
        int dev = 0, cus = 0, per_cu = 0; bool ok = true;
        if (hipGetDevice(&dev) != hipSuccess || hipDeviceGetAttribute(&cus, hipDeviceAttributeMultiprocessorCount, dev) != hipSuccess) { grid = -1; return; }
#if N_LAUNCH_MODE == 1
        ok = setup_kernel<PH_MASK>(per_cu);
#else
        ok = setup_kernel<1>(per_cu) && setup_kernel<2>(per_cu) && setup_kernel<4>(per_cu) && setup_kernel<8>(per_cu) && setup_kernel<16>(per_cu) && setup_kernel<32>(per_cu) &&
             setup_kernel<64>(per_cu) && setup_kernel<128>(per_cu) && setup_kernel<256>(per_cu) && setup_kernel<512>(per_cu);
#endif
        if (!ok) { fprintf(stderr, "kernel_launch: hipFuncSetAttribute failed\n"); grid = -1; return; }
        if (per_cu < 1) fprintf(stderr, "kernel_launch: occupancy query says %d\n", per_cu);
        grid = cus;
    }
    if (grid < 0) return;
    if (hipMemsetAsync((char*)d_ws + WS_CTL, 0, CTL_ZERO_BYTES, stream) != hipSuccess) return;
    Args a{};
    for (int i = 0; i < 27; ++i) a.in[i] = d_in[i];
    a.out = (float*)d_out; a.ws = (unsigned char*)d_ws;
#if N_LAUNCH_MODE == 1
    a.ph_lo = 0; a.ph_hi = N_PHASES;
    hipLaunchKernelGGL(fwd_kernel<PH_MASK>, dim3(grid), dim3(512), LDS_BYTES, stream, a);
#else
    launch_phase<0>(grid, stream, a);
#if DBG_STAGE >= 2
    launch_phase<1>(grid, stream, a); launch_phase<2>(grid, stream, a); launch_phase<3>(grid, stream, a); launch_phase<4>(grid, stream, a); launch_phase<5>(grid, stream, a);
#endif
    launch_phase<6>(grid, stream, a); launch_phase<7>(grid, stream, a); launch_phase<8>(grid, stream, a); launch_phase<9>(grid, stream, a);
#endif
}
```

```cpp
#include <hip/hip_runtime.h>
#include <cstdio>
#include <cstdint>

#ifndef N_LAUNCH_MODE
#define N_LAUNCH_MODE 1
#endif
#ifndef DBG_STAGE
#define DBG_STAGE 2
#endif

#define LAS __attribute__((address_space(3)))
#define GAS __attribute__((address_space(1)))
typedef unsigned short bf16_t;
typedef short bf16x8 __attribute__((ext_vector_type(8)));
typedef short s16x4 __attribute__((ext_vector_type(4)));
typedef float f32x2 __attribute__((ext_vector_type(2)));
typedef float f32x4 __attribute__((ext_vector_type(4)));
typedef float f32x16 __attribute__((ext_vector_type(16)));
typedef unsigned u32x2 __attribute__((ext_vector_type(2)));
typedef unsigned u32x4 __attribute__((ext_vector_type(4)));
typedef int i32x4 __attribute__((ext_vector_type(4)));
typedef __bf16 bf16x2_t __attribute__((ext_vector_type(2)));
#define DI __device__ __forceinline__

constexpr int BATCH = 16, SEQ = 2048, D = 1024, M = BATCH * SEQ;
constexpr int NW1 = 3584;
constexpr int NSEG = 64;
constexpr int MAXTILES = 320;
constexpr float LN_EPS = 1e-5f, RMS_EPS = 1e-6f;
constexpr float ALPHA = 1.189207115002721f;
constexpr float LOG2E = 1.4426950408889634f;
constexpr float NEGF = -1e30f;

constexpr size_t MiB = 1u << 20;
constexpr size_t WS_CTL = 0, CTL_ZERO_BYTES = 1 * MiB;
constexpr size_t WS_WT1 = 1 * MiB;
constexpr size_t WS_WUQT = 8 * MiB;
constexpr size_t WS_WUKVT = WS_WUQT + 768 * 256 * 2;
constexpr size_t WS_WRT = WS_WUKVT + 1024 * 128 * 2;
constexpr size_t WS_WUPT = 9 * MiB;
constexpr size_t WS_WOT = 11 * MiB;
constexpr size_t WS_WEGUT = 13 * MiB;
constexpr size_t WS_WEDT = 45 * MiB;
constexpr size_t WS_STATS0 = 61 * MiB;
constexpr size_t WS_SSQ = WS_STATS0 + (size_t)M * 8;
constexpr size_t WS_TSTAT = WS_SSQ + (size_t)M * 32;
constexpr size_t WS_TOKINFO = 63 * MiB;
constexpr size_t WS_A = 64 * MiB;
constexpr size_t WS_B = 192 * MiB;
constexpr size_t WS_C = 256 * MiB;
constexpr size_t WS_Dr = 384 * MiB;
constexpr size_t WS_END = 512 * MiB;
constexpr size_t WS_QB = WS_C, WS_QI = WS_QB + 32 * MiB, WS_CQ = WS_QI + 16 * MiB, WS_CKV = WS_CQ + 16 * MiB, WS_KB = WS_CKV + 8 * MiB, WS_VB = WS_KB + 4 * MiB,
                 WS_KR = WS_VB + 4 * MiB, WS_KI = WS_KR + 2 * MiB, WS_WI = WS_KI + 2 * MiB;
constexpr size_t WS_H = WS_C;
constexpr size_t WS_QM = WS_Dr, WS_KN = WS_QM + 48 * MiB, WS_VM = WS_KN + 32 * MiB;
constexpr size_t WS_MIXPRE = WS_Dr;
constexpr size_t WS_HID = WS_Dr + 64 * MiB;
constexpr size_t WS_LIST = WS_Dr + 104 * MiB;
constexpr size_t WS_LISTW = WS_Dr + 112 * MiB;
constexpr size_t WS_ROPE = WS_Dr + 120 * MiB;
constexpr int CW_BAR = 4096;
constexpr int CW_CNT = 16384;

DI unsigned pk2(float lo, float hi) { f32x2 v = {lo, hi}; bf16x2_t r = __builtin_convertvector(v, bf16x2_t); return __builtin_bit_cast(unsigned, r); }
DI float bf2f(unsigned short b) { return __uint_as_float((unsigned)b << 16); }
DI float wave_sum(float v) {
#pragma unroll
    for (int o = 1; o < 64; o <<= 1) v += __shfl_xor(v, o);
    return v;
}
DI int wave_min_i(int v) {
#pragma unroll
    for (int o = 1; o < 64; o <<= 1) { const int t = __shfl_xor(v, o); v = t < v ? t : v; }
    return v;
}
DI int wave_max_i(int v) {
#pragma unroll
    for (int o = 1; o < 64; o <<= 1) { const int t = __shfl_xor(v, o); v = t > v ? t : v; }
    return v;
}
DI int lane_id() { int l; asm volatile("v_mbcnt_lo_u32_b32 %0, -1, 0\n\tv_mbcnt_hi_u32_b32 %0, -1, %0" : "=v"(l)); return l; }
DI float fast_exp2(float x) { return __builtin_amdgcn_exp2f(x); }
DI float fast_rcp(float x) { return __builtin_amdgcn_rcpf(x); }
DI float sigmoidf_fast(float v) { return fast_rcp(1.0f + fast_exp2(-v * LOG2E)); }
DI void rope_sincos(int pos, int j, float& sn, float& cs) {
    const double invd[16] = {1.0, 0.5623413251903491, 0.31622776601683794, 0.1778279410038923, 0.1, 0.05623413251903491, 0.03162277660168379, 0.01778279410038923,
                             0.01, 0.005623413251903491, 0.0031622776601683794, 0.001778279410038923, 0.001, 0.0005623413251903491, 0.00031622776601683794, 0.0001778279410038923};
    double inv = invd[0];
#pragma unroll
    for (int t = 1; t < 16; ++t) inv = (j == t) ? invd[t] : inv;
    const double rev = (double)pos * (double)(float)inv * 0.15915494309189535;
    const float fr = (float)(rev - __builtin_floor(rev));
    sn = __builtin_amdgcn_sinf(fr); cs = __builtin_amdgcn_cosf(fr);
}

#define XB_TMO      128
#define XB_XCNT(j)  (256  + 64 * (j))
#define XB_XSUB(j)  (1280 + 64 * (j))
#define XB_XGEN(j)  (2304 + 64 * (j))
#define XB_TOP      3328
#define XB_TOPGEN   3392
#define XCD_BAR_WORDS 3456
#define XB_SPIN_CAP (1u << 18)
DI unsigned xb_ld(unsigned* p)              { return __hip_atomic_load(p, __ATOMIC_RELAXED, __HIP_MEMORY_SCOPE_AGENT); }
DI unsigned xb_add(unsigned* p, unsigned v) { return __hip_atomic_fetch_add(p, v, __ATOMIC_RELAXED, __HIP_MEMORY_SCOPE_AGENT); }
DI unsigned xb_xcc_id() { return (unsigned)__builtin_amdgcn_s_getreg((3 << 11) | 20) & 0xFu; }
#define XB_SPIN(cond, bar) do { unsigned _sp = 0; while (cond) { __builtin_amdgcn_s_sleep(1); \
    if ((++_sp & 255u) == 0u) { if (xb_ld(&(bar)[XB_TMO])) break; if (_sp > XB_SPIN_CAP) { atomicAdd(&(bar)[XB_TMO], 1u); break; } } } } while (0)
struct XcdBarrier { unsigned* bar; unsigned x; volatile LAS unsigned* st; };
DI XcdBarrier xcd_barrier_post(unsigned* bar, volatile LAS unsigned* st) {
    XcdBarrier b; b.bar = bar; b.x = xb_xcc_id(); b.st = st;
    if (threadIdx.x == 0) (void)xb_add(&bar[XB_XCNT(b.x)], 1u);
    return b;
}
DI void xcd_barrier_complete(unsigned* bar, unsigned x, unsigned& nloc, unsigned& nx) {
    const unsigned G = gridDim.x * gridDim.y * gridDim.z;
    unsigned sum, cnt, mine, sp = 0u;
    for (;;) {
        sum = 0u; cnt = 0u; mine = 0u;
#pragma unroll
        for (unsigned j = 0; j < 16; ++j) { const unsigned c = xb_ld(&bar[XB_XCNT(j)]); sum += c; cnt += (c > 0u) ? 1u : 0u; mine = (j == x) ? c : mine; }
        if (sum == G) break;
        __builtin_amdgcn_s_sleep(1);
        if ((++sp & 255u) == 0u) { if (xb_ld(&bar[XB_TMO])) break; if (sp > XB_SPIN_CAP) { atomicAdd(&bar[XB_TMO], 1u); break; } }
    }
    nloc = mine > 0u ? mine : 1u; nx = cnt > 0u ? cnt : 1u;
}
DI void xcd_barrier(const XcdBarrier& b) {
    asm volatile("s_waitcnt vmcnt(0)" ::: "memory");
    __syncthreads();
    if (threadIdx.x == 0) {
        unsigned* bar = b.bar;
        __builtin_amdgcn_s_waitcnt(0);
        unsigned nloc = b.st[0], nx = b.st[1];
        if (nloc == 0u) { xcd_barrier_complete(bar, b.x, nloc, nx); b.st[0] = nloc; b.st[1] = nx; }
        const unsigned old = xb_add(&bar[XB_XSUB(b.x)], 1u);
        const unsigned gen = old / nloc;
        if (old + 1u == (gen + 1u) * nloc) {
            __builtin_amdgcn_fence(__ATOMIC_RELEASE, "agent");
            asm volatile("s_waitcnt vmcnt(0)" ::: "memory");
            const unsigned og = xb_add(&bar[XB_TOP], 1u);
            const unsigned tg = og / nx;
            if (og + 1u == (tg + 1u) * nx) xb_add(&bar[XB_TOPGEN], 1u);
            else XB_SPIN(xb_ld(&bar[XB_TOPGEN]) == tg, bar);
            __builtin_amdgcn_fence(__ATOMIC_ACQUIRE, "agent");
            xb_add(&bar[XB_XGEN(b.x)], 1u);
            asm volatile("s_waitcnt vmcnt(0)" ::: "memory");
        } else {
            XB_SPIN(xb_ld(&bar[XB_XGEN(b.x)]) == gen, bar);
            __builtin_amdgcn_fence(__ATOMIC_ACQUIRE, "agent");
            asm volatile("s_waitcnt vmcnt(0)" ::: "memory");
        }
    }
    __syncthreads();
}

namespace pg8 {
constexpr int BM = 256, BK = 64, HALF = 128, HTB = HALF * BK * 2, STAGE_BYTES = 8 * HTB, NXCD = 8, WGM = 8;
__host__ __device__ __forceinline__ int lds_byte(int r, int c) { const int st = (r >> 4) * 2 + (c >> 5), rr = r & 15, cc = c & 31, ob = rr * 64 + cc * 2; return st * 1024 + (ob ^ (((ob >> 9) & 1) << 5)); }
__host__ __device__ __forceinline__ void stage_rc(int b, int& R, int& C) { const int st = b / 1024, sb = b % 1024, swz = sb ^ (((sb >> 9) & 1) << 5); R = (st >> 1) * 16 + swz / 64; C = (st & 1) * 32 + (swz % 64) / 2; }
__host__ __device__ __forceinline__ int perm32(int rho) { const int n = rho >> 4, i = rho & 15; return 8 * (i >> 2) + 4 * n + (i & 3); }
struct Unit { int pm, pn, a0, a1; };
struct Gemm { const bf16_t* A; const bf16_t* Bt; int K; };

DI void tile_of(int L, int nM, int nN, int& pm, int& pn) {
    const int nwg = nM * nN; int wgid = L;
    { const int q = nwg / NXCD, r = nwg % NXCD, xcd = wgid % NXCD, off = wgid / NXCD; wgid = (xcd < r ? xcd * (q + 1) : r * (q + 1) + (xcd - r) * q) + off; }
    const int nig = WGM * nN, gid = wgid / nig, fm = gid * WGM, gsz = (nM - fm) < WGM ? (nM - fm) : WGM;
    pm = fm + ((wgid % nig) % gsz); pn = (wgid % nig) / gsz;
}
struct StaticOrder {
    int nM, nN, nwg, G, c;
    DI void init(int Mrows, int N, int G_, int c_) { nM = Mrows / BM; nN = N / BM; nwg = nM * nN; G = G_; c = c_; }
    DI bool next(int i, Unit& u) const {
        const long L = (long)i * G + c; if (L >= nwg) return false;
        tile_of((int)L, nM, nN, u.pm, u.pn); u.a0 = 0; u.a1 = 0; return true;
    }
    DI unsigned arow(const Unit&, int) const { return 0u; }
};

template <class Epi, class Sched, bool ALIGN_EPI, bool GATHER>
DI void gemm_phase(LAS unsigned char* lds, const Gemm g, const Sched& S, const Epi& E, int wid) {
    const int lane = lane_id(), tid = wid * 64 + lane, wr = wid >> 2, wc = wid & 3, fr = lane & 15, fq = lane >> 4;
    int K = g.K; asm volatile("" : "+s"(K));
    const int nt = K / BK;
    unsigned voffA[2], voffB[2]; int RA[2];
#pragma unroll
    for (int i = 0; i < 2; ++i) { int R, C; stage_rc(tid * 16 + i * 8192, R, C); const int Rb = Epi::PERM ? ((R & ~31) + perm32(R & 31)) : R;
        voffA[i] = GATHER ? (unsigned)(C * 2) : (unsigned)(R * K + C) * 2u; voffB[i] = (unsigned)(Rb * K + C) * 2u; RA[i] = R; }
    const size_t kstep = (size_t)(BK * 2);
    const size_t hstep = (size_t)HALF * K * 2;
    const size_t tstep = 2 * hstep;
    const unsigned ldsw = (unsigned)wid * 1024u;
    const int aoff = lds_byte(wr * 64 + fr, fq * 8), boff = lds_byte(wc * 32 + fr, fq * 8);
#define PG8_SA(b, h) (((b) * 2 + (h)) * HTB)
#define PG8_SB(b, h) ((4 + (b) * 2 + (h)) * HTB)
#define PG8_STAGE(bufoff, gbase, voff) do { _Pragma("unroll") for (int _i = 0; _i < 2; ++_i) \
        __builtin_amdgcn_global_load_lds((const unsigned*)((const char*)(gbase) + (voff)[_i]), (LAS unsigned*)(lds + (bufoff) + ldsw + _i * 8192), 16, 0, 0); } while (0)
#define PG8_STAGE_A(bufoff, plainptr, hh, kptr, go) do { if constexpr (GATHER) { _Pragma("unroll") for (int _i = 0; _i < 2; ++_i) \
        __builtin_amdgcn_global_load_lds((const unsigned*)((kptr) + (go)[hh][_i]), (LAS unsigned*)(lds + (bufoff) + ldsw + _i * 8192), 16, 0, 0); } \
        else { PG8_STAGE(bufoff, (plainptr) + (hh) * hstep, voffA); } } while (0)
#define PG8_LDA(dst, b, h) do { _Pragma("unroll") for (int m = 0; m < 4; ++m) _Pragma("unroll") for (int k = 0; k < 2; ++k) dst[m][k] = *(const LAS bf16x8*)(lds + PG8_SA(b, h) + aoff + m * 2048 + k * 1024); } while (0)
#define PG8_LDB(dst, b, h) do { _Pragma("unroll") for (int n = 0; n < 2; ++n) _Pragma("unroll") for (int k = 0; k < 2; ++k) dst[n][k] = *(const LAS bf16x8*)(lds + PG8_SB(b, h) + boff + n * 2048 + k * 1024); } while (0)
#define PG8_MMA(ai, bj, At, Bt) do { __builtin_amdgcn_s_setprio(1); _Pragma("unroll") for (int m = 0; m < 4; ++m) _Pragma("unroll") for (int n = 0; n < 2; ++n) _Pragma("unroll") for (int k = 0; k < 2; ++k) \
        acc[ai][bj][m][n] = __builtin_amdgcn_mfma_f32_16x16x32_bf16(Bt[n][k], At[m][k], acc[ai][bj][m][n], 0, 0, 0); __builtin_amdgcn_s_setprio(0); } while (0)
#define PG8_WAIT_V(n) asm volatile("s_waitcnt vmcnt(" #n ")" ::: "memory")
#define PG8_WAIT_L(n) asm volatile("s_waitcnt lgkmcnt(" #n ")" ::: "memory")
#define PG8_BAR __builtin_amdgcn_s_barrier()
#define PG8_SCHED __builtin_amdgcn_sched_barrier(0)
    Unit cur, nxt; int ui = 0;
    if (!S.next(0, cur)) return;
    f32x4 acc[2][2][4][2];
#pragma unroll
    for (int a = 0; a < 2; ++a)
#pragma unroll
        for (int b = 0; b < 2; ++b)
#pragma unroll
            for (int m = 0; m < 4; ++m)
#pragma unroll
                for (int n = 0; n < 2; ++n) acc[a][b][m][n] = (f32x4){0.f, 0.f, 0.f, 0.f};
    bf16x8 At[4][2], B0[2][2], B1[2][2];
    const char* A0 = (const char*)g.A;
    const char* cA = A0 + (GATHER ? (size_t)0 : (size_t)cur.pm * tstep); const char* cB = (const char*)g.Bt + (size_t)cur.pn * tstep;
    unsigned gc[2][2], gn[2][2];
#pragma unroll
    for (int hh = 0; hh < 2; ++hh)
#pragma unroll
        for (int i = 0; i < 2; ++i) { gc[hh][i] = GATHER ? S.arow(cur, hh * HALF + RA[i]) + voffA[i] : 0u; gn[hh][i] = gc[hh][i]; }
    PG8_STAGE(PG8_SB(0, 0), cB, voffB); PG8_STAGE(PG8_SB(0, 1), cB + hstep, voffB); PG8_STAGE_A(PG8_SA(0, 0), cA, 0, A0, gc); PG8_STAGE_A(PG8_SA(0, 1), cA, 1, A0, gc);
    if (wr == 1) PG8_BAR;
    PG8_WAIT_V(2); PG8_BAR;
    PG8_STAGE(PG8_SB(1, 0), cB + kstep, voffB); PG8_STAGE_A(PG8_SA(1, 0), cA + kstep, 0, A0 + kstep, gc); PG8_STAGE(PG8_SB(1, 1), cB + hstep + kstep, voffB);
    PG8_WAIT_V(6); PG8_BAR;
    for (;;) {
        const bool has_next = S.next(ui + 1, nxt);
        const char* nA = has_next ? A0 + (GATHER ? (size_t)0 : (size_t)nxt.pm * tstep) : cA; const char* nB = has_next ? (const char*)g.Bt + (size_t)nxt.pn * tstep : cB;
        if constexpr (GATHER) {
#pragma unroll
            for (int hh = 0; hh < 2; ++hh)
#pragma unroll
                for (int i = 0; i < 2; ++i) gn[hh][i] = has_next ? S.arow(nxt, hh * HALF + RA[i]) + voffA[i] : gc[hh][i];
        }
        for (int t = 0; t < nt; t += 2) {
            const bool last = (t == nt - 2);
            const char* a1 = cA + (size_t)(t + 1) * kstep;
            const char* a2 = last ? nA : cA + (size_t)(t + 2) * kstep; const char* b2 = last ? nB : cB + (size_t)(t + 2) * kstep;
            const char* a3 = a2 + kstep; const char* b3 = b2 + kstep;
            const char* k1 = A0 + (size_t)(t + 1) * kstep; const char* k2 = A0 + (last ? (size_t)0 : (size_t)(t + 2) * kstep); const char* k3 = k2 + kstep;
            unsigned g2[2][2];
#pragma unroll
            for (int hh = 0; hh < 2; ++hh)
#pragma unroll
                for (int i = 0; i < 2; ++i) g2[hh][i] = last ? gn[hh][i] : gc[hh][i];
            PG8_LDB(B0, 0, 0); PG8_LDB(B1, 0, 1); PG8_SCHED; PG8_LDA(At, 0, 0); PG8_STAGE_A(PG8_SA(1, 1), a1, 1, k1, gc);
            PG8_WAIT_V(8); PG8_WAIT_L(0); PG8_BAR; PG8_MMA(0, 0, At, B0); PG8_MMA(0, 1, At, B1); PG8_BAR; PG8_SCHED;
            PG8_LDA(At, 0, 1); PG8_STAGE(PG8_SB(0, 0), b2, voffB); PG8_STAGE(PG8_SB(0, 1), b2 + hstep, voffB); PG8_STAGE_A(PG8_SA(0, 0), a2, 0, k2, g2);
            PG8_WAIT_V(8); PG8_WAIT_L(0); PG8_BAR; PG8_MMA(1, 0, At, B0); PG8_MMA(1, 1, At, B1); PG8_BAR; PG8_SCHED;
            PG8_LDB(B0, 1, 0); PG8_LDB(B1, 1, 1); PG8_SCHED; PG8_LDA(At, 1, 0); PG8_STAGE_A(PG8_SA(0, 1), a2, 1, k2, g2);
            PG8_WAIT_V(8); PG8_WAIT_L(0); PG8_BAR; PG8_MMA(0, 0, At, B0); PG8_MMA(0, 1, At, B1); PG8_BAR; PG8_SCHED;
            PG8_LDA(At, 1, 1); PG8_STAGE(PG8_SB(1, 0), b3, voffB); PG8_STAGE(PG8_SB(1, 1), b3 + hstep, voffB); PG8_STAGE_A(PG8_SA(1, 0), a3, 0, k3, g2);
            PG8_WAIT_V(8); PG8_WAIT_L(0); PG8_BAR; PG8_MMA(1, 0, At, B0); PG8_MMA(1, 1, At, B1); PG8_BAR; PG8_SCHED;
        }
        if constexpr (ALIGN_EPI) { if (wr == 0) PG8_BAR; }
        { const int l2 = lane_id(); E(acc, cur, wr, wc, l2 & 15, l2 >> 4); }
        if (!has_next) break;
#pragma unroll
        for (int a = 0; a < 2; ++a)
#pragma unroll
            for (int b = 0; b < 2; ++b)
#pragma unroll
                for (int m = 0; m < 4; ++m)
#pragma unroll
                    for (int n = 0; n < 2; ++n) acc[a][b][m][n] = (f32x4){0.f, 0.f, 0.f, 0.f};
        cur = nxt; cA = nA; cB = nB; ++ui;
#pragma unroll
        for (int hh = 0; hh < 2; ++hh)
#pragma unroll
            for (int i = 0; i < 2; ++i) gc[hh][i] = gn[hh][i];
        if constexpr (ALIGN_EPI) { if (wr == 1) PG8_BAR; }
    }
    PG8_WAIT_V(0);
    if constexpr (!ALIGN_EPI) { if (wr == 0) PG8_BAR; }
    PG8_BAR;
#undef PG8_SA
#undef PG8_SB
#undef PG8_STAGE
#undef PG8_STAGE_A
#undef PG8_LDA
#undef PG8_LDB
#undef PG8_MMA
#undef PG8_WAIT_V
#undef PG8_WAIT_L
#undef PG8_BAR
#undef PG8_SCHED
}
}
using pg8::Unit;

struct Args { const void* in[27]; float* out; unsigned char* ws; int ph_lo, ph_hi; };
struct Ctx {
    const float *x, *ln0_g, *ln0_b, *w_in, *q_norm_g, *w_uq, *kv_norm_g, *w_uk, *w_uv, *rel_bias, *w_up_a, *w_up_b, *w_gate, *b_gate, *w_o, *ln1_g, *ln1_b,
                *w_grp, *b_grp, *w_rt, *b_rt, *w_eg, *w_eu, *w_ed, *ln2_g, *ln2_b;
    const int* pos;
    float* out; unsigned char* ws;
    LAS unsigned char* lds;
    int G, bid, wid;
};
constexpr int LDS_RING = 131072;
constexpr int LDS_MISC = LDS_RING;
constexpr int LDS_LG = LDS_RING + 4096;
constexpr int LDS_BYTES = LDS_RING + 4096 + 8192;
template <class T> DI T* wsp(const Ctx& X, size_t off) { return (T*)(X.ws + off); }

DI void tr_item(const float* W, int ld, int K, int ncols, bf16_t* WT, const float* scale, LAS float* scr, int item, int lane) {
    const int nblk = (ncols + 31) >> 5, kb = item / nblk, nb = item - kb * nblk, k0 = 64 * kb, n0 = 32 * nb;
    const int n4 = 4 * (lane & 7), kr = lane >> 3;
    f32x4 v[8];
#pragma unroll
    for (int i = 0; i < 8; ++i) { const int kk = 8 * i + kr; v[i] = (n0 + n4 + 3 < ncols) ? *(const f32x4*)(W + (size_t)(k0 + kk) * ld + n0 + n4) : (f32x4){0.f, 0.f, 0.f, 0.f}; }
#pragma unroll
    for (int i = 0; i < 8; ++i) { const int kk = 8 * i + kr; f32x4 t = v[i]; if (scale) t = t * scale[k0 + kk];
        scr[kk * 33 + n4] = t[0]; scr[kk * 33 + n4 + 1] = t[1]; scr[kk * 33 + n4 + 2] = t[2]; scr[kk * 33 + n4 + 3] = t[3]; }
    asm volatile("s_waitcnt lgkmcnt(0)" ::: "memory");
    const int c = lane & 7;
#pragma unroll
    for (int j = 0; j < 4; ++j) { const int n = (lane >> 3) + 8 * j; const LAS float* s = scr + (8 * c) * 33 + n;
        u32x4 o; o.x = pk2(s[0 * 33], s[1 * 33]); o.y = pk2(s[2 * 33], s[3 * 33]); o.z = pk2(s[4 * 33], s[5 * 33]); o.w = pk2(s[6 * 33], s[7 * 33]);
        if (n0 + n < ncols) *(u32x4*)(WT + (size_t)(n0 + n) * K + k0 + 8 * c) = o; }
    asm volatile("s_waitcnt lgkmcnt(0)" ::: "memory");
}
constexpr int tr_items(int K, int ncols) { return (K / 64) * ((ncols + 31) / 32); }

DI void p0_prologue(const Ctx& X) {
    const int lane = lane_id(), wave = X.wid, tid = wave * 64 + lane;
    LAS float* scr = (LAS float*)(X.lds + wave * 16384);
    const int gw = X.bid * 8 + wave, NGW = X.G * 8;
    bf16_t* WT1 = wsp<bf16_t>(X, WS_WT1);
    {
        constexpr int seg_c0[9] = {0, 256, 384, 1312, 928, 416, 1056, 992, 1344};
        constexpr int seg_nc[9] = {256, 128, 32, 32, 64, 512, 256, 64, 8};
        constexpr int seg_d0[9] = {0, 256, 384, 416, 448, 512, 1024, 1280, 1344};
        constexpr int N_GU = 128 * tr_items(1024, 128), N_DN = 32 * tr_items(256, 1024);
        constexpr int N_IN = tr_items(1024, 256) + tr_items(1024, 128) + tr_items(1024, 32) * 2 + tr_items(1024, 64) * 2 + tr_items(1024, 512) + tr_items(1024, 256) + tr_items(1024, 8);
        constexpr int N_NAMED = N_IN + tr_items(1024, 2048) + tr_items(256, 768) + 2 * tr_items(128, 512) + 2 * tr_items(512, 1024) + tr_items(1024, 1024);
        constexpr int N_ALL = N_GU + N_DN + N_NAMED;
        for (int it = gw; it < N_ALL; it += NGW) {
            int r = it;
            if (r < N_GU) { constexpr int per = tr_items(1024, 128); const int job = r / per, rr = r - job * per, e = job >> 2, pn = (job >> 1) & 1, bj = job & 1;
                tr_item((bj ? X.w_eu : X.w_eg) + (size_t)e * 1024 * 256 + 128 * pn, 256, 1024, 128, wsp<bf16_t>(X, WS_WEGUT) + ((size_t)e * 512 + 256 * pn + 128 * bj) * 1024, nullptr, scr, rr, lane); continue; }
            r -= N_GU;
            if (r < N_DN) { constexpr int per = tr_items(256, 1024); const int e = r / per, rr = r - e * per;
                tr_item(X.w_ed + (size_t)e * 256 * 1024, 1024, 256, 1024, wsp<bf16_t>(X, WS_WEDT) + (size_t)e * 1024 * 256, nullptr, scr, rr, lane); continue; }
            r -= N_DN;
            bool done = false;
#pragma unroll
            for (int sg = 0; sg < 9; ++sg) { const int n = tr_items(1024, seg_nc[sg]);
                if (!done && r < n) { tr_item(X.w_in + seg_c0[sg], 1352, 1024, seg_nc[sg], WT1 + (size_t)seg_d0[sg] * 1024, nullptr, scr, r, lane); done = true; }
                if (!done) r -= n; }
            if (done) continue;
            if (r < tr_items(1024, 2048)) { tr_item(X.w_gate, 2048, 1024, 2048, WT1 + (size_t)1536 * 1024, nullptr, scr, r, lane); continue; } r -= tr_items(1024, 2048);
            if (r < tr_items(256, 768)) { tr_item(X.w_uq, 768, 256, 768, wsp<bf16_t>(X, WS_WUQT), X.q_norm_g, scr, r, lane); continue; } r -= tr_items(256, 768);
            if (r < tr_items(128, 512)) { tr_item(X.w_uk, 512, 128, 512, wsp<bf16_t>(X, WS_WUKVT), X.kv_norm_g, scr, r, lane); continue; } r -= tr_items(128, 512);
            if (r < tr_items(128, 512)) { tr_item(X.w_uv, 512, 128, 512, wsp<bf16_t>(X, WS_WUKVT) + 512 * 128, X.kv_norm_g, scr, r, lane); continue; } r -= tr_items(128, 512);
            if (r < tr_items(512, 1024)) { tr_item(X.w_up_a, 1024, 512, 1024, wsp<bf16_t>(X, WS_WUPT), nullptr, scr, r, lane); continue; } r -= tr_items(512, 1024);
            if (r < tr_items(512, 1024)) { tr_item(X.w_up_b, 1024, 512, 1024, wsp<bf16_t>(X, WS_WUPT) + 1024 * 512, nullptr, scr, r, lane); continue; } r -= tr_items(512, 1024);
            tr_item(X.w_o, 1024, 1024, 1024, wsp<bf16_t>(X, WS_WOT), nullptr, scr, r, lane);
        }
    }
    { const int gt = X.bid * 512 + tid, NT = X.G * 512; u32x4 z = {0u, 0u, 0u, 0u};
      for (int i = gt; i < 184 * 1024 / 8; i += NT) *(u32x4*)(WT1 + (size_t)1352 * 1024 + (size_t)i * 8) = z; }
    { const int gt = X.bid * 512 + tid, NT = X.G * 512; bf16_t* WR = wsp<bf16_t>(X, WS_WRT);
      for (int i = gt; i < 64 * 1024; i += NT) { const int j = i >> 10, k = i & 1023;
          const float v = (j < 4) ? X.w_grp[k * 4 + j] : (j < 36 ? X.w_rt[k * 32 + (j - 4)] : 0.f);
          const unsigned hi = pk2(v, 0.f) & 0xffffu; const float lo = v - bf2f((unsigned short)hi);
          WR[(size_t)j * 1024 + k] = (bf16_t)hi; WR[(size_t)(64 + j) * 1024 + k] = (bf16_t)(pk2(lo, 0.f) & 0xffffu); } }
    { const int gt = X.bid * 512 + tid, NT = X.G * 512; float* RT = wsp<float>(X, WS_ROPE);
      for (int i = gt; i < M * 16; i += NT) { const int row = i >> 4, j = i & 15; float sn, cs; rope_sincos(X.pos[row], j, sn, cs); RT[(size_t)row * 32 + j] = cs; RT[(size_t)row * 32 + 16 + j] = sn; } }
    { int* TS = wsp<int>(X, WS_TSTAT);
      for (int t = gw; t < M / 64; t += NGW) { const int p = X.pos[t * 64 + lane]; const int pmin = wave_min_i(p), pmax = wave_max_i(p);
          if (lane == 0) { TS[t * 4 + 0] = pmin >> 6; TS[t * 4 + 1] = pmax >> 6; TS[t * 4 + 2] = pmin; TS[t * 4 + 3] = pmax; } } }
    { bf16_t* XN = wsp<bf16_t>(X, WS_B); float* ST = wsp<float>(X, WS_STATS0);
#if DBG_STAGE == 1
      float* Y1 = wsp<float>(X, WS_A);
#endif
      f32x4 gv[4], bv[4];
#pragma unroll
      for (int j = 0; j < 4; ++j) { gv[j] = *(const f32x4*)(X.ln0_g + 4 * lane + 256 * j); bv[j] = *(const f32x4*)(X.ln0_b + 4 * lane + 256 * j); }
      for (int m = gw; m < M; m += NGW) {
          const f32x4* xr = (const f32x4*)(X.x + (size_t)m * D) + lane;
          f32x4 v[4]; float s = 0.f;
#pragma unroll
          for (int j = 0; j < 4; ++j) { v[j] = xr[64 * j]; s += (v[j].x + v[j].y) + (v[j].z + v[j].w); }
          const float mean = wave_sum(s) * (1.f / D); float s2 = 0.f;
#pragma unroll
          for (int j = 0; j < 4; ++j) { v[j] = v[j] - mean; s2 += (v[j].x * v[j].x + v[j].y * v[j].y) + (v[j].z * v[j].z + v[j].w * v[j].w); }
          const float rstd = 1.f / sqrtf(wave_sum(s2) * (1.f / D) + LN_EPS);
          if (lane == 0) { ST[2 * m] = mean; ST[2 * m + 1] = rstd; }
          u32x2* o8 = (u32x2*)(XN + (size_t)m * D) + lane;
#pragma unroll
          for (int j = 0; j < 4; ++j) { const f32x4 y = v[j] * rstd * gv[j] + bv[j]; u32x2 o; o.x = pk2(y.x, y.y); o.y = pk2(y.z, y.w); o8[64 * j] = o;
#if DBG_STAGE == 1
              *((f32x4*)(Y1 + (size_t)m * D) + lane + 64 * j) = y * ALPHA;
#endif
          }
      } }
}

DI void store8(bf16_t* p, const f32x4& a, const f32x4& b) { u32x4 w; w.x = pk2(a[0], a[1]); w.y = pk2(a[2], a[3]); w.z = pk2(b[0], b[1]); w.w = pk2(b[2], b[3]); *(u32x4*)p = w; }
DI void rope8(f32x4& v0, f32x4& v1, const float* tab, int fq) {
    const float sg = (fq < 2) ? -1.f : 1.f; const int j0 = 8 * (fq & 1);
    const f32x4 c0 = *(const f32x4*)(tab + j0), c1 = *(const f32x4*)(tab + j0 + 4), s0 = *(const f32x4*)(tab + 16 + j0), s1 = *(const f32x4*)(tab + 16 + j0 + 4);
#pragma unroll
    for (int e = 0; e < 4; ++e) {
        const float o0 = __shfl_xor(v0[e], 32), o1 = __shfl_xor(v1[e], 32);
        v0[e] = v0[e] * c0[e] + sg * o0 * s0[e];
        v1[e] = v1[e] * c1[e] + sg * o1 * s1[e];
    }
}
struct Epi1 {
    static constexpr bool PERM = true;
    bf16_t *CQ, *CKV, *KR, *KI, *KB, *VB, *QB, *QI, *G; float *WI, *SSQ; const float* rope; const float* bgate;
    DI void operator()(const f32x4 (&acc)[2][2][4][2], const Unit& u, int wr, int wc, int fr_, int fq_) const {
        int fr = fr_, fq = fq_; asm volatile("" : "+v"(fr), "+v"(fq));
        const int pn = u.pn; const int row0 = u.pm * 256 + wr * 64 + fr;
        if (pn >= 6) {
            const int gc0 = (pn - 6) * 256 + 32 * wc + 8 * fq;
#pragma unroll
            for (int bj = 0; bj < 2; ++bj) { const f32x4 b0 = *(const f32x4*)(bgate + gc0 + 128 * bj), b1 = *(const f32x4*)(bgate + gc0 + 128 * bj + 4);
#pragma unroll
                for (int ai = 0; ai < 2; ++ai)
#pragma unroll
                    for (int m = 0; m < 4; ++m) { f32x4 v0 = acc[ai][bj][m][0] + b0, v1 = acc[ai][bj][m][1] + b1;
#pragma unroll
                        for (int e = 0; e < 4; ++e) { v0[e] = sigmoidf_fast(v0[e]); v1[e] = sigmoidf_fast(v1[e]); }
                        store8(G + (size_t)(row0 + ai * 128 + m * 16) * 2048 + gc0 + 128 * bj, v0, v1); } }
        } else if (pn == 0 || pn == 4) {
            bf16_t* O = pn == 0 ? CQ : QI;
#pragma unroll
            for (int ai = 0; ai < 2; ++ai)
#pragma unroll
                for (int m = 0; m < 4; ++m) { const int row = row0 + ai * 128 + m * 16; float s = 0.f;
#pragma unroll
                    for (int bj = 0; bj < 2; ++bj) { const f32x4 v0 = acc[ai][bj][m][0], v1 = acc[ai][bj][m][1];
                        store8(O + (size_t)row * 256 + 128 * bj + 32 * wc + 8 * fq, v0, v1);
                        s += (v0[0] * v0[0] + v0[1] * v0[1]) + (v0[2] * v0[2] + v0[3] * v0[3]) + (v1[0] * v1[0] + v1[1] * v1[1]) + (v1[2] * v1[2] + v1[3] * v1[3]); }
                    if (pn == 0) { s += __shfl_xor(s, 16); s += __shfl_xor(s, 32); if (fq == 0) SSQ[(size_t)row * 8 + wc] = s; } }
        } else if (pn == 2 || pn == 3) {
            const float sc = 0.125f * LOG2E;
#pragma unroll
            for (int ai = 0; ai < 2; ++ai)
#pragma unroll
                for (int m = 0; m < 4; ++m) { const int row = row0 + ai * 128 + m * 16;
#pragma unroll
                    for (int bj = 0; bj < 2; ++bj) store8(QB + (size_t)row * 512 + (pn - 2) * 256 + 128 * bj + 32 * wc + 8 * fq, acc[ai][bj][m][0] * sc, acc[ai][bj][m][1] * sc); }
        } else if (pn == 1) {
#pragma unroll
            for (int ai = 0; ai < 2; ++ai)
#pragma unroll
                for (int m = 0; m < 4; ++m) { const int row = row0 + ai * 128 + m * 16;
                    { const f32x4 v0 = acc[ai][0][m][0], v1 = acc[ai][0][m][1];
                      store8(CKV + (size_t)row * 128 + 32 * wc + 8 * fq, v0, v1);
                      float s = (v0[0] * v0[0] + v0[1] * v0[1]) + (v0[2] * v0[2] + v0[3] * v0[3]) + (v1[0] * v1[0] + v1[1] * v1[1]) + (v1[2] * v1[2] + v1[3] * v1[3]);
                      s += __shfl_xor(s, 16); s += __shfl_xor(s, 32); if (fq == 0) SSQ[(size_t)row * 8 + 4 + wc] = s; }
                    f32x4 v0 = acc[ai][1][m][0], v1 = acc[ai][1][m][1];
                    if (wc == 0) { rope8(v0, v1, rope + (size_t)row * 32, fq); store8(KR + (size_t)row * 32 + 8 * fq, v0, v1); }
                    else if (wc == 1) store8(KI + (size_t)row * 32 + 8 * fq, v0, v1);
                    else store8(KB + (size_t)row * 64 + 32 * (wc - 2) + 8 * fq, v0, v1); }
        } else {
            const float wsc = 0.35355339059327373f * 0.17677669529663687f;
#pragma unroll
            for (int ai = 0; ai < 2; ++ai)
#pragma unroll
                for (int m = 0; m < 4; ++m) { const int row = row0 + ai * 128 + m * 16;
                    if (wc < 2) store8(VB + (size_t)row * 64 + 32 * wc + 8 * fq, acc[ai][0][m][0], acc[ai][0][m][1]);
                    else if (wc == 2 && fq == 0) { *(f32x4*)(WI + (size_t)row * 8) = acc[ai][0][m][0] * wsc; *(f32x4*)(WI + (size_t)row * 8 + 4) = acc[ai][0][m][1] * wsc; } }
        }
    }
};
struct Epi2 {
    static constexpr bool PERM = true;
    bf16_t* QM; const float* SSQ; const float* rope;
    DI void operator()(const f32x4 (&acc)[2][2][4][2], const Unit& u, int wr, int wc, int fr_, int fq_) const {
        int fr = fr_, fq = fq_; asm volatile("" : "+v"(fr), "+v"(fq));
        const int row0 = u.pm * 256 + wr * 64 + fr; const float sc = 0.10206207261596575f * LOG2E;
#pragma unroll
        for (int ai = 0; ai < 2; ++ai)
#pragma unroll
            for (int m = 0; m < 4; ++m) { const int row = row0 + ai * 128 + m * 16;
                const f32x4 q4 = *(const f32x4*)(SSQ + (size_t)row * 8); const float rs = sc / sqrtf(((q4[0] + q4[1]) + (q4[2] + q4[3])) * (1.f / 256.f) + RMS_EPS);
#pragma unroll
                for (int bj = 0; bj < 2; ++bj) { const int g32 = 8 * u.pn + 4 * bj + wc; f32x4 v0 = acc[ai][bj][m][0] * rs, v1 = acc[ai][bj][m][1] * rs;
                    if (g32 % 3 == 2) rope8(v0, v1, rope + (size_t)row * 32, fq);
                    store8(QM + (size_t)row * 768 + 32 * g32 + 8 * fq, v0, v1); } }
    }
};
struct Epi3 {
    static constexpr bool PERM = true;
    bf16_t *KN, *VM; const float* SSQ;
    DI void operator()(const f32x4 (&acc)[2][2][4][2], const Unit& u, int wr, int wc, int fr_, int fq_) const {
        int fr = fr_, fq = fq_; asm volatile("" : "+v"(fr), "+v"(fq));
        const int row0 = u.pm * 256 + wr * 64 + fr; bf16_t* O = u.pn < 2 ? KN : VM; const int c0 = (u.pn & 1) * 256 + 32 * wc + 8 * fq;
#pragma unroll
        for (int ai = 0; ai < 2; ++ai)
#pragma unroll
            for (int m = 0; m < 4; ++m) { const int row = row0 + ai * 128 + m * 16;
                const f32x4 q4 = *(const f32x4*)(SSQ + (size_t)row * 8 + 4); const float rs = 1.f / sqrtf(((q4[0] + q4[1]) + (q4[2] + q4[3])) * (1.f / 128.f) + RMS_EPS);
#pragma unroll
                for (int bj = 0; bj < 2; ++bj) store8(O + (size_t)row * 512 + c0 + 128 * bj, acc[ai][bj][m][0] * rs, acc[ai][bj][m][1] * rs); }
    }
};
struct PairOrder {
    int G, c;
    DI bool next(int i, Unit& u) const { const int ii = i >> 1, z = i & 1; const long L = (long)ii * G + c; if (L >= 512) return false;
        int pm, pn; pg8::tile_of((int)L, 128, 4, pm, pn); u.pm = pm + 128 * z; u.pn = pn + 4 * z; u.a0 = z; u.a1 = 0; return true; }
    DI unsigned arow(const Unit&, int) const { return 0u; }
};
struct Epi4 {
    static constexpr bool PERM = true;
    bf16_t* MIX; const bf16_t* G;
    DI void operator()(const f32x4 (&acc)[2][2][4][2], const Unit& u, int wr, int wc, int fr_, int fq_) const {
        int fr = fr_, fq = fq_; asm volatile("" : "+v"(fr), "+v"(fq));
        const int z = u.a0, row0 = (u.pm & 127) * 256 + wr * 64 + fr, c0 = (u.pn & 3) * 256 + 32 * wc + 8 * fq;
#pragma unroll
        for (int ai = 0; ai < 2; ++ai)
#pragma unroll
            for (int m = 0; m < 4; ++m) { const int row = row0 + ai * 128 + m * 16;
#pragma unroll
                for (int bj = 0; bj < 2; ++bj) { const int c = c0 + 128 * bj;
                    const u32x4 gw = *(const u32x4*)(G + (size_t)row * 2048 + z * 1024 + c);
                    f32x4 v0 = acc[ai][bj][m][0], v1 = acc[ai][bj][m][1];
                    v0[0] *= __uint_as_float(gw.x << 16); v0[1] *= __uint_as_float(gw.x & 0xffff0000u); v0[2] *= __uint_as_float(gw.y << 16); v0[3] *= __uint_as_float(gw.y & 0xffff0000u);
                    v1[0] *= __uint_as_float(gw.z << 16); v1[1] *= __uint_as_float(gw.z & 0xffff0000u); v1[2] *= __uint_as_float(gw.w << 16); v1[3] *= __uint_as_float(gw.w & 0xffff0000u);
                    bf16_t* o = MIX + (size_t)row * 1024 + c;
                    if (z) { const u32x4 pw = *(const u32x4*)o;
                        v0[0] += __uint_as_float(pw.x << 16); v0[1] += __uint_as_float(pw.x & 0xffff0000u); v0[2] += __uint_as_float(pw.y << 16); v0[3] += __uint_as_float(pw.y & 0xffff0000u);
                        v1[0] += __uint_as_float(pw.z << 16); v1[1] += __uint_as_float(pw.z & 0xffff0000u); v1[2] += __uint_as_float(pw.w << 16); v1[3] += __uint_as_float(pw.w & 0xffff0000u); }
                    store8(o, v0, v1); } }
    }
};
struct Epi5 {
    static constexpr bool PERM = false;
    float* Y1; const float *x, *ST, *g0, *b0;
    DI void operator()(const f32x4 (&acc)[2][2][4][2], const Unit& u, int wr, int wc, int fr_, int fq_) const {
        int fr = fr_, fq = fq_; asm volatile("" : "+v"(fr), "+v"(fq));
        const int row0 = u.pm * 256 + wr * 64 + fr, c0 = u.pn * 256 + 32 * wc + 4 * fq;
        f32x4 gv[2][2], bv[2][2];
#pragma unroll
        for (int bj = 0; bj < 2; ++bj)
#pragma unroll
            for (int n = 0; n < 2; ++n) { gv[bj][n] = *(const f32x4*)(g0 + c0 + 128 * bj + 16 * n) * ALPHA; bv[bj][n] = *(const f32x4*)(b0 + c0 + 128 * bj + 16 * n) * ALPHA; }
#pragma unroll
        for (int ai = 0; ai < 2; ++ai)
#pragma unroll
            for (int m = 0; m < 4; ++m) { const int row = row0 + ai * 128 + m * 16; const float mean = ST[2 * row], rstd = ST[2 * row + 1];
#pragma unroll
                for (int bj = 0; bj < 2; ++bj)
#pragma unroll
                    for (int n = 0; n < 2; ++n) { const size_t off = (size_t)row * 1024 + c0 + 128 * bj + 16 * n;
                        const f32x4 xv = *(const f32x4*)(x + off);
                        *(f32x4*)(Y1 + off) = (xv - mean) * rstd * gv[bj][n] + bv[bj][n] + acc[ai][bj][m][n]; } }
    }
};
struct MoeOrder {
    const LAS int* tstart;
    const LAS int* scnt;
    const int* LIST; int K2;
    int NT, G, c, ntiles;
    DI bool next(int i, Unit& u) const {
        const long L = (long)i * G + c; if (L >= (long)ntiles * NT) return false;
        const int tile = (int)(L / NT), pn = (int)(L - (long)tile * NT);
        int lo = 0, hi = NSEG;
#pragma unroll
        for (int s = 0; s < 6; ++s) { const int mid = (lo + hi) >> 1; if (tstart[mid] <= tile) lo = mid; else hi = mid; }
        const int ts = tstart[lo];
        u.pm = tile; u.pn = __builtin_amdgcn_readfirstlane((lo & 31) * NT + pn); u.a0 = __builtin_amdgcn_readfirstlane(lo); u.a1 = __builtin_amdgcn_readfirstlane(tile - ts); return true;
    }
    DI unsigned arow(const Unit& u, int r) const { const int idx = u.a1 * 256 + r; const int tok = LIST[(size_t)u.a0 * M + (idx < scnt[u.a0] ? idx : 0)]; return (unsigned)tok * (unsigned)K2; }
};
struct Epi7 {
    static constexpr bool PERM = true;
    bf16_t* HID; const float* LISTW; const LAS int* scnt;
    DI void operator()(const f32x4 (&acc)[2][2][4][2], const Unit& u, int wr, int wc, int fr_, int fq_) const {
        int fr = fr_, fq = fq_; asm volatile("" : "+v"(fr), "+v"(fq));
        const int c0 = (u.pn & 1) * 128 + 32 * wc + 8 * fq, cnt = scnt[u.a0];
#pragma unroll
        for (int ai = 0; ai < 2; ++ai)
#pragma unroll
            for (int m = 0; m < 4; ++m) { const int r = ai * 128 + wr * 64 + m * 16 + fr, idx = u.a1 * 256 + r;
                const float w = idx < cnt ? LISTW[(size_t)u.a0 * M + idx] : 0.f;
                f32x4 v0, v1;
#pragma unroll
                for (int e = 0; e < 4; ++e) { const float a0 = acc[ai][0][m][0][e], a1 = acc[ai][0][m][1][e];
                    v0[e] = a0 * sigmoidf_fast(a0) * acc[ai][1][m][0][e] * w; v1[e] = a1 * sigmoidf_fast(a1) * acc[ai][1][m][1][e] * w; }
                store8(HID + ((size_t)u.pm * 256 + r) * 256 + c0, v0, v1); }
    }
};
struct Epi8 {
    static constexpr bool PERM = true;
    bf16_t* PP; const int* LIST; const LAS int* scnt;
    DI void operator()(const f32x4 (&acc)[2][2][4][2], const Unit& u, int wr, int wc, int fr_, int fq_) const {
        int fr = fr_, fq = fq_; asm volatile("" : "+v"(fr), "+v"(fq));
        const int c0 = (u.pn & 3) * 256 + 32 * wc + 8 * fq, cnt = scnt[u.a0]; bf16_t* O = PP + (size_t)(u.a0 >> 5) * M * 1024;
#pragma unroll
        for (int ai = 0; ai < 2; ++ai)
#pragma unroll
            for (int m = 0; m < 4; ++m) { const int r = ai * 128 + wr * 64 + m * 16 + fr, idx = u.a1 * 256 + r;
                if (idx < cnt) { const int tok = LIST[(size_t)u.a0 * M + idx];
#pragma unroll
                    for (int bj = 0; bj < 2; ++bj) store8(O + (size_t)tok * 1024 + c0 + 128 * bj, acc[ai][bj][m][0], acc[ai][bj][m][1]); }
                asm volatile("" ::: "memory"); }
    }
};


DI void p6_ln1_router(const Ctx& X) {
    const int lane = lane_id(), wave = X.wid, tid = wave * 64 + lane, r = lane & 31, hh = lane >> 5;
    LAS unsigned char* HI = X.lds; LAS unsigned char* LO = X.lds + 65536;
    LAS float* LG = (LAS float*)(X.lds + LDS_LG);
    const float* Y1 = wsp<float>(X, WS_A); float* H = wsp<float>(X, WS_H); bf16_t* HB = wsp<bf16_t>(X, WS_B);
    const bf16_t* WR = wsp<bf16_t>(X, WS_WRT);
    unsigned* CNT = wsp<unsigned>(X, WS_CTL) + CW_CNT; int* LIST = wsp<int>(X, WS_LIST); float* LISTW = wsp<float>(X, WS_LISTW);
    f32x4 gv[4], bv[4];
#pragma unroll
    for (int j = 0; j < 4; ++j) { gv[j] = *(const f32x4*)(X.ln1_g + 4 * lane + 256 * j); bv[j] = *(const f32x4*)(X.ln1_b + 4 * lane + 256 * j); }
    for (int unit = X.bid; unit < M / 32; unit += X.G) {
        *(LAS f32x4*)(LG + tid * 4) = (f32x4){0.f, 0.f, 0.f, 0.f};
#pragma unroll 1
        for (int rr = 0; rr < 4; ++rr) {
            const int rl = wave * 4 + rr, m = unit * 32 + rl;
            const f32x4* yr = (const f32x4*)(Y1 + (size_t)m * D) + lane;
            f32x4 v[4]; float s = 0.f;
#pragma unroll
            for (int j = 0; j < 4; ++j) { v[j] = yr[64 * j]; s += (v[j].x + v[j].y) + (v[j].z + v[j].w); }
            const float mean = wave_sum(s) * (1.f / D); float s2 = 0.f;
#pragma unroll
            for (int j = 0; j < 4; ++j) { v[j] = v[j] - mean; s2 += (v[j].x * v[j].x + v[j].y * v[j].y) + (v[j].z * v[j].z + v[j].w * v[j].w); }
            const float rstd = 1.f / sqrtf(wave_sum(s2) * (1.f / D) + LN_EPS);
#pragma unroll
            for (int j = 0; j < 4; ++j) {
                const f32x4 y = v[j] * rstd * gv[j] + bv[j];
                *((f32x4*)(H + (size_t)m * D) + lane + 64 * j) = y;
                u32x2 hi; hi.x = pk2(y.x, y.y); hi.y = pk2(y.z, y.w);
                *((u32x2*)(HB + (size_t)m * D) + lane + 64 * j) = hi;
                const float l0 = y.x - __uint_as_float(hi.x << 16), l1 = y.y - __uint_as_float(hi.x & 0xffff0000u), l2 = y.z - __uint_as_float(hi.y << 16), l3 = y.w - __uint_as_float(hi.y & 0xffff0000u);
                u32x2 lo; lo.x = pk2(l0, l1); lo.y = pk2(l2, l3);
                const int chunk = (lane >> 1) + 32 * j; const unsigned byte = (unsigned)rl * 2048u + (unsigned)((chunk ^ (rl & 15)) * 16) + 8u * (lane & 1);
                *(LAS u32x2*)(HI + byte) = hi; *(LAS u32x2*)(LO + byte) = lo;
            }
        }
        __syncthreads();
        {
            f32x16 a0, a1;
#pragma unroll
            for (int e = 0; e < 16; ++e) { a0[e] = 0.f; a1[e] = 0.f; }
#pragma unroll
            for (int ks = 0; ks < 8; ++ks) {
                const int ch = 16 * wave + 2 * ks + hh; const unsigned byte = (unsigned)r * 2048u + (unsigned)((ch ^ (r & 15)) * 16);
                const bf16x8 ahi = *(const LAS bf16x8*)(HI + byte), alo = *(const LAS bf16x8*)(LO + byte);
                const size_t ko = (size_t)(128 * wave + 16 * ks + 8 * hh);
                const bf16x8 bh0 = *(const bf16x8*)(WR + (size_t)r * 1024 + ko), bh1 = *(const bf16x8*)(WR + (size_t)(32 + r) * 1024 + ko);
                const bf16x8 bl0 = *(const bf16x8*)(WR + (size_t)(64 + r) * 1024 + ko), bl1 = *(const bf16x8*)(WR + (size_t)(96 + r) * 1024 + ko);
                a0 = __builtin_amdgcn_mfma_f32_32x32x16_bf16(ahi, bh0, a0, 0, 0, 0); a0 = __builtin_amdgcn_mfma_f32_32x32x16_bf16(ahi, bl0, a0, 0, 0, 0); a0 = __builtin_amdgcn_mfma_f32_32x32x16_bf16(alo, bh0, a0, 0, 0, 0);
                a1 = __builtin_amdgcn_mfma_f32_32x32x16_bf16(ahi, bh1, a1, 0, 0, 0); a1 = __builtin_amdgcn_mfma_f32_32x32x16_bf16(ahi, bl1, a1, 0, 0, 0); a1 = __builtin_amdgcn_mfma_f32_32x32x16_bf16(alo, bh1, a1, 0, 0, 0);
            }
#pragma unroll
            for (int e = 0; e < 16; ++e) { const int row = (e & 3) + 8 * (e >> 2) + 4 * hh;
                __hip_atomic_fetch_add(LG + row * 64 + r, a0[e], __ATOMIC_RELAXED, __HIP_MEMORY_SCOPE_WORKGROUP);
                if (r < 4) __hip_atomic_fetch_add(LG + row * 64 + 32 + r, a1[e], __ATOMIC_RELAXED, __HIP_MEMORY_SCOPE_WORKGROUP); }
        }
        __syncthreads();
        if (tid < 32) {
            const LAS float* lg = LG + tid * 64; const int token = unit * 32 + tid;
            float gl[4]; float gmax = -3.4e38f; int gsel = 0;
#pragma unroll
            for (int j = 0; j < 4; ++j) { gl[j] = lg[j] + X.b_grp[j]; if (gl[j] > gmax) { gmax = gl[j]; gsel = j; } }
            float gz = 0.f;
#pragma unroll
            for (int j = 0; j < 4; ++j) gz += expf(gl[j] - gmax);
            const float gw = 1.f / gz;
            float e0 = -3.4e38f, e1 = -3.4e38f; int i0 = 0, i1 = 0;
#pragma unroll
            for (int j = 0; j < 8; ++j) { const float v = lg[4 + gsel * 8 + j] + X.b_rt[gsel * 8 + j];
                if (v > e0) { e1 = e0; i1 = i0; e0 = v; i0 = j; } else if (v > e1) { e1 = v; i1 = j; } }
            const float t = expf(e1 - e0), c0 = gw / (1.f + t), c1 = gw * t / (1.f + t);
            const int s0 = gsel * 8 + i0, s1 = 32 + gsel * 8 + i1;
            const unsigned p0 = __hip_atomic_fetch_add(CNT + s0, 1u, __ATOMIC_RELAXED, __HIP_MEMORY_SCOPE_AGENT);
            const unsigned p1 = __hip_atomic_fetch_add(CNT + s1, 1u, __ATOMIC_RELAXED, __HIP_MEMORY_SCOPE_AGENT);
            LIST[(size_t)s0 * M + p0] = token; LISTW[(size_t)s0 * M + p0] = c0;
            LIST[(size_t)s1 * M + p1] = token; LISTW[(size_t)s1 * M + p1] = c1;
        }
        __syncthreads();
    }
}

DI void moe_prep(const Ctx& X) {
    const int tid = X.wid * 64 + lane_id();
    LAS int* tstart = (LAS int*)(X.lds + LDS_MISC + 64); LAS int* scnt = (LAS int*)(X.lds + LDS_MISC + 512);
    unsigned* CNT = wsp<unsigned>(X, WS_CTL) + CW_CNT;
    if (tid < NSEG) scnt[tid] = (int)__hip_atomic_load(CNT + tid, __ATOMIC_RELAXED, __HIP_MEMORY_SCOPE_AGENT);
    __syncthreads();
    if (tid == 0) { int a = 0; for (int s = 0; s < NSEG; ++s) { tstart[s] = a; a += (scnt[s] + 255) >> 8; } tstart[NSEG] = a; }
    __syncthreads();
}

DI void p9_ln2(const Ctx& X) {
    const int lane = lane_id(), wave = X.wid;
    const int gw = X.bid * 8 + wave, NGW = X.G * 8;
    const float* H = wsp<float>(X, WS_H); const bf16_t* PP0 = wsp<bf16_t>(X, WS_A); const bf16_t* PP1 = PP0 + (size_t)M * 1024;
    f32x4 gv[4], bv[4];
#pragma unroll
    for (int j = 0; j < 4; ++j) { gv[j] = *(const f32x4*)(X.ln2_g + 4 * lane + 256 * j); bv[j] = *(const f32x4*)(X.ln2_b + 4 * lane + 256 * j); }
    for (int m = gw; m < M; m += NGW) {
        f32x4 v[4]; float s = 0.f;
#pragma unroll
        for (int j = 0; j < 4; ++j) {
            const f32x4 hv = *((const f32x4*)(H + (size_t)m * D) + lane + 64 * j);
            const u32x2 a = *((const u32x2*)(PP0 + (size_t)m * D) + lane + 64 * j), b = *((const u32x2*)(PP1 + (size_t)m * D) + lane + 64 * j);
            f32x4 y = hv * ALPHA;
            y.x += __uint_as_float(a.x << 16) + __uint_as_float(b.x << 16); y.y += __uint_as_float(a.x & 0xffff0000u) + __uint_as_float(b.x & 0xffff0000u);
            y.z += __uint_as_float(a.y << 16) + __uint_as_float(b.y << 16); y.w += __uint_as_float(a.y & 0xffff0000u) + __uint_as_float(b.y & 0xffff0000u);
            v[j] = y; s += (y.x + y.y) + (y.z + y.w);
        }
        const float mean = wave_sum(s) * (1.f / D); float s2 = 0.f;
#pragma unroll
        for (int j = 0; j < 4; ++j) { v[j] = v[j] - mean; s2 += (v[j].x * v[j].x + v[j].y * v[j].y) + (v[j].z * v[j].z + v[j].w * v[j].w); }
        const float rstd = 1.f / sqrtf(wave_sum(s2) * (1.f / D) + LN_EPS);
#pragma unroll
        for (int j = 0; j < 4; ++j) *((f32x4*)(X.out + (size_t)m * D) + lane + 64 * j) = v[j] * rstd * gv[j] + bv[j];
    }
}

#define MFMA32(a, b, c) __builtin_amdgcn_mfma_f32_32x32x16_bf16((a), (b), (c), 0, 0, 0)
DI bf16x8 pack8(const f32x16& x, int s) {
    u32x4 p; p.x = pk2(x[8 * s + 0], x[8 * s + 1]); p.y = pk2(x[8 * s + 2], x[8 * s + 3]); p.z = pk2(x[8 * s + 4], x[8 * s + 5]); p.w = pk2(x[8 * s + 6], x[8 * s + 7]);
    return __builtin_bit_cast(bf16x8, p);
}
DI void tr_read8(unsigned addr, bf16x8 (&vf)[4]) {
    s16x4 t0, t1, t2, t3, t4, t5, t6, t7;
    asm volatile("ds_read_b64_tr_b16 %0, %8\n\tds_read_b64_tr_b16 %1, %8 offset:1024\n\tds_read_b64_tr_b16 %2, %8 offset:2048\n\tds_read_b64_tr_b16 %3, %8 offset:3072\n\t"
                 "ds_read_b64_tr_b16 %4, %8 offset:4096\n\tds_read_b64_tr_b16 %5, %8 offset:5120\n\tds_read_b64_tr_b16 %6, %8 offset:6144\n\tds_read_b64_tr_b16 %7, %8 offset:7168\n\ts_waitcnt lgkmcnt(0)"
                 : "=&v"(t0), "=&v"(t1), "=&v"(t2), "=&v"(t3), "=&v"(t4), "=&v"(t5), "=&v"(t6), "=&v"(t7) : "v"(addr) : "memory");
    vf[0] = __builtin_shufflevector(t0, t1, 0, 1, 2, 3, 4, 5, 6, 7); vf[1] = __builtin_shufflevector(t2, t3, 0, 1, 2, 3, 4, 5, 6, 7);
    vf[2] = __builtin_shufflevector(t4, t5, 0, 1, 2, 3, 4, 5, 6, 7); vf[3] = __builtin_shufflevector(t6, t7, 0, 1, 2, 3, 4, 5, 6, 7);
}
DI void softmax_tile(f32x16& s0, f32x16& s1, float& mrun, float& lrun, f32x16& o0, f32x16& o1, bf16x8 (&pf)[4]) {
    float mx = s0[0];
#pragma unroll
    for (int e = 1; e < 16; ++e) mx = fmaxf(mx, s0[e]);
#pragma unroll
    for (int e = 0; e < 16; ++e) mx = fmaxf(mx, s1[e]);
    mx = fmaxf(mx, __shfl_xor(mx, 32));
    const float mn = fmaxf(mrun, mx), alpha = fast_exp2(mrun - mn); mrun = mn;
    float ls = 0.f;
#pragma unroll
    for (int e = 0; e < 16; ++e) { s0[e] = fast_exp2(s0[e] - mn); s1[e] = fast_exp2(s1[e] - mn); ls += s0[e] + s1[e]; }
    lrun = lrun * alpha + ls;
#pragma unroll
    for (int e = 0; e < 16; ++e) { o0[e] *= alpha; o1[e] *= alpha; }
    pf[0] = pack8(s0, 0); pf[1] = pack8(s0, 1); pf[2] = pack8(s1, 0); pf[3] = pack8(s1, 1);
}
DI int next_tile(const int* TS, int j, int qmax) { for (++j; j < 32; ++j) if (TS[j * 4] <= qmax) break; return j; }

DI void mla_unit(const Ctx& X, int b, int h, int qb) {
    const int lane = lane_id(), w = X.wid, tid = w * 64 + lane, r = lane & 31, hh = lane >> 5;
    LAS unsigned char* lds = X.lds; const unsigned ldsb = (unsigned)(uintptr_t)lds;
    const int tok0 = b * SEQ;
    const bf16_t* QM = wsp<bf16_t>(X, WS_QM); const bf16_t* KN = wsp<bf16_t>(X, WS_KN); const bf16_t* VM = wsp<bf16_t>(X, WS_VM); const bf16_t* KR = wsp<bf16_t>(X, WS_KR);
    bf16_t* OA = wsp<bf16_t>(X, WS_B);
    const int* TS = wsp<int>(X, WS_TSTAT) + (size_t)b * 32 * 4;
    const int qrow = tok0 + qb * 256 + w * 32 + r;
    bf16x8 qf[6];
#pragma unroll
    for (int s = 0; s < 6; ++s) qf[s] = *(const bf16x8*)(QM + (size_t)qrow * 768 + h * 96 + 16 * s + 8 * hh);
    const int qc = X.pos[qrow] >> 6;
    const i32x4 tsv = *(const i32x4*)(TS + 4 * (lane & 31));
    int qmin = 0x7fffffff, qmax = -0x7fffffff - 1;
#pragma unroll
    for (int t = 0; t < 4; ++t) { const int a = __builtin_amdgcn_readlane(tsv[0], qb * 4 + t), c = __builtin_amdgcn_readlane(tsv[1], qb * 4 + t); qmin = a < qmin ? a : qmin; qmax = c > qmax ? c : qmax; }
    unsigned procm = (unsigned)__ballot(lane < 32 && tsv[0] <= qmax);
    const unsigned maskm = (unsigned)__ballot(lane < 32 && tsv[1] > qmin);
    f32x16 o0, o1;
#pragma unroll
    for (int e = 0; e < 16; ++e) { o0[e] = 0.f; o1[e] = 0.f; }
    float mrun = NEGF, lrun = 0.f;
    const int key_a = tid >> 3, ch_a = tid & 7, key_r = (tid >> 2) & 63, ch_r = tid & 3;
    const unsigned kdst = 192u * key_a + 16u * (ch_a ^ ((key_a >> 2) & 3)), vdst = 12288u + 128u * key_a + 16u * (ch_a ^ (((key_a >> 1) & 1) << 2));
    const unsigned rdst = 192u * key_r + 16u * ((8 + ch_r) ^ ((key_r >> 2) & 3));
    constexpr unsigned BUFB = 20736u;
    const int q4 = (lane & 15) >> 2, p4 = lane & 3, blk = (lane >> 4) & 1, sw = (q4 >> 1) & 1;
    const unsigned vbase = ldsb + 12288u + 128u * (4 * hh + q4) + 16u * (2 * blk + (p4 >> 1)) + 8u * (p4 & 1);
    const unsigned va0 = vbase + 64u * sw, va1 = vbase + 64u * (1 - sw);
    u32x4 rk, rv, rr = {0u, 0u, 0u, 0u}; int rkc = 0;
#define MLA_LOAD(j) do { const size_t t0_ = (size_t)tok0 + (size_t)(j) * 64; rk = *(const u32x4*)(KN + (t0_ + key_a) * 512 + h * 64 + ch_a * 8); rv = *(const u32x4*)(VM + (t0_ + key_a) * 512 + h * 64 + ch_a * 8); \
        if (tid < 256) rr = *(const u32x4*)(KR + (t0_ + key_r) * 32 + ch_r * 8); if (tid < 64) rkc = X.pos[t0_ + tid]; } while (0)
#define MLA_STORE(bo) do { *(LAS u32x4*)(lds + (bo) + kdst) = rk; *(LAS u32x4*)(lds + (bo) + vdst) = rv; if (tid < 256) *(LAS u32x4*)(lds + (bo) + rdst) = rr; if (tid < 64) *(LAS int*)(lds + (bo) + 20480u + 4u * tid) = rkc >> 6; } while (0)
    asm volatile("" :: "v"(qf[0]), "v"(qf[1]), "v"(qf[2]), "v"(qf[3]), "v"(qf[4]), "v"(qf[5]));
    int j = procm ? __builtin_ctz(procm) : 32; procm &= procm - 1u;
    unsigned cur = 0;
    if (j < 32) { MLA_LOAD(j); MLA_STORE(0u); }
    __syncthreads();
    while (j < 32) {
        const int jn = procm ? __builtin_ctz(procm) : 32; procm &= procm - 1u;
        if (jn < 32) MLA_LOAD(jn);
        const unsigned bo = cur * BUFB;
        f32x16 s0, s1;
#pragma unroll
        for (int e = 0; e < 16; ++e) { s0[e] = 0.f; s1[e] = 0.f; }
#pragma unroll
        for (int ks = 0; ks < 6; ++ks) {
            const unsigned ko = 192u * r + 16u * ((2 * ks + hh) ^ ((r >> 2) & 3));
            const bf16x8 a0 = *(const LAS bf16x8*)(lds + bo + ko), a1 = *(const LAS bf16x8*)(lds + bo + ko + 192u * 32u);
            s0 = MFMA32(a0, qf[ks], s0); s1 = MFMA32(a1, qf[ks], s1);
        }
        if ((maskm >> j) & 1u) {
#pragma unroll
            for (int g = 0; g < 4; ++g) {
                const i32x4 c0 = *(const LAS i32x4*)(lds + bo + 20480u + 4u * (8 * g + 4 * hh)), c1 = *(const LAS i32x4*)(lds + bo + 20480u + 4u * (32 + 8 * g + 4 * hh));
#pragma unroll
                for (int e = 0; e < 4; ++e) { if (c0[e] > qc) s0[4 * g + e] = NEGF; if (c1[e] > qc) s1[4 * g + e] = NEGF; }
            }
        }
        bf16x8 pf[4];
        softmax_tile(s0, s1, mrun, lrun, o0, o1, pf);
        { bf16x8 vf[4]; tr_read8(va0 + bo, vf);
#pragma unroll
          for (int k = 0; k < 4; ++k) o0 = MFMA32(vf[k], pf[k], o0);
          tr_read8(va1 + bo, vf);
#pragma unroll
          for (int k = 0; k < 4; ++k) o1 = MFMA32(vf[k], pf[k], o1); }
        if (jn < 32) MLA_STORE((cur ^ 1u) * BUFB);
        __syncthreads();
        cur ^= 1u; j = jn;
    }
#undef MLA_LOAD
#undef MLA_STORE
    const float inv = 1.f / (lrun + __shfl_xor(lrun, 32));
    bf16_t* op = OA + (size_t)qrow * 512 + h * 64 + 4 * hh;
#pragma unroll
    for (int g = 0; g < 4; ++g) {
        u32x2 a, c; a.x = pk2(o0[4 * g] * inv, o0[4 * g + 1] * inv); a.y = pk2(o0[4 * g + 2] * inv, o0[4 * g + 3] * inv);
        c.x = pk2(o1[4 * g] * inv, o1[4 * g + 1] * inv); c.y = pk2(o1[4 * g + 2] * inv, o1[4 * g + 3] * inv);
        *(u32x2*)(op + 8 * g) = a; *(u32x2*)(op + 32 + 8 * g) = c;
    }
}

DI int t5_bucket(int rel) { const int n = rel < 0 ? -rel : rel;
    const int large = 8 + (n >= 12) + (n >= 16) + (n >= 23) + (n >= 32) + (n >= 46) + (n >= 64) + (n >= 91);
    return (rel > 0 ? 16 : 0) + (n < 8 ? n : large); }
DI void dsa_scan(LAS unsigned char* lds, int p, int lane, int w) {
    constexpr unsigned L_HIST = 17408u, L_PRE = 58368u, L_NEED = 58496u;
    {
        const int ql = lane >> 4, part = lane & 15, q = 4 * w + ql;
        unsigned c[16]; unsigned sum = 0u;
#pragma unroll
        for (int t = 0; t < 16; ++t) { c[t] = *(const LAS unsigned*)(lds + L_HIST + 4u * ((16 * part + t) * 32 + q)); sum += c[t]; }
        unsigned sfx = sum;
#pragma unroll
        for (int d = 1; d < 16; d <<= 1) { const unsigned t = __shfl_down(sfx, d, 16); if (part + d < 16) sfx += t; }
        const unsigned total = __shfl(sfx, lane & ~15);
        const unsigned nd = *(const LAS unsigned*)(lds + L_NEED + 4u * q), pold = *(const LAS unsigned*)(lds + L_PRE + 4u * q);
        const unsigned excl = sfx - sum;
        if (nd != 0u) {
            if (total < nd) { if (part == 0) { *(LAS unsigned*)(lds + L_NEED + 4u * q) = 0u; *(LAS unsigned*)(lds + L_PRE + 4u * q) = 0xFFFFFFFFu; } }
            else if (excl < nd && nd <= sfx) {
                unsigned run = excl, bsel = 0u, ndn = 0u; bool found = false;
#pragma unroll
                for (int t = 15; t >= 0; --t) { if (!found && run + c[t] >= nd) { found = true; bsel = (unsigned)(16 * part + t); ndn = nd - run; } if (!found) run += c[t]; }
                *(LAS unsigned*)(lds + L_PRE + 4u * q) = (p == 0 ? 0u : (pold << 8)) | bsel; *(LAS unsigned*)(lds + L_NEED + 4u * q) = ndn;
            }
        }
    }

}
DI void dsa_attend(const Ctx& X, int b, int qt, int tid, unsigned proc);
DI void dsa_unit(const Ctx& X, int b, int qt) {
    const int lane = lane_id(), w = X.wid, tid = w * 64 + lane, r = lane & 31, hh = lane >> 5;
    LAS unsigned char* lds = X.lds; const unsigned ldsb = (unsigned)(uintptr_t)lds;
    constexpr unsigned L_QIT = 0u  , L_HIST = 17408u, L_MSK = 50176u, L_PRE = 58368u, L_NEED = 58496u, L_BT = 58624u, L_KV = 67072u, KVB = 16640u;
    const int tok0 = b * SEQ, q0 = tok0 + qt * 32;
    const bf16_t* QI = wsp<bf16_t>(X, WS_QI); const bf16_t* KI = wsp<bf16_t>(X, WS_KI); const bf16_t* QB = wsp<bf16_t>(X, WS_QB);
    const bf16_t* KB = wsp<bf16_t>(X, WS_KB); const bf16_t* VB = wsp<bf16_t>(X, WS_VB); const float* WI = wsp<float>(X, WS_WI);
    bf16_t* OB = wsp<bf16_t>(X, WS_B) + (size_t)M * 512;
    const int* TS = wsp<int>(X, WS_TSTAT) + (size_t)b * 32 * 4;
    const i32x4 tsv = *(const i32x4*)(TS + 4 * (lane & 31));
    const int qmax = __builtin_amdgcn_readlane(tsv[1], qt >> 1);
    const unsigned proc = (unsigned)__ballot(lane < 32 && tsv[0] <= qmax);
#pragma unroll
    for (int i = 0; i < 2; ++i) { const int c = tid + 512 * i, row = c >> 5, ch = c & 31;
        *(LAS u32x4*)(lds + L_QIT + row * 528 + ch * 16) = *(const u32x4*)(QI + (size_t)(q0 + row) * 256 + ch * 8); }
    if (tid < 257) { const int bk = t5_bucket(tid - 128);
#pragma unroll
        for (int hd = 0; hd < 8; ++hd) *(LAS float*)(lds + L_BT + 4u * (hd * 260 + tid)) = LOG2E * (X.rel_bias[bk * 8 + hd] - X.rel_bias[15 * 8 + hd]); }
    if (tid < 32) { *(LAS unsigned*)(lds + L_PRE + 4u * tid) = 0u; *(LAS unsigned*)(lds + L_NEED + 4u * tid) = 256u; }
#pragma unroll
    for (int i = 0; i < 4; ++i) *(LAS u32x4*)(lds + L_HIST + 16u * (tid + 512 * i)) = (u32x4){0u, 0u, 0u, 0u};
    const int pos_q = X.pos[q0 + r], qc = pos_q >> 6;
    float wq[8];
    { const f32x4 wa = *(const f32x4*)(WI + (size_t)(q0 + r) * 8), wb = *(const f32x4*)(WI + (size_t)(q0 + r) * 8 + 4);
      wq[0] = wa[0]; wq[1] = wa[1]; wq[2] = wa[2]; wq[3] = wa[3]; wq[4] = wb[0]; wq[5] = wb[1]; wq[6] = wb[2]; wq[7] = wb[3]; }
    __syncthreads();
    unsigned keys[8][16];
    bf16x8 nka0, nka1; i32x4 npk[4];
#define DSA_PREF(i_) do { const int jt_ = w + 8 * (i_); if ((proc >> (jt_ >> 1)) & 1u) { const size_t kr_ = (size_t)tok0 + jt_ * 32; \
        nka0 = *(const bf16x8*)(KI + (kr_ + r) * 32 + 8 * hh); nka1 = *(const bf16x8*)(KI + (kr_ + r) * 32 + 16 + 8 * hh); \
        _Pragma("unroll") for (int g_ = 0; g_ < 4; ++g_) npk[g_] = *(const i32x4*)(X.pos + kr_ + 8 * g_ + 4 * hh); } } while (0)
    DSA_PREF(0);
#pragma unroll
    for (int i = 0; i < 8; ++i) {
        const int jt = w + 8 * i;
        const bf16x8 ka0 = nka0, ka1 = nka1; i32x4 pk4[4];
#pragma unroll
        for (int g = 0; g < 4; ++g) pk4[g] = npk[g];
        if (i < 7) DSA_PREF(i + 1);
        if ((proc >> (jt >> 1)) & 1u) {
            f32x16 sc;
#pragma unroll
            for (int e = 0; e < 16; ++e) sc[e] = 0.f;
#pragma unroll
            for (int hd = 0; hd < 8; ++hd) {
                f32x16 S;
#pragma unroll
                for (int e = 0; e < 16; ++e) S[e] = 0.f;
                const bf16x8 b0 = *(const LAS bf16x8*)(lds + L_QIT + r * 528 + hh * 16 + hd * 64), b1 = *(const LAS bf16x8*)(lds + L_QIT + r * 528 + hh * 16 + hd * 64 + 32);
                S = MFMA32(ka0, b0, S); S = MFMA32(ka1, b1, S);
#pragma unroll
                for (int e = 0; e < 16; ++e) sc[e] += wq[hd] * fmaxf(S[e], 0.f);
                asm volatile("" : "+v"(sc));
            }
#pragma unroll
            for (int g = 0; g < 4; ++g) {
#pragma unroll
                for (int e = 0; e < 4; ++e) { const int sidx = jt * 32 + 8 * g + 4 * hh + e; const unsigned u = __float_as_uint(sc[4 * g + e]);
                    const unsigned srt = u ^ ((unsigned)((int)u >> 31) | 0x80000000u);
                    const unsigned kk = ((pk4[g][e] >> 6) <= qc) ? ((srt & 0xFFFFF800u) | (unsigned)(2047 - sidx)) : 0u; keys[i][4 * g + e] = kk;
                    if (kk != 0u) __hip_atomic_fetch_add((LAS unsigned*)(lds + L_HIST) + r + (kk >> 24) * 32u, 1u, __ATOMIC_RELAXED, __HIP_MEMORY_SCOPE_WORKGROUP); }
            }
        } else {
#pragma unroll
            for (int e = 0; e < 16; ++e) keys[i][e] = 0u;
        }
        __builtin_amdgcn_sched_barrier(0);
    }
#undef DSA_PREF
    __syncthreads();
    dsa_scan(lds, 0, lane, w);
    __syncthreads();
#pragma unroll 1
    for (int p = 1; p < 4; ++p) {
        const int shift = 24 - 8 * p;
#pragma unroll
        for (int i = 0; i < 4; ++i) *(LAS u32x4*)(lds + L_HIST + 16u * (tid + 512 * i)) = (u32x4){0u, 0u, 0u, 0u};
        __syncthreads();
        {
            const unsigned pre = *(const LAS unsigned*)(lds + L_PRE + 4u * r), ndq = *(const LAS unsigned*)(lds + L_NEED + 4u * r);
            unsigned P = pre << (shift + 8), lim = (ndq == 0u) ? 0u : (1u << (shift + 8));
            asm volatile("" : "+v"(P), "+v"(lim));
            LAS unsigned* hq = (LAS unsigned*)(lds + L_HIST) + r;
#pragma unroll
            for (int i = 0; i < 8; ++i) {
                if ((proc >> ((w + 8 * i) >> 1)) & 1u) {
                    unsigned mn = 0xFFFFFFFFu;
#pragma unroll
                    for (int e = 0; e < 16; ++e) { const unsigned x = keys[i][e] ^ P; mn = x < mn ? x : mn; }
                    if (__any(mn < lim)) {
                        unsigned P2 = P; asm volatile("" : "+v"(P2));
#pragma unroll
                        for (int e = 0; e < 16; ++e) { const unsigned x = keys[i][e] ^ P2;
                            if (x < lim) __hip_atomic_fetch_add(hq + ((x >> shift) & 255u) * 32u, 1u, __ATOMIC_RELAXED, __HIP_MEMORY_SCOPE_WORKGROUP); }
                    }
                }
                __builtin_amdgcn_sched_barrier(0);
            }
        }
        __syncthreads();
        dsa_scan(lds, p, lane, w);
        __syncthreads();
    }
    {
        const unsigned nd = *(const LAS unsigned*)(lds + L_NEED + 4u * r), pr = *(const LAS unsigned*)(lds + L_PRE + 4u * r);
        const unsigned T = nd == 0u ? 0u : pr, thr = T > 2048u ? T : 2048u;
#pragma unroll
        for (int i = 0; i < 8; ++i) { const int jt = w + 8 * i; unsigned bits = 0u;
#pragma unroll
            for (int e = 0; e < 16; ++e) bits |= (keys[i][e] >= thr ? 1u : 0u) << e;
            *(LAS unsigned short*)(lds + L_MSK + 2u * ((jt * 2 + hh) * 32 + r)) = (unsigned short)bits; }
    }
    __syncthreads();
    dsa_attend(X, b, qt, X.wid * 64 + lane_id(), proc);
}
DI void dsa_attend(const Ctx& X, int b, int qt, int tid, unsigned proc) {
    const int lane = tid & 63, w = X.wid, r = lane & 31, hh = lane >> 5;
    LAS unsigned char* lds = X.lds; const unsigned ldsb = (unsigned)(uintptr_t)lds;
    constexpr unsigned L_MSK = 50176u, L_BT = 58624u, L_KV = 67072u, KVB = 16640u;
    const int tok0 = b * SEQ, q0 = tok0 + qt * 32;
    const bf16_t* QB = wsp<bf16_t>(X, WS_QB); const bf16_t* KB = wsp<bf16_t>(X, WS_KB); const bf16_t* VB = wsp<bf16_t>(X, WS_VB);
    bf16_t* OB = wsp<bf16_t>(X, WS_B) + (size_t)M * 512;
    const int* TS = wsp<int>(X, WS_TSTAT) + (size_t)b * 32 * 4;
    const i32x4 tsv = *(const i32x4*)(TS + 4 * (lane & 31));
    const int posmin_q = __builtin_amdgcn_readlane(tsv[2], qt >> 1);
    const unsigned nearm = (unsigned)__ballot(lane < 32 && tsv[3] - posmin_q > -128);
    unsigned procm = proc;
    const int pos_q = X.pos[q0 + r];
    bf16x8 qf[4];
#pragma unroll
    for (int s = 0; s < 4; ++s) qf[s] = *(const bf16x8*)(QB + (size_t)(q0 + r) * 512 + w * 64 + 16 * s + 8 * hh);
    f32x16 o0, o1;
#pragma unroll
    for (int e = 0; e < 16; ++e) { o0[e] = 0.f; o1[e] = 0.f; }
    float mrun = NEGF, lrun = 0.f;
    const int key_a = tid >> 3, ch_a = tid & 7;
    const unsigned kdst = 128u * key_a + 16u * (ch_a ^ ((key_a >> 1) & 7)), vdst = 8192u + 128u * key_a + 16u * (ch_a ^ (((key_a >> 1) & 1) << 2));
    const int q4 = (lane & 15) >> 2, p4 = lane & 3, blk = (lane >> 4) & 1, sw = (q4 >> 1) & 1;
    const unsigned vbase = ldsb + L_KV + 8192u + 128u * (4 * hh + q4) + 16u * (2 * blk + (p4 >> 1)) + 8u * (p4 & 1);
    const unsigned va0 = vbase + 64u * sw, va1 = vbase + 64u * (1 - sw);
    u32x4 rk, rv; int rp = 0;
#define DSA_LOAD(j) do { const size_t t0_ = (size_t)tok0 + (size_t)(j) * 64; rk = *(const u32x4*)(KB + (t0_ + key_a) * 64 + ch_a * 8); rv = *(const u32x4*)(VB + (t0_ + key_a) * 64 + ch_a * 8); \
        if (tid < 64) rp = X.pos[t0_ + tid]; } while (0)
#define DSA_STORE(bo) do { *(LAS u32x4*)(lds + L_KV + (bo) + kdst) = rk; *(LAS u32x4*)(lds + L_KV + (bo) + vdst) = rv; if (tid < 64) *(LAS int*)(lds + L_KV + (bo) + 16384u + 4u * tid) = rp; } while (0)
    asm volatile("" :: "v"(qf[0]), "v"(qf[1]), "v"(qf[2]), "v"(qf[3]), "v"(pos_q));
    int j = procm ? __builtin_ctz(procm) : 32; procm &= procm - 1u;
    unsigned cur = 0;
    if (j < 32) { DSA_LOAD(j); DSA_STORE(0u); }
    __syncthreads();
    while (j < 32) {
        const int jn = procm ? __builtin_ctz(procm) : 32; procm &= procm - 1u;
        if (jn < 32) DSA_LOAD(jn);
        const unsigned bo = cur * KVB;
        f32x16 s0, s1;
#pragma unroll
        for (int e = 0; e < 16; ++e) { s0[e] = 0.f; s1[e] = 0.f; }
#pragma unroll
        for (int ks = 0; ks < 4; ++ks) {
            const unsigned ko = 128u * r + 16u * ((2 * ks + hh) ^ ((r >> 1) & 7));
            const bf16x8 a0 = *(const LAS bf16x8*)(lds + L_KV + bo + ko), a1 = *(const LAS bf16x8*)(lds + L_KV + bo + ko + 128u * 32u);
            s0 = MFMA32(a0, qf[ks], s0); s1 = MFMA32(a1, qf[ks], s1);
        }
        if ((nearm >> j) & 1u) {
#pragma unroll
            for (int g = 0; g < 4; ++g) {
                const i32x4 c0 = *(const LAS i32x4*)(lds + L_KV + bo + 16384u + 4u * (8 * g + 4 * hh)), c1 = *(const LAS i32x4*)(lds + L_KV + bo + 16384u + 4u * (32 + 8 * g + 4 * hh));
#pragma unroll
                for (int e = 0; e < 4; ++e) {
                    int d0 = c0[e] - pos_q, d1 = c1[e] - pos_q; d0 = d0 < -128 ? -128 : (d0 > 128 ? 128 : d0); d1 = d1 < -128 ? -128 : (d1 > 128 ? 128 : d1);
                    s0[4 * g + e] += *(const LAS float*)(lds + L_BT + 4u * (w * 260 + d0 + 128)); s1[4 * g + e] += *(const LAS float*)(lds + L_BT + 4u * (w * 260 + d1 + 128));
                }
            }
        }
        {
            const unsigned m0 = *(const LAS unsigned short*)(lds + L_MSK + 2u * (((2 * j) * 2 + hh) * 32 + r)), m1 = *(const LAS unsigned short*)(lds + L_MSK + 2u * (((2 * j + 1) * 2 + hh) * 32 + r));
#pragma unroll
            for (int e = 0; e < 16; ++e) { if (!((m0 >> e) & 1u)) s0[e] = NEGF; if (!((m1 >> e) & 1u)) s1[e] = NEGF; }
        }
        bf16x8 pf[4];
        softmax_tile(s0, s1, mrun, lrun, o0, o1, pf);
        { bf16x8 vf[4]; tr_read8(va0 + bo, vf);
#pragma unroll
          for (int k = 0; k < 4; ++k) o0 = MFMA32(vf[k], pf[k], o0);
          tr_read8(va1 + bo, vf);
#pragma unroll
          for (int k = 0; k < 4; ++k) o1 = MFMA32(vf[k], pf[k], o1); }
        if (jn < 32) DSA_STORE((cur ^ 1u) * KVB);
        __syncthreads();
        cur ^= 1u; j = jn;
    }
#undef DSA_LOAD
#undef DSA_STORE
    const float inv = 1.f / (lrun + __shfl_xor(lrun, 32));
    bf16_t* op = OB + (size_t)(q0 + r) * 512 + w * 64 + 4 * hh;
#pragma unroll
    for (int g = 0; g < 4; ++g) {
        u32x2 a, c; a.x = pk2(o0[4 * g] * inv, o0[4 * g + 1] * inv); a.y = pk2(o0[4 * g + 2] * inv, o0[4 * g + 3] * inv);
        c.x = pk2(o1[4 * g] * inv, o1[4 * g + 1] * inv); c.y = pk2(o1[4 * g + 2] * inv, o1[4 * g + 3] * inv);
        *(u32x2*)(op + 8 * g) = a; *(u32x2*)(op + 32 + 8 * g) = c;
    }
    __syncthreads();
}

constexpr int N_PHASES = 10;
template <int PHM>
__global__ void __launch_bounds__(512, 2) fwd_kernel(Args args) {
    extern __shared__ __attribute__((aligned(16))) unsigned char lds_raw[];
    Ctx X;
    X.x = (const float*)args.in[0]; X.pos = (const int*)args.in[1]; X.ln0_g = (const float*)args.in[2]; X.ln0_b = (const float*)args.in[3]; X.w_in = (const float*)args.in[4];
    X.q_norm_g = (const float*)args.in[5]; X.w_uq = (const float*)args.in[6]; X.kv_norm_g = (const float*)args.in[7]; X.w_uk = (const float*)args.in[8]; X.w_uv = (const float*)args.in[9];
    X.rel_bias = (const float*)args.in[10]; X.w_up_a = (const float*)args.in[11]; X.w_up_b = (const float*)args.in[12]; X.w_gate = (const float*)args.in[13]; X.b_gate = (const float*)args.in[14];
    X.w_o = (const float*)args.in[15]; X.ln1_g = (const float*)args.in[16]; X.ln1_b = (const float*)args.in[17]; X.w_grp = (const float*)args.in[18]; X.b_grp = (const float*)args.in[19];
    X.w_rt = (const float*)args.in[20]; X.b_rt = (const float*)args.in[21]; X.w_eg = (const float*)args.in[22]; X.w_eu = (const float*)args.in[23]; X.w_ed = (const float*)args.in[24];
    X.ln2_g = (const float*)args.in[25]; X.ln2_b = (const float*)args.in[26];
    X.out = args.out; X.ws = args.ws; X.lds = (LAS unsigned char*)lds_raw; X.G = gridDim.x; X.bid = blockIdx.x; X.wid = __builtin_amdgcn_readfirstlane((int)(threadIdx.x >> 6));
    if (threadIdx.x < 16) ((LAS unsigned*)(X.lds + LDS_MISC))[threadIdx.x] = 0u;
    __syncthreads();
    const int lo = args.ph_lo, hi = args.ph_hi;
    XcdBarrier bar; bar.bar = wsp<unsigned>(X, WS_CTL) + CW_BAR; bar.x = 0; bar.st = nullptr;
    if (hi - lo > 1) bar = xcd_barrier_post(wsp<unsigned>(X, WS_CTL) + CW_BAR, (volatile LAS unsigned*)(X.lds + LDS_MISC));
#define IN(k) (((PHM >> (k)) & 1) && lo <= (k) && (k) < hi)
#define SEAM(k) do { if (IN(k) && IN((k) + 1)) xcd_barrier(bar); } while (0)

    if (IN(0)) { p0_prologue(X); }
    SEAM(0);
#if DBG_STAGE >= 2
    if (IN(1)) {
        pg8::Gemm g{wsp<bf16_t>(X, WS_B), wsp<bf16_t>(X, WS_WT1), 1024}; pg8::StaticOrder S; S.init(M, NW1, X.G, X.bid);
        Epi1 E{wsp<bf16_t>(X, WS_CQ), wsp<bf16_t>(X, WS_CKV), wsp<bf16_t>(X, WS_KR), wsp<bf16_t>(X, WS_KI), wsp<bf16_t>(X, WS_KB), wsp<bf16_t>(X, WS_VB), wsp<bf16_t>(X, WS_QB), wsp<bf16_t>(X, WS_QI),
               wsp<bf16_t>(X, WS_A), wsp<float>(X, WS_WI), wsp<float>(X, WS_SSQ), wsp<float>(X, WS_ROPE), X.b_gate};
        pg8::gemm_phase<Epi1, pg8::StaticOrder, true, false>(X.lds, g, S, E, X.wid);
    }
    SEAM(1);
    if (IN(2)) {
        { pg8::Gemm g{wsp<bf16_t>(X, WS_CKV), wsp<bf16_t>(X, WS_WUKVT), 128}; pg8::StaticOrder S; S.init(M, 1024, X.G, X.bid);
          Epi3 E{wsp<bf16_t>(X, WS_KN), wsp<bf16_t>(X, WS_VM), wsp<float>(X, WS_SSQ)};
          pg8::gemm_phase<Epi3, pg8::StaticOrder, true, false>(X.lds, g, S, E, X.wid); }
        { pg8::Gemm g{wsp<bf16_t>(X, WS_CQ), wsp<bf16_t>(X, WS_WUQT), 256}; pg8::StaticOrder S; S.init(M, 768, X.G, X.bid);
          Epi2 E{wsp<bf16_t>(X, WS_QM), wsp<float>(X, WS_SSQ), wsp<float>(X, WS_ROPE)};
          pg8::gemm_phase<Epi2, pg8::StaticOrder, true, false>(X.lds, g, S, E, X.wid); }
    }
    SEAM(2);
    if (IN(3)) {
        for (int i = 0;; ++i) { const long L = (long)i * X.G + X.bid; if (L >= 1024) break; const int c = (int)(L & 255), ii = (int)(L >> 8);
            const int bh = c >> 1; const int tab[2][4] = {{7, 0, 5, 2}, {6, 1, 4, 3}}; int qb = tab[0][0];
#pragma unroll
            for (int a = 0; a < 2; ++a)
#pragma unroll
                for (int t = 0; t < 4; ++t) if (a == (c & 1) && t == ii) qb = tab[a][t];
#ifndef NO_MLA
            mla_unit(X, bh >> 3, bh & 7, qb);
#endif
#ifdef REP_MLA
            mla_unit(X, bh >> 3, bh & 7, qb);
#endif
        }
        for (int i = 0;; ++i) { const long L = (long)i * X.G + X.bid; if (L >= 1024) break; const int c = (int)(L & 255), ii = (int)(L >> 8);
            const int b = c >> 4, idx = c & 15; const int qt = ii == 0 ? 63 - idx : (ii == 1 ? idx : (ii == 2 ? 47 - idx : 16 + idx));
#ifndef NO_DSA
            dsa_unit(X, b, qt);
#endif
#ifdef REP_DSA
            dsa_unit(X, b, qt);
#endif
        }
    }
    SEAM(3);
    if (IN(4)) {
        pg8::Gemm g{wsp<bf16_t>(X, WS_B), wsp<bf16_t>(X, WS_WUPT), 512}; PairOrder S{X.G, X.bid};
        Epi4 E{wsp<bf16_t>(X, WS_MIXPRE), wsp<bf16_t>(X, WS_A)};
        pg8::gemm_phase<Epi4, PairOrder, true, false>(X.lds, g, S, E, X.wid);
    }
    SEAM(4);
    if (IN(5)) {
        pg8::Gemm g{wsp<bf16_t>(X, WS_MIXPRE), wsp<bf16_t>(X, WS_WOT), 1024}; pg8::StaticOrder S; S.init(M, 1024, X.G, X.bid);
        Epi5 E{wsp<float>(X, WS_A), X.x, wsp<float>(X, WS_STATS0), X.ln0_g, X.ln0_b};
        pg8::gemm_phase<Epi5, pg8::StaticOrder, true, false>(X.lds, g, S, E, X.wid);
    }
    SEAM(5);
#endif
    if (IN(6)) { p6_ln1_router(X); }
    SEAM(6);
    if (IN(7)) {
        moe_prep(X);
        const LAS int* tstart = (const LAS int*)(X.lds + LDS_MISC + 64); const LAS int* scnt = (const LAS int*)(X.lds + LDS_MISC + 512);
        pg8::Gemm g{wsp<bf16_t>(X, WS_B), wsp<bf16_t>(X, WS_WEGUT), 1024}; MoeOrder S{tstart, scnt, wsp<int>(X, WS_LIST), 2048, 2, X.G, X.bid, __builtin_amdgcn_readfirstlane(tstart[NSEG])};
        Epi7 E{wsp<bf16_t>(X, WS_HID), wsp<float>(X, WS_LISTW), scnt};
        pg8::gemm_phase<Epi7, MoeOrder, true, true>(X.lds, g, S, E, X.wid);
    }
    SEAM(7);
    if (IN(8)) {
        moe_prep(X);
        const LAS int* tstart = (const LAS int*)(X.lds + LDS_MISC + 64); const LAS int* scnt = (const LAS int*)(X.lds + LDS_MISC + 512);
        pg8::Gemm g{wsp<bf16_t>(X, WS_HID), wsp<bf16_t>(X, WS_WEDT), 256}; MoeOrder S{tstart, scnt, wsp<int>(X, WS_LIST), 0, 4, X.G, X.bid, __builtin_amdgcn_readfirstlane(tstart[NSEG])};
        Epi8 E{wsp<bf16_t>(X, WS_A), wsp<int>(X, WS_LIST), scnt};
        pg8::gemm_phase<Epi8, MoeOrder, true, false>(X.lds, g, S, E, X.wid);
    }
    SEAM(8);
    if (IN(9)) { p9_ln2(X); }
#undef IN
#undef SEAM
}

#ifndef PH_MASK
#define PH_MASK 0x3ff
#endif
template <int PHM> static bool setup_kernel(int& per_cu) {
    if (hipFuncSetAttribute((const void*)fwd_kernel<PHM>, hipFuncAttributeMaxDynamicSharedMemorySize, LDS_BYTES) != hipSuccess) return false;
    if (hipOccupancyMaxActiveBlocksPerMultiprocessor(&per_cu, (const void*)fwd_kernel<PHM>, 512, LDS_BYTES) != hipSuccess) per_cu = 0;
    (void)hipGetLastError(); return true;
}
template <int P> static void launch_phase(int grid, hipStream_t stream, Args a) {
    if (!((PH_MASK >> P) & 1)) return;
    a.ph_lo = P; a.ph_hi = P + 1;
    hipLaunchKernelGGL(fwd_kernel<(1 << P)>, dim3(grid), dim3(512), LDS_BYTES, stream, a);
#ifdef REP_MASK
    if ((REP_MASK >> P) & 1) hipLaunchKernelGGL(fwd_kernel<(1 << P)>, dim3(grid), dim3(512), LDS_BYTES, stream, a);
#endif
}
extern "C" void kernel_launch(void* const* d_in, const int* in_sizes, int n_in, void* d_out, int out_size, void* d_ws, size_t ws_size, hipStream_t stream) {
    static int grid = 0;
    if (grid == 0) {
        if (n_in != 27 || in_sizes[0] != M * D || out_size != M * D || ws_size < WS_END) { fprintf(stderr, "kernel_launch: unexpected shapes (n_in %d, ws %zu); nothing launched\n", n_in, ws_size); grid = -1; return; }
        int dev = 0, cus = 0, per_cu = 0; bool ok = true;
        if (hipGetDevice(&dev) != hipSuccess || hipDeviceGetAttribute(&cus, hipDeviceAttributeMultiprocessorCount, dev) != hipSuccess) { grid = -1; return; }
#if N_LAUNCH_MODE == 1
        ok = setup_kernel<PH_MASK>(per_cu);
#else
        ok = setup_kernel<1>(per_cu) && setup_kernel<2>(per_cu) && setup_kernel<4>(per_cu) && setup_kernel<8>(per_cu) && setup_kernel<16>(per_cu) && setup_kernel<32>(per_cu) &&
             setup_kernel<64>(per_cu) && setup_kernel<128>(per_cu) && setup_kernel<256>(per_cu) && setup_kernel<512>(per_cu);
#endif
        if (!ok) { fprintf(stderr, "kernel_launch: hipFuncSetAttribute failed\n"); grid = -1; return; }
        if (per_cu < 1) fprintf(stderr, "kernel_launch: occupancy query says %d\n", per_cu);
        grid = cus;
    }
    if (grid < 0) return;
    if (hipMemsetAsync((char*)d_ws + WS_CTL, 0, CTL_ZERO_BYTES, stream) != hipSuccess) return;
    Args a{};
    for (int i = 0; i < 27; ++i) a.in[i] = d_in[i];
    a.out = (float*)d_out; a.ws = (unsigned char*)d_ws;
#if N_LAUNCH_MODE == 1
    a.ph_lo = 0; a.ph_hi = N_PHASES;
    hipLaunchKernelGGL(fwd_kernel<PH_MASK>, dim3(grid), dim3(512), LDS_BYTES, stream, a);
#else
    launch_phase<0>(grid, stream, a);
#if DBG_STAGE >= 2
    launch_phase<1>(grid, stream, a); launch_phase<2>(grid, stream, a); launch_phase<3>(grid, stream, a); launch_phase<4>(grid, stream, a); launch_phase<5>(grid, stream, a);
#endif
    launch_phase<6>(grid, stream, a); launch_phase<7>(grid, stream, a); launch_phase<8>(grid, stream, a); launch_phase<9>(grid, stream, a);
#endif
}
```

```cpp
#include <hip/hip_runtime.h>
#include <cstdio>
#include <cstdint>

#ifndef N_LAUNCH_MODE
#define N_LAUNCH_MODE 1
#endif
#ifndef DBG_STAGE
#define DBG_STAGE 2
#endif

#define LAS __attribute__((address_space(3)))
#define GAS __attribute__((address_space(1)))
typedef unsigned short bf16_t;
typedef short bf16x8 __attribute__((ext_vector_type(8)));
typedef short s16x4 __attribute__((ext_vector_type(4)));
typedef float f32x2 __attribute__((ext_vector_type(2)));
typedef float f32x4 __attribute__((ext_vector_type(4)));
typedef float f32x16 __attribute__((ext_vector_type(16)));
typedef unsigned u32x2 __attribute__((ext_vector_type(2)));
typedef unsigned u32x4 __attribute__((ext_vector_type(4)));
typedef int i32x4 __attribute__((ext_vector_type(4)));
typedef __bf16 bf16x2_t __attribute__((ext_vector_type(2)));
#define DI __device__ __forceinline__

constexpr int BATCH = 16, SEQ = 2048, D = 1024, M = BATCH * SEQ;
constexpr int NW1 = 3584;
constexpr int NSEG = 64;
constexpr int MAXTILES = 320;
constexpr float LN_EPS = 1e-5f, RMS_EPS = 1e-6f;
constexpr float ALPHA = 1.189207115002721f;
constexpr float LOG2E = 1.4426950408889634f;
constexpr float NEGF = -1e30f;

constexpr size_t MiB = 1u << 20;
constexpr size_t WS_CTL = 0, CTL_ZERO_BYTES = 1 * MiB;
constexpr size_t WS_WT1 = 1 * MiB;
constexpr size_t WS_WUQT = 8 * MiB;
constexpr size_t WS_WUKVT = WS_WUQT + 768 * 256 * 2;
constexpr size_t WS_WRT = WS_WUKVT + 1024 * 128 * 2;
constexpr size_t WS_WUPT = 9 * MiB;
constexpr size_t WS_WOT = 11 * MiB;
constexpr size_t WS_WEGUT = 13 * MiB;
constexpr size_t WS_WEDT = 45 * MiB;
constexpr size_t WS_STATS0 = 61 * MiB;
constexpr size_t WS_SSQ = WS_STATS0 + (size_t)M * 8;
constexpr size_t WS_TSTAT = WS_SSQ + (size_t)M * 32;
constexpr size_t WS_STATS1 = WS_TSTAT + 8192;
constexpr size_t WS_TOKINFO = 63 * MiB;
constexpr size_t WS_A = 64 * MiB;
constexpr size_t WS_B = 192 * MiB;
constexpr size_t WS_C = 256 * MiB;
constexpr size_t WS_Dr = 384 * MiB;
constexpr size_t WS_END = 512 * MiB;
constexpr size_t WS_QB = WS_C, WS_QI = WS_QB + 32 * MiB, WS_CQ = WS_QI + 16 * MiB, WS_CKV = WS_CQ + 16 * MiB, WS_KB = WS_CKV + 8 * MiB, WS_VB = WS_KB + 4 * MiB,
                 WS_KR = WS_VB + 4 * MiB, WS_KI = WS_KR + 2 * MiB, WS_WI = WS_KI + 2 * MiB;
constexpr size_t WS_H = WS_C;
constexpr size_t WS_QM = WS_Dr, WS_KN = WS_QM + 48 * MiB, WS_VM = WS_KN + 32 * MiB;
constexpr size_t WS_MIXPRE = WS_Dr;
constexpr size_t WS_HID = WS_Dr + 64 * MiB;
constexpr size_t WS_LIST = WS_Dr + 104 * MiB;
constexpr size_t WS_LISTW = WS_Dr + 112 * MiB;
constexpr size_t WS_ROPE = WS_Dr + 120 * MiB;
constexpr int CW_BAR = 4096;
constexpr int CW_CNT = 16384;

DI unsigned pk2(float lo, float hi) { f32x2 v = {lo, hi}; bf16x2_t r = __builtin_convertvector(v, bf16x2_t); return __builtin_bit_cast(unsigned, r); }
DI float bf2f(unsigned short b) { return __uint_as_float((unsigned)b << 16); }
DI float wave_sum(float v) {
#pragma unroll
    for (int o = 1; o < 64; o <<= 1) v += __shfl_xor(v, o);
    return v;
}
DI int wave_min_i(int v) {
#pragma unroll
    for (int o = 1; o < 64; o <<= 1) { const int t = __shfl_xor(v, o); v = t < v ? t : v; }
    return v;
}
DI int wave_max_i(int v) {
#pragma unroll
    for (int o = 1; o < 64; o <<= 1) { const int t = __shfl_xor(v, o); v = t > v ? t : v; }
    return v;
}
DI int lane_id() { int l; asm volatile("v_mbcnt_lo_u32_b32 %0, -1, 0\n\tv_mbcnt_hi_u32_b32 %0, -1, %0" : "=v"(l)); return l; }
DI float fast_exp2(float x) { return __builtin_amdgcn_exp2f(x); }
DI float fast_rcp(float x) { return __builtin_amdgcn_rcpf(x); }
DI float sigmoidf_fast(float v) { return fast_rcp(1.0f + fast_exp2(-v * LOG2E)); }
DI void rope_sincos(int pos, int j, float& sn, float& cs) {
    const double invd[16] = {1.0, 0.5623413251903491, 0.31622776601683794, 0.1778279410038923, 0.1, 0.05623413251903491, 0.03162277660168379, 0.01778279410038923,
                             0.01, 0.005623413251903491, 0.0031622776601683794, 0.001778279410038923, 0.001, 0.0005623413251903491, 0.00031622776601683794, 0.0001778279410038923};
    double inv = invd[0];
#pragma unroll
    for (int t = 1; t < 16; ++t) inv = (j == t) ? invd[t] : inv;
    const double rev = (double)pos * (double)(float)inv * 0.15915494309189535;
    const float fr = (float)(rev - __builtin_floor(rev));
    sn = __builtin_amdgcn_sinf(fr); cs = __builtin_amdgcn_cosf(fr);
}

#define XB_TMO      128
#define XB_XCNT(j)  (256  + 64 * (j))
#define XB_XSUB(j)  (1280 + 64 * (j))
#define XB_XGEN(j)  (2304 + 64 * (j))
#define XB_TOP      3328
#define XB_TOPGEN   3392
#define XCD_BAR_WORDS 3456
#define XB_SPIN_CAP (1u << 18)
DI unsigned xb_ld(unsigned* p)              { return __hip_atomic_load(p, __ATOMIC_RELAXED, __HIP_MEMORY_SCOPE_AGENT); }
DI unsigned xb_add(unsigned* p, unsigned v) { return __hip_atomic_fetch_add(p, v, __ATOMIC_RELAXED, __HIP_MEMORY_SCOPE_AGENT); }
DI unsigned xb_xcc_id() { return (unsigned)__builtin_amdgcn_s_getreg((3 << 11) | 20) & 0xFu; }
#define XB_SPIN(cond, bar) do { unsigned _sp = 0; while (cond) { __builtin_amdgcn_s_sleep(1); \
    if ((++_sp & 255u) == 0u) { if (xb_ld(&(bar)[XB_TMO])) break; if (_sp > XB_SPIN_CAP) { atomicAdd(&(bar)[XB_TMO], 1u); break; } } } } while (0)
struct XcdBarrier { unsigned* bar; unsigned x; volatile LAS unsigned* st; };
DI XcdBarrier xcd_barrier_post(unsigned* bar, volatile LAS unsigned* st) {
    XcdBarrier b; b.bar = bar; b.x = xb_xcc_id(); b.st = st;
    if (threadIdx.x == 0) (void)xb_add(&bar[XB_XCNT(b.x)], 1u);
    return b;
}
DI void xcd_barrier_complete(unsigned* bar, unsigned x, unsigned& nloc, unsigned& nx) {
    const unsigned G = gridDim.x * gridDim.y * gridDim.z;
    unsigned sum, cnt, mine, sp = 0u;
    for (;;) {
        sum = 0u; cnt = 0u; mine = 0u;
#pragma unroll
        for (unsigned j = 0; j < 16; ++j) { const unsigned c = xb_ld(&bar[XB_XCNT(j)]); sum += c; cnt += (c > 0u) ? 1u : 0u; mine = (j == x) ? c : mine; }
        if (sum == G) break;
        __builtin_amdgcn_s_sleep(1);
        if ((++sp & 255u) == 0u) { if (xb_ld(&bar[XB_TMO])) break; if (sp > XB_SPIN_CAP) { atomicAdd(&bar[XB_TMO], 1u); break; } }
    }
    nloc = mine > 0u ? mine : 1u; nx = cnt > 0u ? cnt : 1u;
}
DI void xcd_barrier(const XcdBarrier& b) {
    asm volatile("s_waitcnt vmcnt(0)" ::: "memory");
    __syncthreads();
    if (threadIdx.x == 0) {
        unsigned* bar = b.bar;
        __builtin_amdgcn_s_waitcnt(0);
        unsigned nloc = b.st[0], nx = b.st[1];
        if (nloc == 0u) { xcd_barrier_complete(bar, b.x, nloc, nx); b.st[0] = nloc; b.st[1] = nx; }
        const unsigned old = xb_add(&bar[XB_XSUB(b.x)], 1u);
        const unsigned gen = old / nloc;
        if (old + 1u == (gen + 1u) * nloc) {
            __builtin_amdgcn_fence(__ATOMIC_RELEASE, "agent");
            asm volatile("s_waitcnt vmcnt(0)" ::: "memory");
            const unsigned og = xb_add(&bar[XB_TOP], 1u);
            const unsigned tg = og / nx;
            if (og + 1u == (tg + 1u) * nx) xb_add(&bar[XB_TOPGEN], 1u);
            else XB_SPIN(xb_ld(&bar[XB_TOPGEN]) == tg, bar);
            __builtin_amdgcn_fence(__ATOMIC_ACQUIRE, "agent");
            xb_add(&bar[XB_XGEN(b.x)], 1u);
            asm volatile("s_waitcnt vmcnt(0)" ::: "memory");
        } else {
            XB_SPIN(xb_ld(&bar[XB_XGEN(b.x)]) == gen, bar);
            __builtin_amdgcn_fence(__ATOMIC_ACQUIRE, "agent");
            asm volatile("s_waitcnt vmcnt(0)" ::: "memory");
        }
    }
    __syncthreads();
}

namespace pg8 {
constexpr int BM = 256, BK = 64, HALF = 128, HTB = HALF * BK * 2, STAGE_BYTES = 8 * HTB, NXCD = 8, WGM = 8;
__host__ __device__ __forceinline__ int lds_byte(int r, int c) { const int st = (r >> 4) * 2 + (c >> 5), rr = r & 15, cc = c & 31, ob = rr * 64 + cc * 2; return st * 1024 + (ob ^ (((ob >> 9) & 1) << 5)); }
__host__ __device__ __forceinline__ void stage_rc(int b, int& R, int& C) { const int st = b / 1024, sb = b % 1024, swz = sb ^ (((sb >> 9) & 1) << 5); R = (st >> 1) * 16 + swz / 64; C = (st & 1) * 32 + (swz % 64) / 2; }
__host__ __device__ __forceinline__ int perm32(int rho) { const int n = rho >> 4, i = rho & 15; return 8 * (i >> 2) + 4 * n + (i & 3); }
struct Unit { int pm, pn, a0, a1; };
struct Gemm { const bf16_t* A; const bf16_t* Bt; int K; };

DI void tile_of(int L, int nM, int nN, int& pm, int& pn) {
    const int nwg = nM * nN; int wgid = L;
    { const int q = nwg / NXCD, r = nwg % NXCD, xcd = wgid % NXCD, off = wgid / NXCD; wgid = (xcd < r ? xcd * (q + 1) : r * (q + 1) + (xcd - r) * q) + off; }
    const int nig = WGM * nN, gid = wgid / nig, fm = gid * WGM, gsz = (nM - fm) < WGM ? (nM - fm) : WGM;
    pm = fm + ((wgid % nig) % gsz); pn = (wgid % nig) / gsz;
}
struct StaticOrder {
    int nM, nN, nwg, G, c;
    DI void init(int Mrows, int N, int G_, int c_) { nM = Mrows / BM; nN = N / BM; nwg = nM * nN; G = G_; c = c_; }
    DI bool next(int i, Unit& u) const {
        const long L = (long)i * G + c; if (L >= nwg) return false;
        tile_of((int)L, nM, nN, u.pm, u.pn); u.a0 = 0; u.a1 = 0; return true;
    }
    DI unsigned arow(const Unit&, int) const { return 0u; }
};

template <class Epi, class Sched, bool ALIGN_EPI, bool GATHER>
DI void gemm_phase(LAS unsigned char* lds, const Gemm g, const Sched& S, const Epi& E, int wid) {
    const int lane = lane_id(), tid = wid * 64 + lane, wr = wid >> 2, wc = wid & 3, fr = lane & 15, fq = lane >> 4;
    int K = g.K; asm volatile("" : "+s"(K));
    const int nt = K / BK;
    unsigned voffA[2], voffB[2]; int RA[2];
#pragma unroll
    for (int i = 0; i < 2; ++i) { int R, C; stage_rc(tid * 16 + i * 8192, R, C); const int Rb = Epi::PERM ? ((R & ~31) + perm32(R & 31)) : R;
        voffA[i] = GATHER ? (unsigned)(C * 2) : (unsigned)(R * K + C) * 2u; voffB[i] = (unsigned)(Rb * K + C) * 2u; RA[i] = R; }
    const size_t kstep = (size_t)(BK * 2);
    const size_t hstep = (size_t)HALF * K * 2;
    const size_t tstep = 2 * hstep;
    const unsigned ldsw = (unsigned)wid * 1024u;
    const int aoff = lds_byte(wr * 64 + fr, fq * 8), boff = lds_byte(wc * 32 + fr, fq * 8);
#define PG8_SA(b, h) (((b) * 2 + (h)) * HTB)
#define PG8_SB(b, h) ((4 + (b) * 2 + (h)) * HTB)
#define PG8_STAGE(bufoff, gbase, voff) do { _Pragma("unroll") for (int _i = 0; _i < 2; ++_i) \
        __builtin_amdgcn_global_load_lds((const unsigned*)((const char*)(gbase) + (voff)[_i]), (LAS unsigned*)(lds + (bufoff) + ldsw + _i * 8192), 16, 0, 0); } while (0)
#define PG8_STAGE_A(bufoff, plainptr, hh, kptr, go) do { if constexpr (GATHER) { _Pragma("unroll") for (int _i = 0; _i < 2; ++_i) \
        __builtin_amdgcn_global_load_lds((const unsigned*)((kptr) + (go)[hh][_i]), (LAS unsigned*)(lds + (bufoff) + ldsw + _i * 8192), 16, 0, 0); } \
        else { PG8_STAGE(bufoff, (plainptr) + (hh) * hstep, voffA); } } while (0)
#define PG8_LDA(dst, b, h) do { _Pragma("unroll") for (int m = 0; m < 4; ++m) _Pragma("unroll") for (int k = 0; k < 2; ++k) dst[m][k] = *(const LAS bf16x8*)(lds + PG8_SA(b, h) + aoff + m * 2048 + k * 1024); } while (0)
#define PG8_LDB(dst, b, h) do { _Pragma("unroll") for (int n = 0; n < 2; ++n) _Pragma("unroll") for (int k = 0; k < 2; ++k) dst[n][k] = *(const LAS bf16x8*)(lds + PG8_SB(b, h) + boff + n * 2048 + k * 1024); } while (0)
#define PG8_MMA(ai, bj, At, Bt) do { __builtin_amdgcn_s_setprio(1); _Pragma("unroll") for (int m = 0; m < 4; ++m) _Pragma("unroll") for (int n = 0; n < 2; ++n) _Pragma("unroll") for (int k = 0; k < 2; ++k) \
        acc[ai][bj][m][n] = __builtin_amdgcn_mfma_f32_16x16x32_bf16(Bt[n][k], At[m][k], acc[ai][bj][m][n], 0, 0, 0); __builtin_amdgcn_s_setprio(0); } while (0)
#define PG8_WAIT_V(n) asm volatile("s_waitcnt vmcnt(" #n ")" ::: "memory")
#define PG8_WAIT_L(n) asm volatile("s_waitcnt lgkmcnt(" #n ")" ::: "memory")
#define PG8_BAR __builtin_amdgcn_s_barrier()
#define PG8_SCHED __builtin_amdgcn_sched_barrier(0)
    Unit cur, nxt; int ui = 0;
    if (!S.next(0, cur)) return;
    f32x4 acc[2][2][4][2];
#pragma unroll
    for (int a = 0; a < 2; ++a)
#pragma unroll
        for (int b = 0; b < 2; ++b)
#pragma unroll
            for (int m = 0; m < 4; ++m)
#pragma unroll
                for (int n = 0; n < 2; ++n) acc[a][b][m][n] = (f32x4){0.f, 0.f, 0.f, 0.f};
    bf16x8 At[4][2], B0[2][2], B1[2][2];
    const char* A0 = (const char*)g.A;
    const char* cA = A0 + (GATHER ? (size_t)0 : (size_t)cur.pm * tstep); const char* cB = (const char*)g.Bt + (size_t)cur.pn * tstep;
    unsigned gc[2][2], gn[2][2];
#pragma unroll
    for (int hh = 0; hh < 2; ++hh)
#pragma unroll
        for (int i = 0; i < 2; ++i) { gc[hh][i] = GATHER ? S.arow(cur, hh * HALF + RA[i]) + voffA[i] : 0u; gn[hh][i] = gc[hh][i]; }
    PG8_STAGE(PG8_SB(0, 0), cB, voffB); PG8_STAGE(PG8_SB(0, 1), cB + hstep, voffB); PG8_STAGE_A(PG8_SA(0, 0), cA, 0, A0, gc); PG8_STAGE_A(PG8_SA(0, 1), cA, 1, A0, gc);
    if (wr == 1) PG8_BAR;
    PG8_WAIT_V(2); PG8_BAR;
    PG8_STAGE(PG8_SB(1, 0), cB + kstep, voffB); PG8_STAGE_A(PG8_SA(1, 0), cA + kstep, 0, A0 + kstep, gc); PG8_STAGE(PG8_SB(1, 1), cB + hstep + kstep, voffB);
    PG8_WAIT_V(6); PG8_BAR;
    for (;;) {
        const bool has_next = S.next(ui + 1, nxt);
        const char* nA = has_next ? A0 + (GATHER ? (size_t)0 : (size_t)nxt.pm * tstep) : cA; const char* nB = has_next ? (const char*)g.Bt + (size_t)nxt.pn * tstep : cB;
        if constexpr (GATHER) {
#pragma unroll
            for (int hh = 0; hh < 2; ++hh)
#pragma unroll
                for (int i = 0; i < 2; ++i) gn[hh][i] = has_next ? S.arow(nxt, hh * HALF + RA[i]) + voffA[i] : gc[hh][i];
        }
        for (int t = 0; t < nt; t += 2) {
            if constexpr (Epi::MID) { if (t == (nt >> 1)) { const int l2 = lane_id(); E.mid(acc, cur, wr, wc, l2 & 15, l2 >> 4); } }
            const bool last = (t == nt - 2);
            const char* a1 = cA + (size_t)(t + 1) * kstep;
            const char* a2 = last ? nA : cA + (size_t)(t + 2) * kstep; const char* b2 = last ? nB : cB + (size_t)(t + 2) * kstep;
            const char* a3 = a2 + kstep; const char* b3 = b2 + kstep;
            const char* k1 = A0 + (size_t)(t + 1) * kstep; const char* k2 = A0 + (last ? (size_t)0 : (size_t)(t + 2) * kstep); const char* k3 = k2 + kstep;
            unsigned g2[2][2];
#pragma unroll
            for (int hh = 0; hh < 2; ++hh)
#pragma unroll
                for (int i = 0; i < 2; ++i) g2[hh][i] = last ? gn[hh][i] : gc[hh][i];
            PG8_LDB(B0, 0, 0); PG8_LDB(B1, 0, 1); PG8_SCHED; PG8_LDA(At, 0, 0); PG8_STAGE_A(PG8_SA(1, 1), a1, 1, k1, gc);
            PG8_WAIT_V(8); PG8_WAIT_L(0); PG8_BAR; PG8_MMA(0, 0, At, B0); PG8_MMA(0, 1, At, B1); PG8_BAR; PG8_SCHED;
            PG8_LDA(At, 0, 1); PG8_STAGE(PG8_SB(0, 0), b2, voffB); PG8_STAGE(PG8_SB(0, 1), b2 + hstep, voffB); PG8_STAGE_A(PG8_SA(0, 0), a2, 0, k2, g2);
            PG8_WAIT_V(8); PG8_WAIT_L(0); PG8_BAR; PG8_MMA(1, 0, At, B0); PG8_MMA(1, 1, At, B1); PG8_BAR; PG8_SCHED;
            PG8_LDB(B0, 1, 0); PG8_LDB(B1, 1, 1); PG8_SCHED; PG8_LDA(At, 1, 0); PG8_STAGE_A(PG8_SA(0, 1), a2, 1, k2, g2);
            PG8_WAIT_V(8); PG8_WAIT_L(0); PG8_BAR; PG8_MMA(0, 0, At, B0); PG8_MMA(0, 1, At, B1); PG8_BAR; PG8_SCHED;
            PG8_LDA(At, 1, 1); PG8_STAGE(PG8_SB(1, 0), b3, voffB); PG8_STAGE(PG8_SB(1, 1), b3 + hstep, voffB); PG8_STAGE_A(PG8_SA(1, 0), a3, 0, k3, g2);
            PG8_WAIT_V(8); PG8_WAIT_L(0); PG8_BAR; PG8_MMA(1, 0, At, B0); PG8_MMA(1, 1, At, B1); PG8_BAR; PG8_SCHED;
        }
        if constexpr (ALIGN_EPI) { if (wr == 0) PG8_BAR; }
        { const int l2 = lane_id(); E(acc, cur, wr, wc, l2 & 15, l2 >> 4); }
        if (!has_next) break;
#pragma unroll
        for (int a = 0; a < 2; ++a)
#pragma unroll
            for (int b = 0; b < 2; ++b)
#pragma unroll
                for (int m = 0; m < 4; ++m)
#pragma unroll
                    for (int n = 0; n < 2; ++n) acc[a][b][m][n] = (f32x4){0.f, 0.f, 0.f, 0.f};
        cur = nxt; cA = nA; cB = nB; ++ui;
#pragma unroll
        for (int hh = 0; hh < 2; ++hh)
#pragma unroll
            for (int i = 0; i < 2; ++i) gc[hh][i] = gn[hh][i];
        if constexpr (ALIGN_EPI) { if (wr == 1) PG8_BAR; }
    }
    PG8_WAIT_V(0);
    if constexpr (!ALIGN_EPI) { if (wr == 0) PG8_BAR; }
    PG8_BAR;
#undef PG8_SA
#undef PG8_SB
#undef PG8_STAGE
#undef PG8_STAGE_A
#undef PG8_LDA
#undef PG8_LDB
#undef PG8_MMA
#undef PG8_WAIT_V
#undef PG8_WAIT_L
#undef PG8_BAR
#undef PG8_SCHED
}
}
using pg8::Unit;

struct Args { const void* in[27]; float* out; unsigned char* ws; int ph_lo, ph_hi; };
struct Ctx {
    const float *x, *ln0_g, *ln0_b, *w_in, *q_norm_g, *w_uq, *kv_norm_g, *w_uk, *w_uv, *rel_bias, *w_up_a, *w_up_b, *w_gate, *b_gate, *w_o, *ln1_g, *ln1_b,
                *w_grp, *b_grp, *w_rt, *b_rt, *w_eg, *w_eu, *w_ed, *ln2_g, *ln2_b;
    const int* pos;
    float* out; unsigned char* ws;
    LAS unsigned char* lds;
    int G, bid, wid;
};
constexpr int LDS_RING = 131072;
constexpr int LDS_MISC = LDS_RING;
constexpr int LDS_LG = LDS_RING + 4096;
constexpr int LDS_BYTES = LDS_RING + 4096 + 8192;
template <class T> DI T* wsp(const Ctx& X, size_t off) { return (T*)(X.ws + off); }

DI void tr_item(const float* W, int ld, int K, int ncols, bf16_t* WT, const float* scale, LAS float* scr, int item, int lane, int ldd = 0) {
    if (ldd == 0) ldd = K;
    const int nblk = (ncols + 31) >> 5, kb = item / nblk, nb = item - kb * nblk, k0 = 64 * kb, n0 = 32 * nb;
    const int n4 = 4 * (lane & 7), kr = lane >> 3;
    f32x4 v[8];
#pragma unroll
    for (int i = 0; i < 8; ++i) { const int kk = 8 * i + kr; v[i] = (n0 + n4 + 3 < ncols) ? *(const f32x4*)(W + (size_t)(k0 + kk) * ld + n0 + n4) : (f32x4){0.f, 0.f, 0.f, 0.f}; }
#pragma unroll
    for (int i = 0; i < 8; ++i) { const int kk = 8 * i + kr; f32x4 t = v[i]; if (scale) t = t * scale[k0 + kk];
        scr[kk * 33 + n4] = t[0]; scr[kk * 33 + n4 + 1] = t[1]; scr[kk * 33 + n4 + 2] = t[2]; scr[kk * 33 + n4 + 3] = t[3]; }
    asm volatile("s_waitcnt lgkmcnt(0)" ::: "memory");
    const int c = lane & 7;
#pragma unroll
    for (int j = 0; j < 4; ++j) { const int n = (lane >> 3) + 8 * j; const LAS float* s = scr + (8 * c) * 33 + n;
        u32x4 o; o.x = pk2(s[0 * 33], s[1 * 33]); o.y = pk2(s[2 * 33], s[3 * 33]); o.z = pk2(s[4 * 33], s[5 * 33]); o.w = pk2(s[6 * 33], s[7 * 33]);
        if (n0 + n < ncols) *(u32x4*)(WT + (size_t)(n0 + n) * ldd + k0 + 8 * c) = o; }
    asm volatile("s_waitcnt lgkmcnt(0)" ::: "memory");
}
constexpr int tr_items(int K, int ncols) { return (K / 64) * ((ncols + 31) / 32); }

DI void p0_prologue(const Ctx& X) {
    const int lane = lane_id(), wave = X.wid, tid = wave * 64 + lane;
    LAS float* scr = (LAS float*)(X.lds + wave * 16384);
    const int gw = X.bid * 8 + wave, NGW = X.G * 8;
    bf16_t* WT1 = wsp<bf16_t>(X, WS_WT1);
    {
        constexpr int seg_c0[9] = {0, 256, 384, 1312, 928, 416, 1056, 992, 1344};
        constexpr int seg_nc[9] = {256, 128, 32, 32, 64, 512, 256, 64, 8};
        constexpr int seg_d0[9] = {0, 256, 384, 416, 448, 512, 1024, 1280, 1344};
        constexpr int N_GU = 128 * tr_items(1024, 128), N_DN = 32 * tr_items(256, 1024);
        constexpr int N_IN = tr_items(1024, 256) + tr_items(1024, 128) + tr_items(1024, 32) * 2 + tr_items(1024, 64) * 2 + tr_items(1024, 512) + tr_items(1024, 256) + tr_items(1024, 8);
        constexpr int N_NAMED = N_IN + tr_items(1024, 2048) + tr_items(256, 768) + 2 * tr_items(128, 512) + 2 * tr_items(512, 1024) + tr_items(1024, 1024);
        constexpr int N_ALL = N_GU + N_DN + N_NAMED;
        for (int it = gw; it < N_ALL; it += NGW) {
            int r = it;
            if (r < N_GU) { constexpr int per = tr_items(1024, 128); const int job = r / per, rr = r - job * per, e = job >> 2, pn = (job >> 1) & 1, bj = job & 1;
                tr_item((bj ? X.w_eu : X.w_eg) + (size_t)e * 1024 * 256 + 128 * pn, 256, 1024, 128, wsp<bf16_t>(X, WS_WEGUT) + ((size_t)e * 512 + 256 * pn + 128 * bj) * 1024, nullptr, scr, rr, lane); continue; }
            r -= N_GU;
            if (r < N_DN) { constexpr int per = tr_items(256, 1024); const int e = r / per, rr = r - e * per;
                tr_item(X.w_ed + (size_t)e * 256 * 1024, 1024, 256, 1024, wsp<bf16_t>(X, WS_WEDT) + (size_t)e * 1024 * 256, nullptr, scr, rr, lane); continue; }
            r -= N_DN;
            bool done = false;
#pragma unroll
            for (int sg = 0; sg < 9; ++sg) { const int n = tr_items(1024, seg_nc[sg]);
                if (!done && r < n) { tr_item(X.w_in + seg_c0[sg], 1352, 1024, seg_nc[sg], WT1 + (size_t)seg_d0[sg] * 1024, nullptr, scr, r, lane); done = true; }
                if (!done) r -= n; }
            if (done) continue;
            if (r < tr_items(1024, 2048)) { tr_item(X.w_gate, 2048, 1024, 2048, WT1 + (size_t)1536 * 1024, nullptr, scr, r, lane); continue; } r -= tr_items(1024, 2048);
            if (r < tr_items(256, 768)) { tr_item(X.w_uq, 768, 256, 768, wsp<bf16_t>(X, WS_WUQT), X.q_norm_g, scr, r, lane); continue; } r -= tr_items(256, 768);
            if (r < tr_items(128, 512)) { tr_item(X.w_uk, 512, 128, 512, wsp<bf16_t>(X, WS_WUKVT), X.kv_norm_g, scr, r, lane); continue; } r -= tr_items(128, 512);
            if (r < tr_items(128, 512)) { tr_item(X.w_uv, 512, 128, 512, wsp<bf16_t>(X, WS_WUKVT) + 512 * 128, X.kv_norm_g, scr, r, lane); continue; } r -= tr_items(128, 512);
            if (r < tr_items(512, 1024)) { tr_item(X.w_up_a, 1024, 512, 1024, wsp<bf16_t>(X, WS_WUPT), nullptr, scr, r, lane, 1024); continue; } r -= tr_items(512, 1024);
            if (r < tr_items(512, 1024)) { tr_item(X.w_up_b, 1024, 512, 1024, wsp<bf16_t>(X, WS_WUPT) + 512, nullptr, scr, r, lane, 1024); continue; } r -= tr_items(512, 1024);
            tr_item(X.w_o, 1024, 1024, 1024, wsp<bf16_t>(X, WS_WOT), nullptr, scr, r, lane);
        }
    }
    { const int gt = X.bid * 512 + tid, NT = X.G * 512; u32x4 z = {0u, 0u, 0u, 0u};
      for (int i = gt; i < 184 * 1024 / 8; i += NT) *(u32x4*)(WT1 + (size_t)1352 * 1024 + (size_t)i * 8) = z; }
    { const int gt = X.bid * 512 + tid, NT = X.G * 512; bf16_t* WR = wsp<bf16_t>(X, WS_WRT);
      for (int i = gt; i < 64 * 1024; i += NT) { const int j = i >> 10, k = i & 1023;
          const float v = (j < 4) ? X.w_grp[k * 4 + j] : (j < 36 ? X.w_rt[k * 32 + (j - 4)] : 0.f);
          const unsigned hi = pk2(v, 0.f) & 0xffffu; const float lo = v - bf2f((unsigned short)hi);
          WR[(size_t)j * 1024 + k] = (bf16_t)hi; WR[(size_t)(64 + j) * 1024 + k] = (bf16_t)(pk2(lo, 0.f) & 0xffffu); } }
    { const int gt = X.bid * 512 + tid, NT = X.G * 512; float* RT = wsp<float>(X, WS_ROPE);
      for (int i = gt; i < M * 16; i += NT) { const int row = i >> 4, j = i & 15; float sn, cs; rope_sincos(X.pos[row], j, sn, cs); RT[(size_t)row * 32 + j] = cs; RT[(size_t)row * 32 + 16 + j] = sn; } }
    { int* TS = wsp<int>(X, WS_TSTAT);
      for (int t = gw; t < M / 64; t += NGW) { const int p = X.pos[t * 64 + lane]; const int pmin = wave_min_i(p), pmax = wave_max_i(p);
          if (lane == 0) { TS[t * 4 + 0] = pmin >> 6; TS[t * 4 + 1] = pmax >> 6; TS[t * 4 + 2] = pmin; TS[t * 4 + 3] = pmax; } } }
    { bf16_t* XN = wsp<bf16_t>(X, WS_B); float* ST = wsp<float>(X, WS_STATS0);
#if DBG_STAGE == 1
      float* Y1 = wsp<float>(X, WS_A);
#endif
      f32x4 gv[4], bv[4];
#pragma unroll
      for (int j = 0; j < 4; ++j) { gv[j] = *(const f32x4*)(X.ln0_g + 4 * lane + 256 * j); bv[j] = *(const f32x4*)(X.ln0_b + 4 * lane + 256 * j); }
      for (int m = gw; m < M; m += NGW) {
          const f32x4* xr = (const f32x4*)(X.x + (size_t)m * D) + lane;
          f32x4 v[4]; float s = 0.f;
#pragma unroll
          for (int j = 0; j < 4; ++j) { v[j] = xr[64 * j]; s += (v[j].x + v[j].y) + (v[j].z + v[j].w); }
          const float mean = wave_sum(s) * (1.f / D); float s2 = 0.f;
#pragma unroll
          for (int j = 0; j < 4; ++j) { v[j] = v[j] - mean; s2 += (v[j].x * v[j].x + v[j].y * v[j].y) + (v[j].z * v[j].z + v[j].w * v[j].w); }
          const float rstd = 1.f / sqrtf(wave_sum(s2) * (1.f / D) + LN_EPS);
          if (lane == 0) { ST[2 * m] = mean; ST[2 * m + 1] = rstd; }
          u32x2* o8 = (u32x2*)(XN + (size_t)m * D) + lane;
#pragma unroll
          for (int j = 0; j < 4; ++j) { const f32x4 y = v[j] * rstd * gv[j] + bv[j]; u32x2 o; o.x = pk2(y.x, y.y); o.y = pk2(y.z, y.w); o8[64 * j] = o;
#if DBG_STAGE == 1
              *((f32x4*)(Y1 + (size_t)m * D) + lane + 64 * j) = y * ALPHA;
#endif
          }
      } }
}

DI void store8(bf16_t* p, const f32x4& a, const f32x4& b) { u32x4 w; w.x = pk2(a[0], a[1]); w.y = pk2(a[2], a[3]); w.z = pk2(b[0], b[1]); w.w = pk2(b[2], b[3]); *(u32x4*)p = w; }
DI void rope8(f32x4& v0, f32x4& v1, const float* tab, int fq) {
    const float sg = (fq < 2) ? -1.f : 1.f; const int j0 = 8 * (fq & 1);
    const f32x4 c0 = *(const f32x4*)(tab + j0), c1 = *(const f32x4*)(tab + j0 + 4), s0 = *(const f32x4*)(tab + 16 + j0), s1 = *(const f32x4*)(tab + 16 + j0 + 4);
#pragma unroll
    for (int e = 0; e < 4; ++e) {
        const float o0 = __shfl_xor(v0[e], 32), o1 = __shfl_xor(v1[e], 32);
        v0[e] = v0[e] * c0[e] + sg * o0 * s0[e];
        v1[e] = v1[e] * c1[e] + sg * o1 * s1[e];
    }
}
struct Epi1 {
    static constexpr bool PERM = true, MID = false;
    bf16_t *CQ, *CKV, *KR, *KI, *KB, *VB, *QB, *QI, *G; float *WI, *SSQ; const float* rope; const float* bgate;
    DI void operator()(const f32x4 (&acc)[2][2][4][2], const Unit& u, int wr, int wc, int fr_, int fq_) const {
        int fr = fr_, fq = fq_; asm volatile("" : "+v"(fr), "+v"(fq));
        const int pn = u.pn; const int row0 = u.pm * 256 + wr * 64 + fr;
        if (pn >= 6) {
            const int gc0 = (pn - 6) * 256 + 32 * wc + 8 * fq;
#pragma unroll
            for (int bj = 0; bj < 2; ++bj) { const f32x4 b0 = *(const f32x4*)(bgate + gc0 + 128 * bj), b1 = *(const f32x4*)(bgate + gc0 + 128 * bj + 4);
#pragma unroll
                for (int ai = 0; ai < 2; ++ai)
#pragma unroll
                    for (int m = 0; m < 4; ++m) { f32x4 v0 = acc[ai][bj][m][0] + b0, v1 = acc[ai][bj][m][1] + b1;
#pragma unroll
                        for (int e = 0; e < 4; ++e) { v0[e] = sigmoidf_fast(v0[e]); v1[e] = sigmoidf_fast(v1[e]); }
                        store8(G + (size_t)(row0 + ai * 128 + m * 16) * 2048 + gc0 + 128 * bj, v0, v1); } }
        } else if (pn == 0 || pn == 4) {
            bf16_t* O = pn == 0 ? CQ : QI;
#pragma unroll
            for (int ai = 0; ai < 2; ++ai)
#pragma unroll
                for (int m = 0; m < 4; ++m) { const int row = row0 + ai * 128 + m * 16; float s = 0.f;
#pragma unroll
                    for (int bj = 0; bj < 2; ++bj) { const f32x4 v0 = acc[ai][bj][m][0], v1 = acc[ai][bj][m][1];
                        store8(O + (size_t)row * 256 + 128 * bj + 32 * wc + 8 * fq, v0, v1);
                        s += (v0[0] * v0[0] + v0[1] * v0[1]) + (v0[2] * v0[2] + v0[3] * v0[3]) + (v1[0] * v1[0] + v1[1] * v1[1]) + (v1[2] * v1[2] + v1[3] * v1[3]); }
                    if (pn == 0) { s += __shfl_xor(s, 16); s += __shfl_xor(s, 32); if (fq == 0) SSQ[(size_t)row * 8 + wc] = s; } }
        } else if (pn == 2 || pn == 3) {
            const float sc = 0.125f * LOG2E;
#pragma unroll
            for (int ai = 0; ai < 2; ++ai)
#pragma unroll
                for (int m = 0; m < 4; ++m) { const int row = row0 + ai * 128 + m * 16;
#pragma unroll
                    for (int bj = 0; bj < 2; ++bj) store8(QB + (size_t)row * 512 + (pn - 2) * 256 + 128 * bj + 32 * wc + 8 * fq, acc[ai][bj][m][0] * sc, acc[ai][bj][m][1] * sc); }
        } else if (pn == 1) {
#pragma unroll
            for (int ai = 0; ai < 2; ++ai)
#pragma unroll
                for (int m = 0; m < 4; ++m) { const int row = row0 + ai * 128 + m * 16;
                    { const f32x4 v0 = acc[ai][0][m][0], v1 = acc[ai][0][m][1];
                      store8(CKV + (size_t)row * 128 + 32 * wc + 8 * fq, v0, v1);
                      float s = (v0[0] * v0[0] + v0[1] * v0[1]) + (v0[2] * v0[2] + v0[3] * v0[3]) + (v1[0] * v1[0] + v1[1] * v1[1]) + (v1[2] * v1[2] + v1[3] * v1[3]);
                      s += __shfl_xor(s, 16); s += __shfl_xor(s, 32); if (fq == 0) SSQ[(size_t)row * 8 + 4 + wc] = s; }
                    f32x4 v0 = acc[ai][1][m][0], v1 = acc[ai][1][m][1];
                    if (wc == 0) { rope8(v0, v1, rope + (size_t)row * 32, fq); store8(KR + (size_t)row * 32 + 8 * fq, v0, v1); }
                    else if (wc == 1) store8(KI + (size_t)row * 32 + 8 * fq, v0, v1);
                    else store8(KB + (size_t)row * 64 + 32 * (wc - 2) + 8 * fq, v0, v1); }
        } else {
            const float wsc = 0.35355339059327373f * 0.17677669529663687f;
#pragma unroll
            for (int ai = 0; ai < 2; ++ai)
#pragma unroll
                for (int m = 0; m < 4; ++m) { const int row = row0 + ai * 128 + m * 16;
                    if (wc < 2) store8(VB + (size_t)row * 64 + 32 * wc + 8 * fq, acc[ai][0][m][0], acc[ai][0][m][1]);
                    else if (wc == 2 && fq == 0) { *(f32x4*)(WI + (size_t)row * 8) = acc[ai][0][m][0] * wsc; *(f32x4*)(WI + (size_t)row * 8 + 4) = acc[ai][0][m][1] * wsc; } }
        }
    }
};
struct Epi2 {
    static constexpr bool PERM = true, MID = false;
    bf16_t* QM; const float* SSQ; const float* rope;
    DI void operator()(const f32x4 (&acc)[2][2][4][2], const Unit& u, int wr, int wc, int fr_, int fq_) const {
        int fr = fr_, fq = fq_; asm volatile("" : "+v"(fr), "+v"(fq));
        const int row0 = u.pm * 256 + wr * 64 + fr; const float sc = 0.10206207261596575f * LOG2E;
#pragma unroll
        for (int ai = 0; ai < 2; ++ai)
#pragma unroll
            for (int m = 0; m < 4; ++m) { const int row = row0 + ai * 128 + m * 16;
                const f32x4 q4 = *(const f32x4*)(SSQ + (size_t)row * 8); const float rs = sc / sqrtf(((q4[0] + q4[1]) + (q4[2] + q4[3])) * (1.f / 256.f) + RMS_EPS);
#pragma unroll
                for (int bj = 0; bj < 2; ++bj) { const int g32 = 8 * u.pn + 4 * bj + wc; f32x4 v0 = acc[ai][bj][m][0] * rs, v1 = acc[ai][bj][m][1] * rs;
                    if (g32 % 3 == 2) rope8(v0, v1, rope + (size_t)row * 32, fq);
                    store8(QM + (size_t)row * 768 + 32 * g32 + 8 * fq, v0, v1); } }
    }
};
struct Epi3 {
    static constexpr bool PERM = true, MID = false;
    bf16_t *KN, *VM; const float* SSQ;
    DI void operator()(const f32x4 (&acc)[2][2][4][2], const Unit& u, int wr, int wc, int fr_, int fq_) const {
        int fr = fr_, fq = fq_; asm volatile("" : "+v"(fr), "+v"(fq));
        const int row0 = u.pm * 256 + wr * 64 + fr; bf16_t* O = u.pn < 2 ? KN : VM; const int c0 = (u.pn & 1) * 256 + 32 * wc + 8 * fq;
#pragma unroll
        for (int ai = 0; ai < 2; ++ai)
#pragma unroll
            for (int m = 0; m < 4; ++m) { const int row = row0 + ai * 128 + m * 16;
                const f32x4 q4 = *(const f32x4*)(SSQ + (size_t)row * 8 + 4); const float rs = 1.f / sqrtf(((q4[0] + q4[1]) + (q4[2] + q4[3])) * (1.f / 128.f) + RMS_EPS);
#pragma unroll
                for (int bj = 0; bj < 2; ++bj) store8(O + (size_t)row * 512 + c0 + 128 * bj, acc[ai][bj][m][0] * rs, acc[ai][bj][m][1] * rs); }
    }
};
struct Epi4 {
    static constexpr bool PERM = true, MID = true;
    bf16_t* MIX; const bf16_t* G;
    DI void mid(f32x4 (&acc)[2][2][4][2], const Unit& u, int wr, int wc, int fr, int fq) const {
        const int row0 = u.pm * 256 + wr * 64 + fr, c0 = u.pn * 256 + 32 * wc + 8 * fq;
#pragma unroll
        for (int ai = 0; ai < 2; ++ai)
#pragma unroll
            for (int m = 0; m < 4; ++m) { const int row = row0 + ai * 128 + m * 16;
#pragma unroll
                for (int bj = 0; bj < 2; ++bj) { const int c = c0 + 128 * bj;
                    const u32x4 ga = *(const u32x4*)(G + (size_t)row * 2048 + c), gb = *(const u32x4*)(G + (size_t)row * 2048 + 1024 + c);
                    const unsigned gaw[4] = {ga.x, ga.y, ga.z, ga.w}, gbw[4] = {gb.x, gb.y, gb.z, gb.w};
#pragma unroll
                    for (int q = 0; q < 4; ++q) {
                        const float a0 = __uint_as_float(gaw[q] << 16), a1 = __uint_as_float(gaw[q] & 0xffff0000u), b0 = __uint_as_float(gbw[q] << 16), b1 = __uint_as_float(gbw[q] & 0xffff0000u);
                        const float r0 = a0 * fast_rcp(fmaxf(b0, 1e-30f)), r1 = a1 * fast_rcp(fmaxf(b1, 1e-30f));
                        acc[ai][bj][m][q >> 1][2 * (q & 1)] *= r0; acc[ai][bj][m][q >> 1][2 * (q & 1) + 1] *= r1; }
                }
                asm volatile("" ::: "memory"); }
    }
    DI void operator()(const f32x4 (&acc)[2][2][4][2], const Unit& u, int wr, int wc, int fr_, int fq_) const {
        int fr = fr_, fq = fq_; asm volatile("" : "+v"(fr), "+v"(fq));
        const int row0 = u.pm * 256 + wr * 64 + fr, c0 = u.pn * 256 + 32 * wc + 8 * fq;
#pragma unroll
        for (int ai = 0; ai < 2; ++ai)
#pragma unroll
            for (int m = 0; m < 4; ++m) { const int row = row0 + ai * 128 + m * 16;
#pragma unroll
                for (int bj = 0; bj < 2; ++bj) { const int c = c0 + 128 * bj;
                    const u32x4 gw = *(const u32x4*)(G + (size_t)row * 2048 + 1024 + c);
                    f32x4 v0 = acc[ai][bj][m][0], v1 = acc[ai][bj][m][1];
                    v0[0] *= __uint_as_float(gw.x << 16); v0[1] *= __uint_as_float(gw.x & 0xffff0000u); v0[2] *= __uint_as_float(gw.y << 16); v0[3] *= __uint_as_float(gw.y & 0xffff0000u);
                    v1[0] *= __uint_as_float(gw.z << 16); v1[1] *= __uint_as_float(gw.z & 0xffff0000u); v1[2] *= __uint_as_float(gw.w << 16); v1[3] *= __uint_as_float(gw.w & 0xffff0000u);
                    store8(MIX + (size_t)row * 1024 + c, v0, v1); } }
    }
};
struct Epi5 {
    static constexpr bool PERM = false, MID = false;
    float* Y1; const float *x, *ST, *g0, *b0;
    DI void operator()(const f32x4 (&acc)[2][2][4][2], const Unit& u, int wr, int wc, int fr_, int fq_) const {
        int fr = fr_, fq = fq_; asm volatile("" : "+v"(fr), "+v"(fq));
        const int row0 = u.pm * 256 + wr * 64 + fr, c0 = u.pn * 256 + 32 * wc + 4 * fq;
        f32x4 gv[2][2], bv[2][2];
#pragma unroll
        for (int bj = 0; bj < 2; ++bj)
#pragma unroll
            for (int n = 0; n < 2; ++n) { gv[bj][n] = *(const f32x4*)(g0 + c0 + 128 * bj + 16 * n) * ALPHA; bv[bj][n] = *(const f32x4*)(b0 + c0 + 128 * bj + 16 * n) * ALPHA; }
#pragma unroll
        for (int ai = 0; ai < 2; ++ai)
#pragma unroll
            for (int m = 0; m < 4; ++m) { const int row = row0 + ai * 128 + m * 16; const float mean = ST[2 * row], rstd = ST[2 * row + 1];
#pragma unroll
                for (int bj = 0; bj < 2; ++bj)
#pragma unroll
                    for (int n = 0; n < 2; ++n) { const size_t off = (size_t)row * 1024 + c0 + 128 * bj + 16 * n;
                        const f32x4 xv = *(const f32x4*)(x + off);
                        *(f32x4*)(Y1 + off) = (xv - mean) * rstd * gv[bj][n] + bv[bj][n] + acc[ai][bj][m][n]; } }
    }
};
struct MoeOrder {
    const LAS int* tstart;
    const LAS int* scnt;
    const int* LIST; int K2;
    int NT, G, c, ntiles;
    DI bool next(int i, Unit& u) const {
        const long L = (long)i * G + c; if (L >= (long)ntiles * NT) return false;
        const int tile = (int)(L / NT), pn = (int)(L - (long)tile * NT);
        int lo = 0, hi = NSEG;
#pragma unroll
        for (int s = 0; s < 6; ++s) { const int mid = (lo + hi) >> 1; if (tstart[mid] <= tile) lo = mid; else hi = mid; }
        const int ts = tstart[lo];
        u.pm = tile; u.pn = __builtin_amdgcn_readfirstlane((lo & 31) * NT + pn); u.a0 = __builtin_amdgcn_readfirstlane(lo); u.a1 = __builtin_amdgcn_readfirstlane(tile - ts); return true;
    }
    DI unsigned arow(const Unit& u, int r) const { const int idx = u.a1 * 256 + r; const int tok = LIST[(size_t)u.a0 * M + (idx < scnt[u.a0] ? idx : 0)]; return (unsigned)tok * (unsigned)K2; }
};
struct Epi7 {
    static constexpr bool PERM = true, MID = false;
    bf16_t* HID; const float* LISTW; const LAS int* scnt;
    DI void operator()(const f32x4 (&acc)[2][2][4][2], const Unit& u, int wr, int wc, int fr_, int fq_) const {
        int fr = fr_, fq = fq_; asm volatile("" : "+v"(fr), "+v"(fq));
        const int c0 = (u.pn & 1) * 128 + 32 * wc + 8 * fq, cnt = scnt[u.a0];
#pragma unroll
        for (int ai = 0; ai < 2; ++ai)
#pragma unroll
            for (int m = 0; m < 4; ++m) { const int r = ai * 128 + wr * 64 + m * 16 + fr, idx = u.a1 * 256 + r;
                const float w = idx < cnt ? LISTW[(size_t)u.a0 * M + idx] : 0.f;
                f32x4 v0, v1;
#pragma unroll
                for (int e = 0; e < 4; ++e) { const float a0 = acc[ai][0][m][0][e], a1 = acc[ai][0][m][1][e];
                    v0[e] = a0 * sigmoidf_fast(a0) * acc[ai][1][m][0][e] * w; v1[e] = a1 * sigmoidf_fast(a1) * acc[ai][1][m][1][e] * w; }
                store8(HID + ((size_t)u.pm * 256 + r) * 256 + c0, v0, v1); }
    }
};
struct Epi8 {
    static constexpr bool PERM = true, MID = false;
    bf16_t* PP; const int* LIST; const LAS int* scnt;
    DI void operator()(const f32x4 (&acc)[2][2][4][2], const Unit& u, int wr, int wc, int fr_, int fq_) const {
        int fr = fr_, fq = fq_; asm volatile("" : "+v"(fr), "+v"(fq));
        const int c0 = (u.pn & 3) * 256 + 32 * wc + 8 * fq, cnt = scnt[u.a0]; bf16_t* O = PP + (size_t)(u.a0 >> 5) * M * 1024;
#pragma unroll
        for (int ai = 0; ai < 2; ++ai)
#pragma unroll
            for (int m = 0; m < 4; ++m) { const int r = ai * 128 + wr * 64 + m * 16 + fr, idx = u.a1 * 256 + r;
                if (idx < cnt) { const int tok = LIST[(size_t)u.a0 * M + idx];
#pragma unroll
                    for (int bj = 0; bj < 2; ++bj) store8(O + (size_t)tok * 1024 + c0 + 128 * bj, acc[ai][bj][m][0], acc[ai][bj][m][1]); }
                asm volatile("" ::: "memory"); }
    }
};


DI void p6_ln1_router(const Ctx& X) {
    const int lane = lane_id(), wave = X.wid, tid = wave * 64 + lane, r = lane & 31, hh = lane >> 5;
    LAS unsigned char* HI = X.lds; LAS unsigned char* LO = X.lds + 65536;
    LAS float* LG = (LAS float*)(X.lds + LDS_LG);
    const float* Y1 = wsp<float>(X, WS_A); float* ST1 = wsp<float>(X, WS_STATS1); bf16_t* HB = wsp<bf16_t>(X, WS_B);
    const bf16_t* WR = wsp<bf16_t>(X, WS_WRT);
    unsigned* CNT = wsp<unsigned>(X, WS_CTL) + CW_CNT; int* LIST = wsp<int>(X, WS_LIST); float* LISTW = wsp<float>(X, WS_LISTW);
    f32x4 gv[4], bv[4];
#pragma unroll
    for (int j = 0; j < 4; ++j) { gv[j] = *(const f32x4*)(X.ln1_g + 4 * lane + 256 * j); bv[j] = *(const f32x4*)(X.ln1_b + 4 * lane + 256 * j); }
    for (int unit = X.bid; unit < M / 32; unit += X.G) {
        *(LAS f32x4*)(LG + tid * 4) = (f32x4){0.f, 0.f, 0.f, 0.f};
        f32x4 vv[4][4];
#pragma unroll
        for (int rr = 0; rr < 4; ++rr) { const f32x4* yr = (const f32x4*)(Y1 + (size_t)(unit * 32 + wave * 4 + rr) * D) + lane;
#pragma unroll
            for (int j = 0; j < 4; ++j) vv[rr][j] = yr[64 * j]; }
#pragma unroll
        for (int rr = 0; rr < 4; ++rr) {
            const int rl = wave * 4 + rr, m = unit * 32 + rl;
            f32x4 v[4]; float s = 0.f;
#pragma unroll
            for (int j = 0; j < 4; ++j) { v[j] = vv[rr][j]; s += (v[j].x + v[j].y) + (v[j].z + v[j].w); }
            const float mean = wave_sum(s) * (1.f / D); float s2 = 0.f;
#pragma unroll
            for (int j = 0; j < 4; ++j) { v[j] = v[j] - mean; s2 += (v[j].x * v[j].x + v[j].y * v[j].y) + (v[j].z * v[j].z + v[j].w * v[j].w); }
            const float rstd = 1.f / sqrtf(wave_sum(s2) * (1.f / D) + LN_EPS);
            if (lane == 0) { ST1[2 * m] = mean; ST1[2 * m + 1] = rstd; }
#pragma unroll
            for (int j = 0; j < 4; ++j) {
                const f32x4 y = v[j] * rstd * gv[j] + bv[j];
                u32x2 hi; hi.x = pk2(y.x, y.y); hi.y = pk2(y.z, y.w);
                *((u32x2*)(HB + (size_t)m * D) + lane + 64 * j) = hi;
                const float l0 = y.x - __uint_as_float(hi.x << 16), l1 = y.y - __uint_as_float(hi.x & 0xffff0000u), l2 = y.z - __uint_as_float(hi.y << 16), l3 = y.w - __uint_as_float(hi.y & 0xffff0000u);
                u32x2 lo; lo.x = pk2(l0, l1); lo.y = pk2(l2, l3);
                const int chunk = (lane >> 1) + 32 * j; const unsigned byte = (unsigned)rl * 2048u + (unsigned)((chunk ^ (rl & 15)) * 16) + 8u * (lane & 1);
                *(LAS u32x2*)(HI + byte) = hi; *(LAS u32x2*)(LO + byte) = lo;
            }
        }
        __syncthreads();
        {
            f32x16 a0, a1;
#pragma unroll
            for (int e = 0; e < 16; ++e) { a0[e] = 0.f; a1[e] = 0.f; }
#pragma unroll
            for (int ks = 0; ks < 8; ++ks) {
                const int ch = 16 * wave + 2 * ks + hh; const unsigned byte = (unsigned)r * 2048u + (unsigned)((ch ^ (r & 15)) * 16);
                const bf16x8 ahi = *(const LAS bf16x8*)(HI + byte), alo = *(const LAS bf16x8*)(LO + byte);
                const size_t ko = (size_t)(128 * wave + 16 * ks + 8 * hh);
                const bf16x8 bh0 = *(const bf16x8*)(WR + (size_t)r * 1024 + ko), bh1 = *(const bf16x8*)(WR + (size_t)(32 + r) * 1024 + ko);
                const bf16x8 bl0 = *(const bf16x8*)(WR + (size_t)(64 + r) * 1024 + ko), bl1 = *(const bf16x8*)(WR + (size_t)(96 + r) * 1024 + ko);
                a0 = __builtin_amdgcn_mfma_f32_32x32x16_bf16(ahi, bh0, a0, 0, 0, 0); a0 = __builtin_amdgcn_mfma_f32_32x32x16_bf16(ahi, bl0, a0, 0, 0, 0); a0 = __builtin_amdgcn_mfma_f32_32x32x16_bf16(alo, bh0, a0, 0, 0, 0);
                a1 = __builtin_amdgcn_mfma_f32_32x32x16_bf16(ahi, bh1, a1, 0, 0, 0); a1 = __builtin_amdgcn_mfma_f32_32x32x16_bf16(ahi, bl1, a1, 0, 0, 0); a1 = __builtin_amdgcn_mfma_f32_32x32x16_bf16(alo, bh1, a1, 0, 0, 0);
            }
#pragma unroll
            for (int e = 0; e < 16; ++e) { const int row = (e & 3) + 8 * (e >> 2) + 4 * hh;
                __hip_atomic_fetch_add(LG + row * 64 + r, a0[e], __ATOMIC_RELAXED, __HIP_MEMORY_SCOPE_WORKGROUP);
                if (r < 4) __hip_atomic_fetch_add(LG + row * 64 + 32 + r, a1[e], __ATOMIC_RELAXED, __HIP_MEMORY_SCOPE_WORKGROUP); }
        }
        __syncthreads();
        if (tid < 32) {
            const LAS float* lg = LG + tid * 64; const int token = unit * 32 + tid;
            float gl[4]; float gmax = -3.4e38f; int gsel = 0;
#pragma unroll
            for (int j = 0; j < 4; ++j) { gl[j] = lg[j] + X.b_grp[j]; if (gl[j] > gmax) { gmax = gl[j]; gsel = j; } }
            float gz = 0.f;
#pragma unroll
            for (int j = 0; j < 4; ++j) gz += expf(gl[j] - gmax);
            const float gw = 1.f / gz;
            float e0 = -3.4e38f, e1 = -3.4e38f; int i0 = 0, i1 = 0;
#pragma unroll
            for (int j = 0; j < 8; ++j) { const float v = lg[4 + gsel * 8 + j] + X.b_rt[gsel * 8 + j];
                if (v > e0) { e1 = e0; i1 = i0; e0 = v; i0 = j; } else if (v > e1) { e1 = v; i1 = j; } }
            const float t = expf(e1 - e0), c0 = gw / (1.f + t), c1 = gw * t / (1.f + t);
            const int s0 = gsel * 8 + i0, s1 = 32 + gsel * 8 + i1;
            const unsigned p0 = __hip_atomic_fetch_add(CNT + s0, 1u, __ATOMIC_RELAXED, __HIP_MEMORY_SCOPE_AGENT);
            const unsigned p1 = __hip_atomic_fetch_add(CNT + s1, 1u, __ATOMIC_RELAXED, __HIP_MEMORY_SCOPE_AGENT);
            LIST[(size_t)s0 * M + p0] = token; LISTW[(size_t)s0 * M + p0] = c0;
            LIST[(size_t)s1 * M + p1] = token; LISTW[(size_t)s1 * M + p1] = c1;
        }
        __syncthreads();
    }
}

DI void moe_prep(const Ctx& X) {
    const int tid = X.wid * 64 + lane_id();
    LAS int* tstart = (LAS int*)(X.lds + LDS_MISC + 64); LAS int* scnt = (LAS int*)(X.lds + LDS_MISC + 512);
    unsigned* CNT = wsp<unsigned>(X, WS_CTL) + CW_CNT;
    if (tid < NSEG) scnt[tid] = (int)__hip_atomic_load(CNT + tid, __ATOMIC_RELAXED, __HIP_MEMORY_SCOPE_AGENT);
    __syncthreads();
    if (tid == 0) { int a = 0; for (int s = 0; s < NSEG; ++s) { tstart[s] = a; a += (scnt[s] + 255) >> 8; } tstart[NSEG] = a; }
    __syncthreads();
}

DI void p9_ln2(const Ctx& X) {
    const int lane = lane_id(), wave = X.wid;
    const int gw = X.bid * 8 + wave, NGW = X.G * 8;
    const float* Y1 = wsp<float>(X, WS_A); const float* ST1 = wsp<float>(X, WS_STATS1); const bf16_t* PP0 = wsp<bf16_t>(X, WS_C); const bf16_t* PP1 = PP0 + (size_t)M * 1024;
    f32x4 gv[4], bv[4], g1[4], b1[4];
#pragma unroll
    for (int j = 0; j < 4; ++j) { gv[j] = *(const f32x4*)(X.ln2_g + 4 * lane + 256 * j); bv[j] = *(const f32x4*)(X.ln2_b + 4 * lane + 256 * j);
        g1[j] = *(const f32x4*)(X.ln1_g + 4 * lane + 256 * j) * ALPHA; b1[j] = *(const f32x4*)(X.ln1_b + 4 * lane + 256 * j) * ALPHA; }
    for (int m = gw; m < M; m += NGW) {
        f32x4 v[4]; float s = 0.f; const float mean1 = ST1[2 * m], rstd1 = ST1[2 * m + 1];
#pragma unroll
        for (int j = 0; j < 4; ++j) {
            const f32x4 yv = *((const f32x4*)(Y1 + (size_t)m * D) + lane + 64 * j);
            const u32x2 a = *((const u32x2*)(PP0 + (size_t)m * D) + lane + 64 * j), b = *((const u32x2*)(PP1 + (size_t)m * D) + lane + 64 * j);
            f32x4 y = (yv - mean1) * rstd1 * g1[j] + b1[j];
            y.x += __uint_as_float(a.x << 16) + __uint_as_float(b.x << 16); y.y += __uint_as_float(a.x & 0xffff0000u) + __uint_as_float(b.x & 0xffff0000u);
            y.z += __uint_as_float(a.y << 16) + __uint_as_float(b.y << 16); y.w += __uint_as_float(a.y & 0xffff0000u) + __uint_as_float(b.y & 0xffff0000u);
            v[j] = y; s += (y.x + y.y) + (y.z + y.w);
        }
        const float mean = wave_sum(s) * (1.f / D); float s2 = 0.f;
#pragma unroll
        for (int j = 0; j < 4; ++j) { v[j] = v[j] - mean; s2 += (v[j].x * v[j].x + v[j].y * v[j].y) + (v[j].z * v[j].z + v[j].w * v[j].w); }
        const float rstd = 1.f / sqrtf(wave_sum(s2) * (1.f / D) + LN_EPS);
#pragma unroll
        for (int j = 0; j < 4; ++j) *((f32x4*)(X.out + (size_t)m * D) + lane + 64 * j) = v[j] * rstd * gv[j] + bv[j];
    }
}

#define MFMA32(a, b, c) __builtin_amdgcn_mfma_f32_32x32x16_bf16((a), (b), (c), 0, 0, 0)
DI bf16x8 pack8(const f32x16& x, int s) {
    u32x4 p; p.x = pk2(x[8 * s + 0], x[8 * s + 1]); p.y = pk2(x[8 * s + 2], x[8 * s + 3]); p.z = pk2(x[8 * s + 4], x[8 * s + 5]); p.w = pk2(x[8 * s + 6], x[8 * s + 7]);
    return __builtin_bit_cast(bf16x8, p);
}
struct TrRegs { s16x4 t0, t1, t2, t3, t4, t5, t6, t7; };
DI void tr_issue8(unsigned addr, TrRegs& T) {
    asm volatile("ds_read_b64_tr_b16 %0, %8\n\tds_read_b64_tr_b16 %1, %8 offset:1024\n\tds_read_b64_tr_b16 %2, %8 offset:2048\n\tds_read_b64_tr_b16 %3, %8 offset:3072\n\t"
                 "ds_read_b64_tr_b16 %4, %8 offset:4096\n\tds_read_b64_tr_b16 %5, %8 offset:5120\n\tds_read_b64_tr_b16 %6, %8 offset:6144\n\tds_read_b64_tr_b16 %7, %8 offset:7168"
                 : "=&v"(T.t0), "=&v"(T.t1), "=&v"(T.t2), "=&v"(T.t3), "=&v"(T.t4), "=&v"(T.t5), "=&v"(T.t6), "=&v"(T.t7) : "v"(addr) : "memory");
}
DI void tr_wait(TrRegs& A, TrRegs& B) {
    asm volatile("s_waitcnt lgkmcnt(0)" : "+v"(A.t0), "+v"(A.t1), "+v"(A.t2), "+v"(A.t3), "+v"(A.t4), "+v"(A.t5), "+v"(A.t6), "+v"(A.t7),
                 "+v"(B.t0), "+v"(B.t1), "+v"(B.t2), "+v"(B.t3), "+v"(B.t4), "+v"(B.t5), "+v"(B.t6), "+v"(B.t7) :: "memory");
}
DI void tr_frags(const TrRegs& T, bf16x8 (&vf)[4]) {
    vf[0] = __builtin_shufflevector(T.t0, T.t1, 0, 1, 2, 3, 4, 5, 6, 7); vf[1] = __builtin_shufflevector(T.t2, T.t3, 0, 1, 2, 3, 4, 5, 6, 7);
    vf[2] = __builtin_shufflevector(T.t4, T.t5, 0, 1, 2, 3, 4, 5, 6, 7); vf[3] = __builtin_shufflevector(T.t6, T.t7, 0, 1, 2, 3, 4, 5, 6, 7);
}
DI float xhalf_max(float x) {
    const unsigned u = __float_as_uint(x);
    const auto r = __builtin_amdgcn_permlane32_swap(u, u, false, false);
    return fmaxf(__uint_as_float(r[0]), __uint_as_float(r[1]));
}
constexpr float M_FLOOR = -64.f, SM_THR = 4.f;
DI void softmax_tile(f32x16& s0, f32x16& s1, float& meff, float& lrun, f32x16& o0, f32x16& o1, bf16x8 (&pf)[4]) {
    float mx = fmaxf(s0[0], s1[0]);
#pragma unroll
    for (int e = 1; e < 16; ++e) mx = fmaxf(mx, fmaxf(s0[e], s1[e]));
    mx = xhalf_max(mx);
    if (__any(mx > SM_THR)) {
        const float delta = fmaxf(mx, 0.f), alpha = fast_exp2(-delta);
#pragma unroll
        for (int e = 0; e < 16; ++e) { s0[e] -= delta; s1[e] -= delta; o0[e] *= alpha; o1[e] *= alpha; }
        lrun *= alpha; meff += delta;
    }
    float ls = 0.f;
#pragma unroll
    for (int e = 0; e < 16; ++e) { s0[e] = fast_exp2(s0[e]); s1[e] = fast_exp2(s1[e]); ls += s0[e] + s1[e]; }
    lrun += ls;
    pf[0] = pack8(s0, 0); pf[1] = pack8(s0, 1); pf[2] = pack8(s1, 0); pf[3] = pack8(s1, 1);
}
DI int next_tile(const int* TS, int j, int qmax) { for (++j; j < 32; ++j) if (TS[j * 4] <= qmax) break; return j; }

DI void mla_unit(const Ctx& X, int b, int h, int qb) {
    const int lane = lane_id(), w = X.wid, tid = w * 64 + lane, r = lane & 31, hh = lane >> 5;
    LAS unsigned char* lds = X.lds; const unsigned ldsb = (unsigned)(uintptr_t)lds;
    const int tok0 = b * SEQ;
    const bf16_t* QM = wsp<bf16_t>(X, WS_QM); const bf16_t* KN = wsp<bf16_t>(X, WS_KN); const bf16_t* VM = wsp<bf16_t>(X, WS_VM); const bf16_t* KR = wsp<bf16_t>(X, WS_KR);
    bf16_t* OA = wsp<bf16_t>(X, WS_B);
    const int* TS = wsp<int>(X, WS_TSTAT) + (size_t)b * 32 * 4;
    const int qrow = tok0 + qb * 256 + w * 32 + r;
    bf16x8 qf[6];
#pragma unroll
    for (int s = 0; s < 6; ++s) qf[s] = *(const bf16x8*)(QM + (size_t)qrow * 768 + h * 96 + 16 * s + 8 * hh);
    const int qc = X.pos[qrow] >> 6;
    const i32x4 tsv = *(const i32x4*)(TS + 4 * (lane & 31));
    int qmin = 0x7fffffff, qmax = -0x7fffffff - 1;
#pragma unroll
    for (int t = 0; t < 4; ++t) { const int a = __builtin_amdgcn_readlane(tsv[0], qb * 4 + t), c = __builtin_amdgcn_readlane(tsv[1], qb * 4 + t); qmin = a < qmin ? a : qmin; qmax = c > qmax ? c : qmax; }
    unsigned procm = (unsigned)__ballot(lane < 32 && tsv[0] <= qmax);
    const unsigned maskm = (unsigned)__ballot(lane < 32 && tsv[1] > qmin);
    f32x16 o0, o1;
#pragma unroll
    for (int e = 0; e < 16; ++e) { o0[e] = 0.f; o1[e] = 0.f; }
    float mrun = M_FLOOR, lrun = 0.f;
    const int key_a = tid >> 3, ch_a = tid & 7, key_r = (tid >> 2) & 63, ch_r = tid & 3;
    const unsigned kdst = 192u * key_a + 16u * (ch_a ^ ((key_a >> 2) & 3)), vdst = 12288u + 128u * key_a + 16u * (ch_a ^ (((key_a >> 1) & 1) << 2));
    const unsigned rdst = 192u * key_r + 16u * ((8 + ch_r) ^ ((key_r >> 2) & 3));
    constexpr unsigned BUFB = 20736u;
    const int q4 = (lane & 15) >> 2, p4 = lane & 3, blk = (lane >> 4) & 1, sw = (q4 >> 1) & 1;
    const unsigned vbase = ldsb + 12288u + 128u * (4 * hh + q4) + 16u * (2 * blk + (p4 >> 1)) + 8u * (p4 & 1);
    const unsigned va0 = vbase + 64u * sw, va1 = vbase + 64u * (1 - sw);
    u32x4 rk, rv, rr = {0u, 0u, 0u, 0u}; int rkc = 0;
#define MLA_LOAD(j) do { const size_t t0_ = (size_t)tok0 + (size_t)(j) * 64; rk = *(const u32x4*)(KN + (t0_ + key_a) * 512 + h * 64 + ch_a * 8); rv = *(const u32x4*)(VM + (t0_ + key_a) * 512 + h * 64 + ch_a * 8); \
        if (tid < 256) rr = *(const u32x4*)(KR + (t0_ + key_r) * 32 + ch_r * 8); if (tid < 64) rkc = X.pos[t0_ + tid]; } while (0)
#define MLA_STORE(bo) do { *(LAS u32x4*)(lds + (bo) + kdst) = rk; *(LAS u32x4*)(lds + (bo) + vdst) = rv; if (tid < 256) *(LAS u32x4*)(lds + (bo) + rdst) = rr; if (tid < 64) *(LAS int*)(lds + (bo) + 20480u + 4u * tid) = rkc >> 6; } while (0)
    asm volatile("" :: "v"(qf[0]), "v"(qf[1]), "v"(qf[2]), "v"(qf[3]), "v"(qf[4]), "v"(qf[5]));
    int j = procm ? __builtin_ctz(procm) : 32; procm &= procm - 1u;
    unsigned cur = 0;
    if (j < 32) { MLA_LOAD(j); MLA_STORE(0u); }
    __syncthreads();
    f32x16 s0, s1; bf16x8 pf[4];
#define MLA_QK(bo_, j_) do { const float nm = -mrun; \
        if ((maskm >> (j_)) & 1u) { _Pragma("unroll") for (int g = 0; g < 4; ++g) { \
                const i32x4 c0 = *(const LAS i32x4*)(lds + (bo_) + 20480u + 4u * (8 * g + 4 * hh)), c1 = *(const LAS i32x4*)(lds + (bo_) + 20480u + 4u * (32 + 8 * g + 4 * hh)); \
                _Pragma("unroll") for (int e = 0; e < 4; ++e) { s0[4 * g + e] = c0[e] > qc ? NEGF : nm; s1[4 * g + e] = c1[e] > qc ? NEGF : nm; } } } \
        else { _Pragma("unroll") for (int e = 0; e < 16; ++e) { s0[e] = nm; s1[e] = nm; } } \
        _Pragma("unroll") for (int ks = 0; ks < 6; ++ks) { const unsigned ko = 192u * r + 16u * ((2 * ks + hh) ^ ((r >> 2) & 3)); \
            const bf16x8 a0 = *(const LAS bf16x8*)(lds + (bo_) + ko), a1 = *(const LAS bf16x8*)(lds + (bo_) + ko + 192u * 32u); \
            s0 = MFMA32(a0, qf[ks], s0); s1 = MFMA32(a1, qf[ks], s1); } } while (0)
#define MLA_PV(bo_) do { TrRegs TA, TB; tr_issue8(va0 + (bo_), TA); tr_issue8(va1 + (bo_), TB); tr_wait(TA, TB); bf16x8 vf[4]; tr_frags(TA, vf); \
        _Pragma("unroll") for (int k = 0; k < 4; ++k) o0 = MFMA32(vf[k], pf[k], o0); tr_frags(TB, vf); \
        _Pragma("unroll") for (int k = 0; k < 4; ++k) o1 = MFMA32(vf[k], pf[k], o1); } while (0)
    if (w < 4) {
        while (j < 32) {
            const int jn = procm ? __builtin_ctz(procm) : 32; procm &= procm - 1u;
            if (jn < 32) MLA_LOAD(jn);
            const unsigned bo = cur * BUFB;
            MLA_QK(bo, j);
            softmax_tile(s0, s1, mrun, lrun, o0, o1, pf);
            MLA_PV(bo);
            cur = cur == 2u ? 0u : cur + 1u;
            if (jn < 32) MLA_STORE(cur * BUFB);
            __syncthreads();
            j = jn;
        }
    } else {
        bool have = false; unsigned pbo = 0u;
        while (j < 32) {
            const int jn = procm ? __builtin_ctz(procm) : 32; procm &= procm - 1u;
            if (jn < 32) MLA_LOAD(jn);
            const unsigned bo = cur * BUFB;
            if (have) MLA_PV(pbo);
            MLA_QK(bo, j);
            softmax_tile(s0, s1, mrun, lrun, o0, o1, pf);
            pbo = bo; have = true;
            cur = cur == 2u ? 0u : cur + 1u;
            if (jn < 32) MLA_STORE(cur * BUFB);
            __syncthreads();
            j = jn;
        }
        if (have) MLA_PV(pbo);
    }
    __syncthreads();
#undef MLA_QK
#undef MLA_PV
#undef MLA_LOAD
#undef MLA_STORE
    const float inv = 1.f / (lrun + __shfl_xor(lrun, 32));
    bf16_t* op = OA + (size_t)qrow * 1024 + h * 64 + 4 * hh;
#pragma unroll
    for (int g = 0; g < 4; ++g) {
        u32x2 a, c; a.x = pk2(o0[4 * g] * inv, o0[4 * g + 1] * inv); a.y = pk2(o0[4 * g + 2] * inv, o0[4 * g + 3] * inv);
        c.x = pk2(o1[4 * g] * inv, o1[4 * g + 1] * inv); c.y = pk2(o1[4 * g + 2] * inv, o1[4 * g + 3] * inv);
        *(u32x2*)(op + 8 * g) = a; *(u32x2*)(op + 32 + 8 * g) = c;
    }
}

DI int t5_bucket(int rel) { const int n = rel < 0 ? -rel : rel;
    const int large = 8 + (n >= 12) + (n >= 16) + (n >= 23) + (n >= 32) + (n >= 46) + (n >= 64) + (n >= 91);
    return (rel > 0 ? 16 : 0) + (n < 8 ? n : large); }
DI void dsa_scan(LAS unsigned char* lds, int p, int lane, int w) {
    constexpr unsigned L_HIST = 17408u, L_PRE = 58368u, L_NEED = 58496u;
    {
        const int ql = lane >> 4, part = lane & 15, q = 4 * w + ql;
        unsigned c[16]; unsigned sum = 0u;
#pragma unroll
        for (int t = 0; t < 16; ++t) { c[t] = *(const LAS unsigned*)(lds + L_HIST + 4u * ((16 * part + t) * 32 + q)); sum += c[t]; }
        unsigned sfx = sum;
#pragma unroll
        for (int d = 1; d < 16; d <<= 1) { const unsigned t = __shfl_down(sfx, d, 16); if (part + d < 16) sfx += t; }
        const unsigned total = __shfl(sfx, lane & ~15);
        const unsigned nd = *(const LAS unsigned*)(lds + L_NEED + 4u * q), pold = *(const LAS unsigned*)(lds + L_PRE + 4u * q);
        const unsigned excl = sfx - sum;
        if (nd != 0u) {
            if (total < nd) { if (part == 0) { *(LAS unsigned*)(lds + L_NEED + 4u * q) = 0u; *(LAS unsigned*)(lds + L_PRE + 4u * q) = 0xFFFFFFFFu; } }
            else if (excl < nd && nd <= sfx) {
                unsigned run = excl, bsel = 0u, ndn = 0u; bool found = false;
#pragma unroll
                for (int t = 15; t >= 0; --t) { if (!found && run + c[t] >= nd) { found = true; bsel = (unsigned)(16 * part + t); ndn = nd - run; } if (!found) run += c[t]; }
                *(LAS unsigned*)(lds + L_PRE + 4u * q) = (p == 0 ? 0u : (pold << 8)) | bsel; *(LAS unsigned*)(lds + L_NEED + 4u * q) = ndn;
            }
        }
    }

}
DI void dsa_attend(const Ctx& X, int b, int qt, int tid, unsigned proc);
template <bool ATTEND>
DI void dsa_unit(const Ctx& X, int b, int qt) {
    const int lane = lane_id(), w = X.wid, tid = w * 64 + lane, r = lane & 31, hh = lane >> 5;
    LAS unsigned char* lds = X.lds; const unsigned ldsb = (unsigned)(uintptr_t)lds;
    constexpr unsigned L_QIT = 0u  , L_HIST = 17408u, L_MSK = 50176u, L_PRE = 58368u, L_NEED = 58496u, L_BT = 58624u, L_KV = 67072u, KVB = 16640u;
    const int tok0 = b * SEQ, q0 = tok0 + qt * 32;
    const bf16_t* QI = wsp<bf16_t>(X, WS_QI); const bf16_t* KI = wsp<bf16_t>(X, WS_KI); const bf16_t* QB = wsp<bf16_t>(X, WS_QB);
    const bf16_t* KB = wsp<bf16_t>(X, WS_KB); const bf16_t* VB = wsp<bf16_t>(X, WS_VB); const float* WI = wsp<float>(X, WS_WI);
    bf16_t* OB = wsp<bf16_t>(X, WS_B) + (size_t)M * 512;
    const int* TS = wsp<int>(X, WS_TSTAT) + (size_t)b * 32 * 4;
    const i32x4 tsv = *(const i32x4*)(TS + 4 * (lane & 31));
    const int qmax = __builtin_amdgcn_readlane(tsv[1], qt >> 1);
    const unsigned proc = (unsigned)__ballot(lane < 32 && tsv[0] <= qmax);
#pragma unroll
    for (int i = 0; i < 2; ++i) { const int c = tid + 512 * i, row = c >> 5, ch = c & 31;
        *(LAS u32x4*)(lds + L_QIT + row * 528 + ch * 16) = *(const u32x4*)(QI + (size_t)(q0 + row) * 256 + ch * 8); }
    if (tid < 257) { const int bk = t5_bucket(tid - 128);
#pragma unroll
        for (int hd = 0; hd < 8; ++hd) *(LAS float*)(lds + L_BT + 4u * (hd * 260 + tid)) = LOG2E * (X.rel_bias[bk * 8 + hd] - X.rel_bias[15 * 8 + hd]); }
    if (tid < 32) { *(LAS unsigned*)(lds + L_PRE + 4u * tid) = 0u; *(LAS unsigned*)(lds + L_NEED + 4u * tid) = 256u; }
#pragma unroll
    for (int i = 0; i < 4; ++i) *(LAS u32x4*)(lds + L_HIST + 16u * (tid + 512 * i)) = (u32x4){0u, 0u, 0u, 0u};
    const int pos_q = X.pos[q0 + r], qc = pos_q >> 6;
    float wq[8];
    { const f32x4 wa = *(const f32x4*)(WI + (size_t)(q0 + r) * 8), wb = *(const f32x4*)(WI + (size_t)(q0 + r) * 8 + 4);
      wq[0] = wa[0]; wq[1] = wa[1]; wq[2] = wa[2]; wq[3] = wa[3]; wq[4] = wb[0]; wq[5] = wb[1]; wq[6] = wb[2]; wq[7] = wb[3]; }
    __syncthreads();
    unsigned keys[8][16];
    bf16x8 nka0, nka1; i32x4 npk[4];
#define DSA_PREF(i_) do { const int jt_ = w + 8 * (i_); if ((proc >> (jt_ >> 1)) & 1u) { const size_t kr_ = (size_t)tok0 + jt_ * 32; \
        nka0 = *(const bf16x8*)(KI + (kr_ + r) * 32 + 8 * hh); nka1 = *(const bf16x8*)(KI + (kr_ + r) * 32 + 16 + 8 * hh); \
        _Pragma("unroll") for (int g_ = 0; g_ < 4; ++g_) npk[g_] = *(const i32x4*)(X.pos + kr_ + 8 * g_ + 4 * hh); } } while (0)
    DSA_PREF(0);
#pragma unroll
    for (int i = 0; i < 8; ++i) {
        const int jt = w + 8 * i;
        const bf16x8 ka0 = nka0, ka1 = nka1; i32x4 pk4[4];
#pragma unroll
        for (int g = 0; g < 4; ++g) pk4[g] = npk[g];
        if (i < 7) DSA_PREF(i + 1);
        if ((proc >> (jt >> 1)) & 1u) {
            f32x16 sc;
#pragma unroll
            for (int e = 0; e < 16; ++e) sc[e] = 0.f;
#pragma unroll
            for (int hd = 0; hd < 8; ++hd) {
                f32x16 S;
#pragma unroll
                for (int e = 0; e < 16; ++e) S[e] = 0.f;
                const bf16x8 b0 = *(const LAS bf16x8*)(lds + L_QIT + r * 528 + hh * 16 + hd * 64), b1 = *(const LAS bf16x8*)(lds + L_QIT + r * 528 + hh * 16 + hd * 64 + 32);
                S = MFMA32(ka0, b0, S); S = MFMA32(ka1, b1, S);
#pragma unroll
                for (int e = 0; e < 16; ++e) sc[e] += wq[hd] * __builtin_amdgcn_fmed3f(S[e], 0.f, 3.0e38f);
                asm volatile("" : "+v"(sc));
            }
#pragma unroll
            for (int g = 0; g < 4; ++g) {
#pragma unroll
                for (int e = 0; e < 4; ++e) { const int sidx = jt * 32 + 8 * g + 4 * hh + e; const unsigned u = __float_as_uint(sc[4 * g + e]);
                    const unsigned srt = u ^ ((unsigned)((int)u >> 31) | 0x80000000u);
                    unsigned kk = (srt & 0xFFFFF800u) | (unsigned)(2047 - sidx); kk = ((pk4[g][e] >> 6) <= qc) ? kk : 0u; keys[i][4 * g + e] = kk;
                    __hip_atomic_fetch_add((LAS unsigned*)(lds + L_HIST) + r + (kk >> 24) * 32u, 1u, __ATOMIC_RELAXED, __HIP_MEMORY_SCOPE_WORKGROUP); }
            }
        } else {
#pragma unroll
            for (int e = 0; e < 16; ++e) keys[i][e] = 0u;
        }
        __builtin_amdgcn_sched_barrier(0);
    }
#undef DSA_PREF
    __syncthreads();
    dsa_scan(lds, 0, lane, w);
    __syncthreads();
#pragma unroll 1
    for (int p = 1; p < 4; ++p) {
        const int shift = 24 - 8 * p;
#pragma unroll
        for (int i = 0; i < 4; ++i) *(LAS u32x4*)(lds + L_HIST + 16u * (tid + 512 * i)) = (u32x4){0u, 0u, 0u, 0u};
        __syncthreads();
        {
            const unsigned pre = *(const LAS unsigned*)(lds + L_PRE + 4u * r), ndq = *(const LAS unsigned*)(lds + L_NEED + 4u * r);
            unsigned P = pre << (shift + 8), lim = (ndq == 0u) ? 0u : (1u << (shift + 8));
            asm volatile("" : "+v"(P), "+v"(lim));
            LAS unsigned* hq = (LAS unsigned*)(lds + L_HIST) + r;
#pragma unroll
            for (int i = 0; i < 8; ++i) {
                if ((proc >> ((w + 8 * i) >> 1)) & 1u) {
                    unsigned mn = 0xFFFFFFFFu;
#pragma unroll
                    for (int e = 0; e < 16; ++e) { const unsigned x = keys[i][e] ^ P; mn = x < mn ? x : mn; }
                    if (__any(mn < lim)) {
                        unsigned P2 = P; asm volatile("" : "+v"(P2));
#pragma unroll
                        for (int e = 0; e < 16; ++e) { const unsigned x = keys[i][e] ^ P2;
                            if (x < lim) __hip_atomic_fetch_add(hq + ((x >> shift) & 255u) * 32u, 1u, __ATOMIC_RELAXED, __HIP_MEMORY_SCOPE_WORKGROUP); }
                    }
                }
                __builtin_amdgcn_sched_barrier(0);
            }
        }
        __syncthreads();
        dsa_scan(lds, p, lane, w);
        __syncthreads();
    }
    {
        const unsigned nd = *(const LAS unsigned*)(lds + L_NEED + 4u * r), pr = *(const LAS unsigned*)(lds + L_PRE + 4u * r);
        const unsigned T = nd == 0u ? 0u : pr, thr = T > 2048u ? T : 2048u;
#pragma unroll
        for (int i = 0; i < 8; ++i) { const int jt = w + 8 * i; unsigned bits = 0u;
#pragma unroll
            for (int e = 0; e < 16; ++e) bits |= (keys[i][e] >= thr ? 1u : 0u) << e;
            *(LAS unsigned short*)(lds + L_MSK + 2u * ((jt * 2 + hh) * 32 + r)) = (unsigned short)bits; }
    }
    __syncthreads();
    if constexpr (ATTEND) dsa_attend(X, b, qt, X.wid * 64 + lane_id(), proc); else __syncthreads();
}
DI void dsa_attend(const Ctx& X, int b, int qt, int tid, unsigned proc) {
    const int lane = tid & 63, w = X.wid, r = lane & 31, hh = lane >> 5;
    LAS unsigned char* lds = X.lds; const unsigned ldsb = (unsigned)(uintptr_t)lds;
    constexpr unsigned L_MSK = 50176u, L_BT = 58624u, L_KV = 67072u, KVB = 16640u;
    const int tok0 = b * SEQ, q0 = tok0 + qt * 32;
    const bf16_t* QB = wsp<bf16_t>(X, WS_QB); const bf16_t* KB = wsp<bf16_t>(X, WS_KB); const bf16_t* VB = wsp<bf16_t>(X, WS_VB);
    bf16_t* OB = wsp<bf16_t>(X, WS_B) + 512;
    const int* TS = wsp<int>(X, WS_TSTAT) + (size_t)b * 32 * 4;
    const i32x4 tsv = *(const i32x4*)(TS + 4 * (lane & 31));
    const int posmin_q = __builtin_amdgcn_readlane(tsv[2], qt >> 1);
    const unsigned nearm = (unsigned)__ballot(lane < 32 && tsv[3] - posmin_q > -128);
    unsigned procm = proc;
    const int pos_q = X.pos[q0 + r];
    bf16x8 qf[4];
#pragma unroll
    for (int s = 0; s < 4; ++s) qf[s] = *(const bf16x8*)(QB + (size_t)(q0 + r) * 512 + w * 64 + 16 * s + 8 * hh);
    f32x16 o0, o1;
#pragma unroll
    for (int e = 0; e < 16; ++e) { o0[e] = 0.f; o1[e] = 0.f; }
    float mrun = M_FLOOR, lrun = 0.f;
    const int key_a = tid >> 3, ch_a = tid & 7;
    const unsigned kdst = 128u * key_a + 16u * (ch_a ^ ((key_a >> 1) & 7)), vdst = 8192u + 128u * key_a + 16u * (ch_a ^ (((key_a >> 1) & 1) << 2));
    const int q4 = (lane & 15) >> 2, p4 = lane & 3, blk = (lane >> 4) & 1, sw = (q4 >> 1) & 1;
    const unsigned vbase = ldsb + L_KV + 8192u + 128u * (4 * hh + q4) + 16u * (2 * blk + (p4 >> 1)) + 8u * (p4 & 1);
    const unsigned va0 = vbase + 64u * sw, va1 = vbase + 64u * (1 - sw);
    u32x4 rk, rv; int rp = 0;
#define DSA_LOAD(j) do { const size_t t0_ = (size_t)tok0 + (size_t)(j) * 64; rk = *(const u32x4*)(KB + (t0_ + key_a) * 64 + ch_a * 8); rv = *(const u32x4*)(VB + (t0_ + key_a) * 64 + ch_a * 8); \
        if (tid < 64) rp = X.pos[t0_ + tid]; } while (0)
#define DSA_STORE(bo) do { *(LAS u32x4*)(lds + L_KV + (bo) + kdst) = rk; *(LAS u32x4*)(lds + L_KV + (bo) + vdst) = rv; if (tid < 64) *(LAS int*)(lds + L_KV + (bo) + 16384u + 4u * tid) = rp; } while (0)
    asm volatile("" :: "v"(qf[0]), "v"(qf[1]), "v"(qf[2]), "v"(qf[3]), "v"(pos_q));
    int j = procm ? __builtin_ctz(procm) : 32; procm &= procm - 1u;
    unsigned cur = 0;
    if (j < 32) { DSA_LOAD(j); DSA_STORE(0u); }
    __syncthreads();
    f32x16 s0, s1; bf16x8 pf[4];
#define DSA_QK(bo_, j_) do { const float nm = -mrun; \
        const unsigned m0 = *(const LAS unsigned short*)(lds + L_MSK + 2u * (((2 * (j_)) * 2 + hh) * 32 + r)), m1 = *(const LAS unsigned short*)(lds + L_MSK + 2u * (((2 * (j_) + 1) * 2 + hh) * 32 + r)); \
        if ((nearm >> (j_)) & 1u) { _Pragma("unroll") for (int g = 0; g < 4; ++g) { \
                const i32x4 c0 = *(const LAS i32x4*)(lds + L_KV + (bo_) + 16384u + 4u * (8 * g + 4 * hh)), c1 = *(const LAS i32x4*)(lds + L_KV + (bo_) + 16384u + 4u * (32 + 8 * g + 4 * hh)); \
                _Pragma("unroll") for (int e = 0; e < 4; ++e) { \
                    int d0 = c0[e] - pos_q, d1 = c1[e] - pos_q; d0 = d0 < -128 ? -128 : (d0 > 128 ? 128 : d0); d1 = d1 < -128 ? -128 : (d1 > 128 ? 128 : d1); \
                    const float b0 = *(const LAS float*)(lds + L_BT + 4u * (w * 260 + d0 + 128)) + nm, b1 = *(const LAS float*)(lds + L_BT + 4u * (w * 260 + d1 + 128)) + nm; \
                    s0[4 * g + e] = ((m0 >> (4 * g + e)) & 1u) ? b0 : NEGF; s1[4 * g + e] = ((m1 >> (4 * g + e)) & 1u) ? b1 : NEGF; } } } \
        else { _Pragma("unroll") for (int e = 0; e < 16; ++e) { s0[e] = ((m0 >> e) & 1u) ? nm : NEGF; s1[e] = ((m1 >> e) & 1u) ? nm : NEGF; } } \
        _Pragma("unroll") for (int ks = 0; ks < 4; ++ks) { const unsigned ko = 128u * r + 16u * ((2 * ks + hh) ^ ((r >> 1) & 7)); \
            const bf16x8 a0 = *(const LAS bf16x8*)(lds + L_KV + (bo_) + ko), a1 = *(const LAS bf16x8*)(lds + L_KV + (bo_) + ko + 128u * 32u); \
            s0 = MFMA32(a0, qf[ks], s0); s1 = MFMA32(a1, qf[ks], s1); } } while (0)
#define DSA_PV(bo_) do { TrRegs TA, TB; tr_issue8(va0 + (bo_), TA); tr_issue8(va1 + (bo_), TB); tr_wait(TA, TB); bf16x8 vf[4]; tr_frags(TA, vf); \
        _Pragma("unroll") for (int k = 0; k < 4; ++k) o0 = MFMA32(vf[k], pf[k], o0); tr_frags(TB, vf); \
        _Pragma("unroll") for (int k = 0; k < 4; ++k) o1 = MFMA32(vf[k], pf[k], o1); } while (0)
    if (w < 4) {
        while (j < 32) {
            const int jn = procm ? __builtin_ctz(procm) : 32; procm &= procm - 1u;
            if (jn < 32) DSA_LOAD(jn);
            const unsigned bo = cur * KVB;
            DSA_QK(bo, j);
            softmax_tile(s0, s1, mrun, lrun, o0, o1, pf);
            DSA_PV(bo);
            cur = cur == 2u ? 0u : cur + 1u;
            if (jn < 32) DSA_STORE(cur * KVB);
            __syncthreads();
            j = jn;
        }
    } else {
        bool have = false; unsigned pbo = 0u;
        while (j < 32) {
            const int jn = procm ? __builtin_ctz(procm) : 32; procm &= procm - 1u;
            if (jn < 32) DSA_LOAD(jn);
            const unsigned bo = cur * KVB;
            if (have) DSA_PV(pbo);
            DSA_QK(bo, j);
            softmax_tile(s0, s1, mrun, lrun, o0, o1, pf);
            pbo = bo; have = true;
            cur = cur == 2u ? 0u : cur + 1u;
            if (jn < 32) DSA_STORE(cur * KVB);
            __syncthreads();
            j = jn;
        }
        if (have) DSA_PV(pbo);
    }
#undef DSA_QK
#undef DSA_PV
#undef DSA_LOAD
#undef DSA_STORE
    const float inv = 1.f / (lrun + __shfl_xor(lrun, 32));
    bf16_t* op = OB + (size_t)(q0 + r) * 1024 + w * 64 + 4 * hh;
#pragma unroll
    for (int g = 0; g < 4; ++g) {
        u32x2 a, c; a.x = pk2(o0[4 * g] * inv, o0[4 * g + 1] * inv); a.y = pk2(o0[4 * g + 2] * inv, o0[4 * g + 3] * inv);
        c.x = pk2(o1[4 * g] * inv, o1[4 * g + 1] * inv); c.y = pk2(o1[4 * g + 2] * inv, o1[4 * g + 3] * inv);
        *(u32x2*)(op + 8 * g) = a; *(u32x2*)(op + 32 + 8 * g) = c;
    }
    __syncthreads();
}

constexpr int N_PHASES = 10;
template <int PHM>
__global__ void __launch_bounds__(512, 2) fwd_kernel(Args args) {
    extern __shared__ __attribute__((aligned(16))) unsigned char lds_raw[];
    Ctx X;
    X.x = (const float*)args.in[0]; X.pos = (const int*)args.in[1]; X.ln0_g = (const float*)args.in[2]; X.ln0_b = (const float*)args.in[3]; X.w_in = (const float*)args.in[4];
    X.q_norm_g = (const float*)args.in[5]; X.w_uq = (const float*)args.in[6]; X.kv_norm_g = (const float*)args.in[7]; X.w_uk = (const float*)args.in[8]; X.w_uv = (const float*)args.in[9];
    X.rel_bias = (const float*)args.in[10]; X.w_up_a = (const float*)args.in[11]; X.w_up_b = (const float*)args.in[12]; X.w_gate = (const float*)args.in[13]; X.b_gate = (const float*)args.in[14];
    X.w_o = (const float*)args.in[15]; X.ln1_g = (const float*)args.in[16]; X.ln1_b = (const float*)args.in[17]; X.w_grp = (const float*)args.in[18]; X.b_grp = (const float*)args.in[19];
    X.w_rt = (const float*)args.in[20]; X.b_rt = (const float*)args.in[21]; X.w_eg = (const float*)args.in[22]; X.w_eu = (const float*)args.in[23]; X.w_ed = (const float*)args.in[24];
    X.ln2_g = (const float*)args.in[25]; X.ln2_b = (const float*)args.in[26];
    X.out = args.out; X.ws = args.ws; X.lds = (LAS unsigned char*)lds_raw; X.G = gridDim.x; X.bid = blockIdx.x; X.wid = __builtin_amdgcn_readfirstlane((int)(threadIdx.x >> 6));
    if (threadIdx.x < 16) ((LAS unsigned*)(X.lds + LDS_MISC))[threadIdx.x] = 0u;
    __syncthreads();
    const int lo = args.ph_lo, hi = args.ph_hi;
    XcdBarrier bar; bar.bar = wsp<unsigned>(X, WS_CTL) + CW_BAR; bar.x = 0; bar.st = nullptr;
    if (hi - lo > 1) bar = xcd_barrier_post(wsp<unsigned>(X, WS_CTL) + CW_BAR, (volatile LAS unsigned*)(X.lds + LDS_MISC));
#define IN(k) (((PHM >> (k)) & 1) && lo <= (k) && (k) < hi)
#define SEAM(k) do { if (IN(k) && IN((k) + 1)) xcd_barrier(bar); } while (0)

    if (IN(0)) { p0_prologue(X); }
    SEAM(0);
#if DBG_STAGE >= 2
    if (IN(1)) {
        pg8::Gemm g{wsp<bf16_t>(X, WS_B), wsp<bf16_t>(X, WS_WT1), 1024}; pg8::StaticOrder S; S.init(M, NW1, X.G, X.bid);
        Epi1 E{wsp<bf16_t>(X, WS_CQ), wsp<bf16_t>(X, WS_CKV), wsp<bf16_t>(X, WS_KR), wsp<bf16_t>(X, WS_KI), wsp<bf16_t>(X, WS_KB), wsp<bf16_t>(X, WS_VB), wsp<bf16_t>(X, WS_QB), wsp<bf16_t>(X, WS_QI),
               wsp<bf16_t>(X, WS_A), wsp<float>(X, WS_WI), wsp<float>(X, WS_SSQ), wsp<float>(X, WS_ROPE), X.b_gate};
        pg8::gemm_phase<Epi1, pg8::StaticOrder, true, false>(X.lds, g, S, E, X.wid);
    }
    SEAM(1);
    if (IN(2)) {
        { pg8::Gemm g{wsp<bf16_t>(X, WS_CKV), wsp<bf16_t>(X, WS_WUKVT), 128}; pg8::StaticOrder S; S.init(M, 1024, X.G, X.bid);
          Epi3 E{wsp<bf16_t>(X, WS_KN), wsp<bf16_t>(X, WS_VM), wsp<float>(X, WS_SSQ)};
          pg8::gemm_phase<Epi3, pg8::StaticOrder, true, false>(X.lds, g, S, E, X.wid); }
        { pg8::Gemm g{wsp<bf16_t>(X, WS_CQ), wsp<bf16_t>(X, WS_WUQT), 256}; pg8::StaticOrder S; S.init(M, 768, X.G, X.bid);
          Epi2 E{wsp<bf16_t>(X, WS_QM), wsp<float>(X, WS_SSQ), wsp<float>(X, WS_ROPE)};
          pg8::gemm_phase<Epi2, pg8::StaticOrder, true, false>(X.lds, g, S, E, X.wid); }
    }
    SEAM(2);
    if (IN(3)) {
        for (int i = 0;; ++i) { const long L = (long)i * X.G + X.bid; if (L >= 1024) break; const int c = (int)(L & 255), ii = (int)(L >> 8);
            const int bh = c >> 1; const int tab[2][4] = {{7, 0, 5, 2}, {6, 1, 4, 3}}; int qb = tab[0][0];
#pragma unroll
            for (int a = 0; a < 2; ++a)
#pragma unroll
                for (int t = 0; t < 4; ++t) if (a == (c & 1) && t == ii) qb = tab[a][t];
#ifndef NO_MLA
            mla_unit(X, bh >> 3, bh & 7, qb);
#endif
#ifdef REP_MLA
            mla_unit(X, bh >> 3, bh & 7, qb);
#endif
        }
        for (int i = 0;; ++i) { const long L = (long)i * X.G + X.bid; if (L >= 1024) break; const int c = (int)(L & 255), ii = (int)(L >> 8);
            const int b = c >> 4, idx = c & 15; const int qt = ii == 0 ? 63 - idx : (ii == 1 ? idx : (ii == 2 ? 47 - idx : 16 + idx));
#ifdef REP_DSA_SEL
            dsa_unit<false>(X, b, qt);
#endif
#ifndef NO_DSA
            dsa_unit<true>(X, b, qt);
#endif
#ifdef REP_DSA
            dsa_unit<true>(X, b, qt);
#endif
        }
    }
    SEAM(3);
    if (IN(4)) {
        pg8::Gemm g{wsp<bf16_t>(X, WS_B), wsp<bf16_t>(X, WS_WUPT), 1024}; pg8::StaticOrder S; S.init(M, 1024, X.G, X.bid);
        Epi4 E{wsp<bf16_t>(X, WS_MIXPRE), wsp<bf16_t>(X, WS_A)};
        pg8::gemm_phase<Epi4, pg8::StaticOrder, true, false>(X.lds, g, S, E, X.wid);
    }
    SEAM(4);
    if (IN(5)) {
        pg8::Gemm g{wsp<bf16_t>(X, WS_MIXPRE), wsp<bf16_t>(X, WS_WOT), 1024}; pg8::StaticOrder S; S.init(M, 1024, X.G, X.bid);
        Epi5 E{wsp<float>(X, WS_A), X.x, wsp<float>(X, WS_STATS0), X.ln0_g, X.ln0_b};
        pg8::gemm_phase<Epi5, pg8::StaticOrder, true, false>(X.lds, g, S, E, X.wid);
    }
    SEAM(5);
#endif
    if (IN(6)) { p6_ln1_router(X); }
    SEAM(6);
    if (IN(7)) {
        moe_prep(X);
        const LAS int* tstart = (const LAS int*)(X.lds + LDS_MISC + 64); const LAS int* scnt = (const LAS int*)(X.lds + LDS_MISC + 512);
        pg8::Gemm g{wsp<bf16_t>(X, WS_B), wsp<bf16_t>(X, WS_WEGUT), 1024}; MoeOrder S{tstart, scnt, wsp<int>(X, WS_LIST), 2048, 2, X.G, X.bid, __builtin_amdgcn_readfirstlane(tstart[NSEG])};
        Epi7 E{wsp<bf16_t>(X, WS_HID), wsp<float>(X, WS_LISTW), scnt};
        pg8::gemm_phase<Epi7, MoeOrder, true, true>(X.lds, g, S, E, X.wid);
    }
    SEAM(7);
    if (IN(8)) {
        moe_prep(X);
        const LAS int* tstart = (const LAS int*)(X.lds + LDS_MISC + 64); const LAS int* scnt = (const LAS int*)(X.lds + LDS_MISC + 512);
        pg8::Gemm g{wsp<bf16_t>(X, WS_HID), wsp<bf16_t>(X, WS_WEDT), 256}; MoeOrder S{tstart, scnt, wsp<int>(X, WS_LIST), 0, 4, X.G, X.bid, __builtin_amdgcn_readfirstlane(tstart[NSEG])};
        Epi8 E{wsp<bf16_t>(X, WS_C), wsp<int>(X, WS_LIST), scnt};
        pg8::gemm_phase<Epi8, MoeOrder, true, false>(X.lds, g, S, E, X.wid);
    }
    SEAM(8);
    if (IN(9)) { p9_ln2(X); }
#undef IN
#undef SEAM
}

#ifndef PH_MASK
#define PH_MASK 0x3ff
#endif
template <int PHM> static bool setup_kernel(int& per_cu) {
    if (hipFuncSetAttribute((const void*)fwd_kernel<PHM>, hipFuncAttributeMaxDynamicSharedMemorySize, LDS_BYTES) != hipSuccess) return false;
    if (hipOccupancyMaxActiveBlocksPerMultiprocessor(&per_cu, (const void*)fwd_kernel<PHM>, 512, LDS_BYTES) != hipSuccess) per_cu = 0;
    (void)hipGetLastError(); return true;
}
template <int P> static void launch_phase(int grid, hipStream_t stream, Args a) {
    if (!((PH_MASK >> P) & 1)) return;
    a.ph_lo = P; a.ph_hi = P + 1;
    hipLaunchKernelGGL(fwd_kernel<(1 << P)>, dim3(grid), dim3(512), LDS_BYTES, stream, a);
#ifdef REP_MASK
    if ((REP_MASK >> P) & 1) hipLaunchKernelGGL(fwd_kernel<(1 << P)>, dim3(grid), dim3(512), LDS_BYTES, stream, a);
#endif
}
extern "C" void kernel_launch(void* const* d_in, const int* in_sizes, int n_in, void* d_out, int out_size, void* d_ws, size_t ws_size, hipStream_t stream) {
    static int grid = 0;
    if (grid == 0) {
        if (n_in != 27 || in_sizes[0] != M * D || out_size != M * D || ws_size < WS_END) { fprintf(stderr, "kernel_launch: unexpected shapes (n_in %d, ws %zu); nothing launched\n", n_in, ws_size); grid = -1; return; }
        int dev = 0, cus = 0, per_cu = 0; bool ok = true;
        if (hipGetDevice(&dev) != hipSuccess || hipDeviceGetAttribute(&cus, hipDeviceAttributeMultiprocessorCount, dev) != hipSuccess) { grid = -1; return; }
#if N_LAUNCH_MODE == 1
        ok = setup_kernel<PH_MASK>(per_cu);
#else
        ok = setup_kernel<1>(per_cu) && setup_kernel<2>(per_cu) && setup_kernel<4>(per_cu) && setup_kernel<8>(per_cu) && setup_kernel<16>(per_cu) && setup_kernel<32>(per_cu) &&
             setup_kernel<64>(per_cu) && setup_kernel<128>(per_cu) && setup_kernel<256>(per_cu) && setup_kernel<512>(per_cu);
#endif
        if (!ok) { fprintf(stderr, "kernel_launch: hipFuncSetAttribute failed\n"); grid = -1; return; }
        if (per_cu < 1) fprintf(stderr, "kernel_launch: occupancy query says %d\n", per_cu);
        grid = cus;
    }
    if (grid < 0) return;
    if (hipMemsetAsync((char*)d_ws + WS_CTL, 0, CTL_ZERO_BYTES, stream) != hipSuccess) return;
    Args a{};
    for (int i = 0; i < 27; ++i) a.in[i] = d_in[i];
    a.out = (float*)d_out; a.ws = (unsigned char*)d_ws;
#if N_LAUNCH_MODE == 1
    a.ph_lo = 0; a.ph_hi = N_PHASES;
    hipLaunchKernelGGL(fwd_kernel<PH_MASK>, dim3(grid), dim3(512), LDS_BYTES, stream, a);
#else
    launch_phase<0>(grid, stream, a);
#if DBG_STAGE >= 2
    launch_phase<1>(grid, stream, a); launch_phase<2>(grid, stream, a); launch_phase<3>(grid, stream, a); launch_phase<4>(grid, stream, a); launch_phase<5>(grid, stream, a);
#endif
    launch_phase<6>(grid, stream, a); launch_phase<7>(grid, stream, a); launch_phase<8>(grid, stream, a); launch_phase<9>(grid, stream, a);
#endif
}
```

```cpp
#include <hip/hip_runtime.h>
#include <cstdio>
#include <cstdint>

#ifndef N_LAUNCH_MODE
#define N_LAUNCH_MODE 1
#endif
#ifndef DBG_STAGE
#define DBG_STAGE 2
#endif

#define LAS __attribute__((address_space(3)))
#define GAS __attribute__((address_space(1)))
typedef unsigned short bf16_t;
typedef short bf16x8 __attribute__((ext_vector_type(8)));
typedef short s16x4 __attribute__((ext_vector_type(4)));
typedef float f32x2 __attribute__((ext_vector_type(2)));
typedef float f32x4 __attribute__((ext_vector_type(4)));
typedef float f32x16 __attribute__((ext_vector_type(16)));
typedef unsigned u32x2 __attribute__((ext_vector_type(2)));
typedef unsigned u32x4 __attribute__((ext_vector_type(4)));
typedef int i32x4 __attribute__((ext_vector_type(4)));
typedef __bf16 bf16x2_t __attribute__((ext_vector_type(2)));
#define DI __device__ __forceinline__

constexpr int BATCH = 16, SEQ = 2048, D = 1024, M = BATCH * SEQ;
constexpr int NW1 = 3584;
constexpr int NSEG = 64;
constexpr int MAXTILES = 320;
constexpr float LN_EPS = 1e-5f, RMS_EPS = 1e-6f;
constexpr float ALPHA = 1.189207115002721f;
constexpr float LOG2E = 1.4426950408889634f;
constexpr float NEGF = -1e30f;

constexpr size_t MiB = 1u << 20;
constexpr size_t WS_CTL = 0, CTL_ZERO_BYTES = 1 * MiB;
constexpr size_t WS_WT1 = 1 * MiB;
constexpr size_t WS_WUQT = 8 * MiB;
constexpr size_t WS_WUKVT = WS_WUQT + 768 * 256 * 2;
constexpr size_t WS_WRT = WS_WUKVT + 1024 * 128 * 2;
constexpr size_t WS_WUPT = 9 * MiB;
constexpr size_t WS_WOT = 11 * MiB;
constexpr size_t WS_WEGUT = 13 * MiB;
constexpr size_t WS_WEDT = 45 * MiB;
constexpr size_t WS_STATS0 = 61 * MiB;
constexpr size_t WS_SSQ = WS_STATS0 + (size_t)M * 8;
constexpr size_t WS_TSTAT = WS_SSQ + (size_t)M * 32;
constexpr size_t WS_STATS1 = WS_TSTAT + 8192;
constexpr size_t WS_TOKINFO = 63 * MiB;
constexpr size_t WS_A = 64 * MiB;
constexpr size_t WS_B = 192 * MiB;
constexpr size_t WS_C = 256 * MiB;
constexpr size_t WS_Dr = 384 * MiB;
constexpr size_t WS_END = 512 * MiB;
constexpr size_t WS_QB = WS_C, WS_QI = WS_QB + 32 * MiB, WS_CQ = WS_QI + 16 * MiB, WS_CKV = WS_CQ + 16 * MiB, WS_KB = WS_CKV + 8 * MiB, WS_VB = WS_KB + 4 * MiB,
                 WS_KR = WS_VB + 4 * MiB, WS_KI = WS_KR + 2 * MiB, WS_WI = WS_KI + 2 * MiB;
constexpr size_t WS_H = WS_C;
constexpr size_t WS_QM = WS_Dr, WS_KN = WS_QM + 48 * MiB, WS_VM = WS_KN + 32 * MiB;
constexpr size_t WS_MIXPRE = WS_Dr;
constexpr size_t WS_HID = WS_Dr + 64 * MiB;
constexpr size_t WS_LIST = WS_Dr + 104 * MiB;
constexpr size_t WS_LISTW = WS_Dr + 112 * MiB;
constexpr size_t WS_ROPE = WS_Dr + 120 * MiB;
constexpr int CW_BAR = 4096;
constexpr int CW_CNT = 16384;

DI unsigned pk2(float lo, float hi) { f32x2 v = {lo, hi}; bf16x2_t r = __builtin_convertvector(v, bf16x2_t); return __builtin_bit_cast(unsigned, r); }
DI float bf2f(unsigned short b) { return __uint_as_float((unsigned)b << 16); }
DI float wave_sum(float v) {
#pragma unroll
    for (int o = 1; o < 64; o <<= 1) v += __shfl_xor(v, o);
    return v;
}
DI int wave_min_i(int v) {
#pragma unroll
    for (int o = 1; o < 64; o <<= 1) { const int t = __shfl_xor(v, o); v = t < v ? t : v; }
    return v;
}
DI int wave_max_i(int v) {
#pragma unroll
    for (int o = 1; o < 64; o <<= 1) { const int t = __shfl_xor(v, o); v = t > v ? t : v; }
    return v;
}
DI int lane_id() { int l; asm volatile("v_mbcnt_lo_u32_b32 %0, -1, 0\n\tv_mbcnt_hi_u32_b32 %0, -1, %0" : "=v"(l)); return l; }
DI float fast_exp2(float x) { return __builtin_amdgcn_exp2f(x); }
DI float fast_rcp(float x) { return __builtin_amdgcn_rcpf(x); }
DI float sigmoidf_fast(float v) { return fast_rcp(1.0f + fast_exp2(-v * LOG2E)); }
DI void rope_sincos(int pos, int j, float& sn, float& cs) {
    const double invd[16] = {1.0, 0.5623413251903491, 0.31622776601683794, 0.1778279410038923, 0.1, 0.05623413251903491, 0.03162277660168379, 0.01778279410038923,
                             0.01, 0.005623413251903491, 0.0031622776601683794, 0.001778279410038923, 0.001, 0.0005623413251903491, 0.00031622776601683794, 0.0001778279410038923};
    double inv = invd[0];
#pragma unroll
    for (int t = 1; t < 16; ++t) inv = (j == t) ? invd[t] : inv;
    const double rev = (double)pos * (double)(float)inv * 0.15915494309189535;
    const float fr = (float)(rev - __builtin_floor(rev));
    sn = __builtin_amdgcn_sinf(fr); cs = __builtin_amdgcn_cosf(fr);
}

#define XB_TMO      128
#define XB_XCNT(j)  (256  + 64 * (j))
#define XB_XSUB(j)  (1280 + 64 * (j))
#define XB_XGEN(j)  (2304 + 64 * (j))
#define XB_TOP      3328
#define XB_TOPGEN   3392
#define XCD_BAR_WORDS 3456
#define XB_SPIN_CAP (1u << 18)
DI unsigned xb_ld(unsigned* p)              { return __hip_atomic_load(p, __ATOMIC_RELAXED, __HIP_MEMORY_SCOPE_AGENT); }
DI unsigned xb_add(unsigned* p, unsigned v) { return __hip_atomic_fetch_add(p, v, __ATOMIC_RELAXED, __HIP_MEMORY_SCOPE_AGENT); }
DI unsigned xb_xcc_id() { return (unsigned)__builtin_amdgcn_s_getreg((3 << 11) | 20) & 0xFu; }
#define XB_SPIN(cond, bar) do { unsigned _sp = 0; while (cond) { __builtin_amdgcn_s_sleep(1); \
    if ((++_sp & 255u) == 0u) { if (xb_ld(&(bar)[XB_TMO])) break; if (_sp > XB_SPIN_CAP) { atomicAdd(&(bar)[XB_TMO], 1u); break; } } } } while (0)
struct XcdBarrier { unsigned* bar; unsigned x; volatile LAS unsigned* st; };
DI XcdBarrier xcd_barrier_post(unsigned* bar, volatile LAS unsigned* st) {
    XcdBarrier b; b.bar = bar; b.x = xb_xcc_id(); b.st = st;
    if (threadIdx.x == 0) (void)xb_add(&bar[XB_XCNT(b.x)], 1u);
    return b;
}
DI void xcd_barrier_complete(unsigned* bar, unsigned x, unsigned& nloc, unsigned& nx) {
    const unsigned G = gridDim.x * gridDim.y * gridDim.z;
    unsigned sum, cnt, mine, sp = 0u;
    for (;;) {
        sum = 0u; cnt = 0u; mine = 0u;
#pragma unroll
        for (unsigned j = 0; j < 16; ++j) { const unsigned c = xb_ld(&bar[XB_XCNT(j)]); sum += c; cnt += (c > 0u) ? 1u : 0u; mine = (j == x) ? c : mine; }
        if (sum == G) break;
        __builtin_amdgcn_s_sleep(1);
        if ((++sp & 255u) == 0u) { if (xb_ld(&bar[XB_TMO])) break; if (sp > XB_SPIN_CAP) { atomicAdd(&bar[XB_TMO], 1u); break; } }
    }
    nloc = mine > 0u ? mine : 1u; nx = cnt > 0u ? cnt : 1u;
}
DI void xcd_barrier(const XcdBarrier& b) {
    asm volatile("s_waitcnt vmcnt(0)" ::: "memory");
    __syncthreads();
    if (threadIdx.x == 0) {
        unsigned* bar = b.bar;
        __builtin_amdgcn_s_waitcnt(0);
        unsigned nloc = b.st[0], nx = b.st[1];
        if (nloc == 0u) { xcd_barrier_complete(bar, b.x, nloc, nx); b.st[0] = nloc; b.st[1] = nx; }
        const unsigned old = xb_add(&bar[XB_XSUB(b.x)], 1u);
        const unsigned gen = old / nloc;
        if (old + 1u == (gen + 1u) * nloc) {
            __builtin_amdgcn_fence(__ATOMIC_RELEASE, "agent");
            asm volatile("s_waitcnt vmcnt(0)" ::: "memory");
            const unsigned og = xb_add(&bar[XB_TOP], 1u);
            const unsigned tg = og / nx;
            if (og + 1u == (tg + 1u) * nx) xb_add(&bar[XB_TOPGEN], 1u);
            else XB_SPIN(xb_ld(&bar[XB_TOPGEN]) == tg, bar);
            __builtin_amdgcn_fence(__ATOMIC_ACQUIRE, "agent");
            xb_add(&bar[XB_XGEN(b.x)], 1u);
            asm volatile("s_waitcnt vmcnt(0)" ::: "memory");
        } else {
            XB_SPIN(xb_ld(&bar[XB_XGEN(b.x)]) == gen, bar);
            __builtin_amdgcn_fence(__ATOMIC_ACQUIRE, "agent");
            asm volatile("s_waitcnt vmcnt(0)" ::: "memory");
        }
    }
    __syncthreads();
}

namespace pg8 {
constexpr int BM = 256, BK = 64, HALF = 128, HTB = HALF * BK * 2, STAGE_BYTES = 8 * HTB, NXCD = 8, WGM = 8;
__host__ __device__ __forceinline__ int lds_byte(int r, int c) { const int st = (r >> 4) * 2 + (c >> 5), rr = r & 15, cc = c & 31, ob = rr * 64 + cc * 2; return st * 1024 + (ob ^ (((ob >> 9) & 1) << 5)); }
__host__ __device__ __forceinline__ void stage_rc(int b, int& R, int& C) { const int st = b / 1024, sb = b % 1024, swz = sb ^ (((sb >> 9) & 1) << 5); R = (st >> 1) * 16 + swz / 64; C = (st & 1) * 32 + (swz % 64) / 2; }
__host__ __device__ __forceinline__ int perm32(int rho) { const int n = rho >> 4, i = rho & 15; return 8 * (i >> 2) + 4 * n + (i & 3); }
struct Unit { int pm, pn, a0, a1; };
struct Gemm { const bf16_t* A; const bf16_t* Bt; int K; };

DI void tile_of(int L, int nM, int nN, int& pm, int& pn) {
    const int nwg = nM * nN; int wgid = L;
    { const int q = nwg / NXCD, r = nwg % NXCD, xcd = wgid % NXCD, off = wgid / NXCD; wgid = (xcd < r ? xcd * (q + 1) : r * (q + 1) + (xcd - r) * q) + off; }
    const int nig = WGM * nN, gid = wgid / nig, fm = gid * WGM, gsz = (nM - fm) < WGM ? (nM - fm) : WGM;
    pm = fm + ((wgid % nig) % gsz); pn = (wgid % nig) / gsz;
}
struct StaticOrder {
    int nM, nN, nwg, G, c;
    DI void init(int Mrows, int N, int G_, int c_) { nM = Mrows / BM; nN = N / BM; nwg = nM * nN; G = G_; c = c_; }
    DI bool next(int i, Unit& u) const {
        const long L = (long)i * G + c; if (L >= nwg) return false;
        tile_of((int)L, nM, nN, u.pm, u.pn); u.a0 = 0; u.a1 = 0; return true;
    }
    DI unsigned arow(const Unit&, int) const { return 0u; }
};

template <class Epi, class Sched, bool ALIGN_EPI, bool GATHER>
DI void gemm_phase(LAS unsigned char* lds, const Gemm g, const Sched& S, const Epi& E, int wid) {
    const int lane = lane_id(), tid = wid * 64 + lane, wr = wid >> 2, wc = wid & 3, fr = lane & 15, fq = lane >> 4;
    int K = g.K; asm volatile("" : "+s"(K));
    const int nt = K / BK;
    unsigned voffA[2], voffB[2]; int RA[2];
#pragma unroll
    for (int i = 0; i < 2; ++i) { int R, C; stage_rc(tid * 16 + i * 8192, R, C); const int Rb = Epi::PERM ? ((R & ~31) + perm32(R & 31)) : R;
        voffA[i] = GATHER ? (unsigned)(C * 2) : (unsigned)(R * K + C) * 2u; voffB[i] = (unsigned)(Rb * K + C) * 2u; RA[i] = R; }
    const size_t kstep = (size_t)(BK * 2);
    const size_t hstep = (size_t)HALF * K * 2;
    const size_t tstep = 2 * hstep;
    const unsigned ldsw = (unsigned)wid * 1024u;
    const int aoff = lds_byte(wr * 64 + fr, fq * 8), boff = lds_byte(wc * 32 + fr, fq * 8);
#define PG8_SA(b, h) (((b) * 2 + (h)) * HTB)
#define PG8_SB(b, h) ((4 + (b) * 2 + (h)) * HTB)
#define PG8_STAGE(bufoff, gbase, voff) do { _Pragma("unroll") for (int _i = 0; _i < 2; ++_i) \
        __builtin_amdgcn_global_load_lds((const unsigned*)((const char*)(gbase) + (voff)[_i]), (LAS unsigned*)(lds + (bufoff) + ldsw + _i * 8192), 16, 0, 0); } while (0)
#define PG8_STAGE_A(bufoff, plainptr, hh, kptr, go) do { if constexpr (GATHER) { _Pragma("unroll") for (int _i = 0; _i < 2; ++_i) \
        __builtin_amdgcn_global_load_lds((const unsigned*)((kptr) + (go)[hh][_i]), (LAS unsigned*)(lds + (bufoff) + ldsw + _i * 8192), 16, 0, 0); } \
        else { PG8_STAGE(bufoff, (plainptr) + (hh) * hstep, voffA); } } while (0)
#define PG8_LDA(dst, b, h) do { _Pragma("unroll") for (int m = 0; m < 4; ++m) _Pragma("unroll") for (int k = 0; k < 2; ++k) dst[m][k] = *(const LAS bf16x8*)(lds + PG8_SA(b, h) + aoff + m * 2048 + k * 1024); } while (0)
#define PG8_LDB(dst, b, h) do { _Pragma("unroll") for (int n = 0; n < 2; ++n) _Pragma("unroll") for (int k = 0; k < 2; ++k) dst[n][k] = *(const LAS bf16x8*)(lds + PG8_SB(b, h) + boff + n * 2048 + k * 1024); } while (0)
#define PG8_MMA(ai, bj, At, Bt) do { __builtin_amdgcn_s_setprio(1); _Pragma("unroll") for (int m = 0; m < 4; ++m) _Pragma("unroll") for (int n = 0; n < 2; ++n) _Pragma("unroll") for (int k = 0; k < 2; ++k) \
        acc[ai][bj][m][n] = __builtin_amdgcn_mfma_f32_16x16x32_bf16(Bt[n][k], At[m][k], acc[ai][bj][m][n], 0, 0, 0); __builtin_amdgcn_s_setprio(0); } while (0)
#define PG8_WAIT_V(n) asm volatile("s_waitcnt vmcnt(" #n ")" ::: "memory")
#define PG8_WAIT_L(n) asm volatile("s_waitcnt lgkmcnt(" #n ")" ::: "memory")
#define PG8_BAR __builtin_amdgcn_s_barrier()
#define PG8_SCHED __builtin_amdgcn_sched_barrier(0)
    Unit cur, nxt; int ui = 0;
    if (!S.next(0, cur)) return;
    f32x4 acc[2][2][4][2];
#pragma unroll
    for (int a = 0; a < 2; ++a)
#pragma unroll
        for (int b = 0; b < 2; ++b)
#pragma unroll
            for (int m = 0; m < 4; ++m)
#pragma unroll
                for (int n = 0; n < 2; ++n) acc[a][b][m][n] = (f32x4){0.f, 0.f, 0.f, 0.f};
    bf16x8 At[4][2], B0[2][2], B1[2][2];
    const char* A0 = (const char*)g.A;
    const char* cA = A0 + (GATHER ? (size_t)0 : (size_t)cur.pm * tstep); const char* cB = (const char*)g.Bt + (size_t)cur.pn * tstep;
    unsigned gc[2][2], gn[2][2];
#pragma unroll
    for (int hh = 0; hh < 2; ++hh)
#pragma unroll
        for (int i = 0; i < 2; ++i) { gc[hh][i] = GATHER ? S.arow(cur, hh * HALF + RA[i]) + voffA[i] : 0u; gn[hh][i] = gc[hh][i]; }
    PG8_STAGE(PG8_SB(0, 0), cB, voffB); PG8_STAGE(PG8_SB(0, 1), cB + hstep, voffB); PG8_STAGE_A(PG8_SA(0, 0), cA, 0, A0, gc); PG8_STAGE_A(PG8_SA(0, 1), cA, 1, A0, gc);
    if (wr == 1) PG8_BAR;
    PG8_WAIT_V(2); PG8_BAR;
    PG8_STAGE(PG8_SB(1, 0), cB + kstep, voffB); PG8_STAGE_A(PG8_SA(1, 0), cA + kstep, 0, A0 + kstep, gc); PG8_STAGE(PG8_SB(1, 1), cB + hstep + kstep, voffB);
    PG8_WAIT_V(6); PG8_BAR;
    for (;;) {
        const bool has_next = S.next(ui + 1, nxt);
        const char* nA = has_next ? A0 + (GATHER ? (size_t)0 : (size_t)nxt.pm * tstep) : cA; const char* nB = has_next ? (const char*)g.Bt + (size_t)nxt.pn * tstep : cB;
        if constexpr (GATHER) {
#pragma unroll
            for (int hh = 0; hh < 2; ++hh)
#pragma unroll
                for (int i = 0; i < 2; ++i) gn[hh][i] = has_next ? S.arow(nxt, hh * HALF + RA[i]) + voffA[i] : gc[hh][i];
        }
        for (int t = 0; t < nt; t += 2) {
            if constexpr (Epi::MID) { if (t == (nt >> 1)) { const int l2 = lane_id(); E.mid(acc, cur, wr, wc, l2 & 15, l2 >> 4); } }
            const bool last = (t == nt - 2);
            const char* a1 = cA + (size_t)(t + 1) * kstep;
            const char* a2 = last ? nA : cA + (size_t)(t + 2) * kstep; const char* b2 = last ? nB : cB + (size_t)(t + 2) * kstep;
            const char* a3 = a2 + kstep; const char* b3 = b2 + kstep;
            const char* k1 = A0 + (size_t)(t + 1) * kstep; const char* k2 = A0 + (last ? (size_t)0 : (size_t)(t + 2) * kstep); const char* k3 = k2 + kstep;
            unsigned g2[2][2];
#pragma unroll
            for (int hh = 0; hh < 2; ++hh)
#pragma unroll
                for (int i = 0; i < 2; ++i) g2[hh][i] = last ? gn[hh][i] : gc[hh][i];
            PG8_LDB(B0, 0, 0); PG8_LDB(B1, 0, 1); PG8_SCHED; PG8_LDA(At, 0, 0); PG8_STAGE_A(PG8_SA(1, 1), a1, 1, k1, gc);
            PG8_WAIT_V(8); PG8_WAIT_L(0); PG8_BAR; PG8_MMA(0, 0, At, B0); PG8_MMA(0, 1, At, B1); PG8_BAR; PG8_SCHED;
            PG8_LDA(At, 0, 1); PG8_STAGE(PG8_SB(0, 0), b2, voffB); PG8_STAGE(PG8_SB(0, 1), b2 + hstep, voffB); PG8_STAGE_A(PG8_SA(0, 0), a2, 0, k2, g2);
            PG8_WAIT_V(8); PG8_WAIT_L(0); PG8_BAR; PG8_MMA(1, 0, At, B0); PG8_MMA(1, 1, At, B1); PG8_BAR; PG8_SCHED;
            PG8_LDB(B0, 1, 0); PG8_LDB(B1, 1, 1); PG8_SCHED; PG8_LDA(At, 1, 0); PG8_STAGE_A(PG8_SA(0, 1), a2, 1, k2, g2);
            PG8_WAIT_V(8); PG8_WAIT_L(0); PG8_BAR; PG8_MMA(0, 0, At, B0); PG8_MMA(0, 1, At, B1); PG8_BAR; PG8_SCHED;
            PG8_LDA(At, 1, 1); PG8_STAGE(PG8_SB(1, 0), b3, voffB); PG8_STAGE(PG8_SB(1, 1), b3 + hstep, voffB); PG8_STAGE_A(PG8_SA(1, 0), a3, 0, k3, g2);
            PG8_WAIT_V(8); PG8_WAIT_L(0); PG8_BAR; PG8_MMA(1, 0, At, B0); PG8_MMA(1, 1, At, B1); PG8_BAR; PG8_SCHED;
        }
        if constexpr (ALIGN_EPI) { if (wr == 0) PG8_BAR; }
        { const int l2 = lane_id(); E(acc, cur, wr, wc, l2 & 15, l2 >> 4); }
        if (!has_next) break;
#pragma unroll
        for (int a = 0; a < 2; ++a)
#pragma unroll
            for (int b = 0; b < 2; ++b)
#pragma unroll
                for (int m = 0; m < 4; ++m)
#pragma unroll
                    for (int n = 0; n < 2; ++n) acc[a][b][m][n] = (f32x4){0.f, 0.f, 0.f, 0.f};
        cur = nxt; cA = nA; cB = nB; ++ui;
#pragma unroll
        for (int hh = 0; hh < 2; ++hh)
#pragma unroll
            for (int i = 0; i < 2; ++i) gc[hh][i] = gn[hh][i];
        if constexpr (ALIGN_EPI) { if (wr == 1) PG8_BAR; }
    }
    PG8_WAIT_V(0);
    if constexpr (!ALIGN_EPI) { if (wr == 0) PG8_BAR; }
    PG8_BAR;
#undef PG8_SA
#undef PG8_SB
#undef PG8_STAGE
#undef PG8_STAGE_A
#undef PG8_LDA
#undef PG8_LDB
#undef PG8_MMA
#undef PG8_WAIT_V
#undef PG8_WAIT_L
#undef PG8_BAR
#undef PG8_SCHED
}
}
using pg8::Unit;

struct Args { const void* in[27]; float* out; unsigned char* ws; int ph_lo, ph_hi; };
struct Ctx {
    const float *x, *ln0_g, *ln0_b, *w_in, *q_norm_g, *w_uq, *kv_norm_g, *w_uk, *w_uv, *rel_bias, *w_up_a, *w_up_b, *w_gate, *b_gate, *w_o, *ln1_g, *ln1_b,
                *w_grp, *b_grp, *w_rt, *b_rt, *w_eg, *w_eu, *w_ed, *ln2_g, *ln2_b;
    const int* pos;
    float* out; unsigned char* ws;
    LAS unsigned char* lds;
    int G, bid, wid;
};
constexpr int LDS_RING = 131072;
constexpr int LDS_MISC = LDS_RING;
constexpr int LDS_LG = LDS_RING + 4096;
constexpr int LDS_RT = LDS_LG + 8192;
constexpr int LDS_BYTES = LDS_RING + 4096 + 8192 + 5120;
template <class T> DI T* wsp(const Ctx& X, size_t off) { return (T*)(X.ws + off); }

DI void tr_item(const float* W, int ld, int K, int ncols, bf16_t* WT, const float* scale, LAS float* scr, int item, int lane, int ldd = 0) {
    if (ldd == 0) ldd = K;
    const int nblk = (ncols + 31) >> 5, kb = item / nblk, nb = item - kb * nblk, k0 = 64 * kb, n0 = 32 * nb;
    const int n4 = 4 * (lane & 7), kr = lane >> 3;
    f32x4 v[8];
#pragma unroll
    for (int i = 0; i < 8; ++i) { const int kk = 8 * i + kr; v[i] = (n0 + n4 + 3 < ncols) ? *(const f32x4*)(W + (size_t)(k0 + kk) * ld + n0 + n4) : (f32x4){0.f, 0.f, 0.f, 0.f}; }
#pragma unroll
    for (int i = 0; i < 8; ++i) { const int kk = 8 * i + kr; f32x4 t = v[i]; if (scale) t = t * scale[k0 + kk];
        scr[kk * 33 + n4] = t[0]; scr[kk * 33 + n4 + 1] = t[1]; scr[kk * 33 + n4 + 2] = t[2]; scr[kk * 33 + n4 + 3] = t[3]; }
    asm volatile("s_waitcnt lgkmcnt(0)" ::: "memory");
    const int c = lane & 7;
#pragma unroll
    for (int j = 0; j < 4; ++j) { const int n = (lane >> 3) + 8 * j; const LAS float* s = scr + (8 * c) * 33 + n;
        u32x4 o; o.x = pk2(s[0 * 33], s[1 * 33]); o.y = pk2(s[2 * 33], s[3 * 33]); o.z = pk2(s[4 * 33], s[5 * 33]); o.w = pk2(s[6 * 33], s[7 * 33]);
        if (n0 + n < ncols) *(u32x4*)(WT + (size_t)(n0 + n) * ldd + k0 + 8 * c) = o; }
    asm volatile("s_waitcnt lgkmcnt(0)" ::: "memory");
}
constexpr int tr_items(int K, int ncols) { return (K / 64) * ((ncols + 31) / 32); }

DI void p0_prologue(const Ctx& X) {
    const int lane = lane_id(), wave = X.wid, tid = wave * 64 + lane;
    LAS float* scr = (LAS float*)(X.lds + wave * 16384);
    const int gw = X.bid * 8 + wave, NGW = X.G * 8;
    bf16_t* WT1 = wsp<bf16_t>(X, WS_WT1);
    {
        constexpr int seg_c0[9] = {0, 256, 384, 1312, 928, 416, 1056, 992, 1344};
        constexpr int seg_nc[9] = {256, 128, 32, 32, 64, 512, 256, 64, 8};
        constexpr int seg_d0[9] = {0, 256, 384, 416, 448, 512, 1024, 1280, 1344};
        constexpr int N_GU = 128 * tr_items(1024, 128), N_DN = 32 * tr_items(256, 1024);
        constexpr int N_IN = tr_items(1024, 256) + tr_items(1024, 128) + tr_items(1024, 32) * 2 + tr_items(1024, 64) * 2 + tr_items(1024, 512) + tr_items(1024, 256) + tr_items(1024, 8);
        constexpr int N_NAMED = N_IN + tr_items(1024, 2048) + tr_items(256, 768) + 2 * tr_items(128, 512) + 2 * tr_items(512, 1024) + tr_items(1024, 1024);
        constexpr int N_ALL = N_GU + N_DN + N_NAMED;
        for (int it = gw; it < N_ALL; it += NGW) {
            int r = it;
            if (r < N_GU) { constexpr int per = tr_items(1024, 128); const int job = r / per, rr = r - job * per, e = job >> 2, pn = (job >> 1) & 1, bj = job & 1;
                tr_item((bj ? X.w_eu : X.w_eg) + (size_t)e * 1024 * 256 + 128 * pn, 256, 1024, 128, wsp<bf16_t>(X, WS_WEGUT) + ((size_t)e * 512 + 256 * pn + 128 * bj) * 1024, nullptr, scr, rr, lane); continue; }
            r -= N_GU;
            if (r < N_DN) { constexpr int per = tr_items(256, 1024); const int e = r / per, rr = r - e * per;
                tr_item(X.w_ed + (size_t)e * 256 * 1024, 1024, 256, 1024, wsp<bf16_t>(X, WS_WEDT) + (size_t)e * 1024 * 256, nullptr, scr, rr, lane); continue; }
            r -= N_DN;
            bool done = false;
#pragma unroll
            for (int sg = 0; sg < 9; ++sg) { const int n = tr_items(1024, seg_nc[sg]);
                if (!done && r < n) { tr_item(X.w_in + seg_c0[sg], 1352, 1024, seg_nc[sg], WT1 + (size_t)seg_d0[sg] * 1024, nullptr, scr, r, lane); done = true; }
                if (!done) r -= n; }
            if (done) continue;
            if (r < tr_items(1024, 2048)) { tr_item(X.w_gate, 2048, 1024, 2048, WT1 + (size_t)1536 * 1024, nullptr, scr, r, lane); continue; } r -= tr_items(1024, 2048);
            if (r < tr_items(256, 768)) { tr_item(X.w_uq, 768, 256, 768, wsp<bf16_t>(X, WS_WUQT), X.q_norm_g, scr, r, lane); continue; } r -= tr_items(256, 768);
            if (r < tr_items(128, 512)) { tr_item(X.w_uk, 512, 128, 512, wsp<bf16_t>(X, WS_WUKVT), X.kv_norm_g, scr, r, lane); continue; } r -= tr_items(128, 512);
            if (r < tr_items(128, 512)) { tr_item(X.w_uv, 512, 128, 512, wsp<bf16_t>(X, WS_WUKVT) + 512 * 128, X.kv_norm_g, scr, r, lane); continue; } r -= tr_items(128, 512);
            if (r < tr_items(512, 1024)) { tr_item(X.w_up_a, 1024, 512, 1024, wsp<bf16_t>(X, WS_WUPT), nullptr, scr, r, lane, 1024); continue; } r -= tr_items(512, 1024);
            if (r < tr_items(512, 1024)) { tr_item(X.w_up_b, 1024, 512, 1024, wsp<bf16_t>(X, WS_WUPT) + 512, nullptr, scr, r, lane, 1024); continue; } r -= tr_items(512, 1024);
            tr_item(X.w_o, 1024, 1024, 1024, wsp<bf16_t>(X, WS_WOT), nullptr, scr, r, lane);
        }
    }
    { const int gt = X.bid * 512 + tid, NT = X.G * 512; u32x4 z = {0u, 0u, 0u, 0u};
      for (int i = gt; i < 184 * 1024 / 8; i += NT) *(u32x4*)(WT1 + (size_t)1352 * 1024 + (size_t)i * 8) = z; }
    { const int gt = X.bid * 512 + tid, NT = X.G * 512; bf16_t* WR = wsp<bf16_t>(X, WS_WRT);
      for (int i = gt; i < 64 * 1024; i += NT) { const int j = i >> 10, k = i & 1023;
          const float v = (j < 4) ? X.w_grp[k * 4 + j] : (j < 36 ? X.w_rt[k * 32 + (j - 4)] : 0.f);
          const unsigned hi = pk2(v, 0.f) & 0xffffu; const float lo = v - bf2f((unsigned short)hi);
          WR[(size_t)j * 1024 + k] = (bf16_t)hi; WR[(size_t)(64 + j) * 1024 + k] = (bf16_t)(pk2(lo, 0.f) & 0xffffu); } }
    { const int gt = X.bid * 512 + tid, NT = X.G * 512; float* RT = wsp<float>(X, WS_ROPE);
      for (int i = gt; i < M * 16; i += NT) { const int row = i >> 4, j = i & 15; float sn, cs; rope_sincos(X.pos[row], j, sn, cs); RT[(size_t)row * 32 + j] = cs; RT[(size_t)row * 32 + 16 + j] = sn; } }
    { int* TS = wsp<int>(X, WS_TSTAT);
      for (int t = gw; t < M / 64; t += NGW) { const int p = X.pos[t * 64 + lane]; const int pmin = wave_min_i(p), pmax = wave_max_i(p);
          if (lane == 0) { TS[t * 4 + 0] = pmin >> 6; TS[t * 4 + 1] = pmax >> 6; TS[t * 4 + 2] = pmin; TS[t * 4 + 3] = pmax; } } }
    { bf16_t* XN = wsp<bf16_t>(X, WS_B); float* ST = wsp<float>(X, WS_STATS0);
#if DBG_STAGE == 1
      float* Y1 = wsp<float>(X, WS_A);
#endif
      f32x4 gv[4], bv[4];
#pragma unroll
      for (int j = 0; j < 4; ++j) { gv[j] = *(const f32x4*)(X.ln0_g + 4 * lane + 256 * j); bv[j] = *(const f32x4*)(X.ln0_b + 4 * lane + 256 * j); }
      for (int m = gw; m < M; m += NGW) {
          const f32x4* xr = (const f32x4*)(X.x + (size_t)m * D) + lane;
          f32x4 v[4]; float s = 0.f;
#pragma unroll
          for (int j = 0; j < 4; ++j) { v[j] = xr[64 * j]; s += (v[j].x + v[j].y) + (v[j].z + v[j].w); }
          const float mean = wave_sum(s) * (1.f / D); float s2 = 0.f;
#pragma unroll
          for (int j = 0; j < 4; ++j) { v[j] = v[j] - mean; s2 += (v[j].x * v[j].x + v[j].y * v[j].y) + (v[j].z * v[j].z + v[j].w * v[j].w); }
          const float rstd = 1.f / sqrtf(wave_sum(s2) * (1.f / D) + LN_EPS);
          if (lane == 0) { ST[2 * m] = mean; ST[2 * m + 1] = rstd; }
          u32x2* o8 = (u32x2*)(XN + (size_t)m * D) + lane;
#pragma unroll
          for (int j = 0; j < 4; ++j) { const f32x4 y = v[j] * rstd * gv[j] + bv[j]; u32x2 o; o.x = pk2(y.x, y.y); o.y = pk2(y.z, y.w); o8[64 * j] = o;
#if DBG_STAGE == 1
              *((f32x4*)(Y1 + (size_t)m * D) + lane + 64 * j) = y * ALPHA;
#endif
          }
      } }
}

DI void store8(bf16_t* p, const f32x4& a, const f32x4& b) { u32x4 w; w.x = pk2(a[0], a[1]); w.y = pk2(a[2], a[3]); w.z = pk2(b[0], b[1]); w.w = pk2(b[2], b[3]); *(u32x4*)p = w; }
DI void rope8(f32x4& v0, f32x4& v1, const float* tab, int fq) {
    const float sg = (fq < 2) ? -1.f : 1.f; const int j0 = 8 * (fq & 1);
    const f32x4 c0 = *(const f32x4*)(tab + j0), c1 = *(const f32x4*)(tab + j0 + 4), s0 = *(const f32x4*)(tab + 16 + j0), s1 = *(const f32x4*)(tab + 16 + j0 + 4);
#pragma unroll
    for (int e = 0; e < 4; ++e) {
        const float o0 = __shfl_xor(v0[e], 32), o1 = __shfl_xor(v1[e], 32);
        v0[e] = v0[e] * c0[e] + sg * o0 * s0[e];
        v1[e] = v1[e] * c1[e] + sg * o1 * s1[e];
    }
}
struct Epi1 {
    static constexpr bool PERM = true, MID = false;
    bf16_t *CQ, *CKV, *KR, *KI, *KB, *VB, *QB, *QI, *G; float *WI, *SSQ; const float* rope; const float* bgate;
    DI void operator()(const f32x4 (&acc)[2][2][4][2], const Unit& u, int wr, int wc, int fr_, int fq_) const {
        int fr = fr_, fq = fq_; asm volatile("" : "+v"(fr), "+v"(fq));
        const int pn = u.pn; const int row0 = u.pm * 256 + wr * 64 + fr;
        if (pn >= 6) {
            const int gc0 = (pn - 6) * 256 + 32 * wc + 8 * fq;
#pragma unroll
            for (int bj = 0; bj < 2; ++bj) { const f32x4 b0 = *(const f32x4*)(bgate + gc0 + 128 * bj), b1 = *(const f32x4*)(bgate + gc0 + 128 * bj + 4);
#pragma unroll
                for (int ai = 0; ai < 2; ++ai)
#pragma unroll
                    for (int m = 0; m < 4; ++m) { f32x4 v0 = acc[ai][bj][m][0] + b0, v1 = acc[ai][bj][m][1] + b1;
#pragma unroll
                        for (int e = 0; e < 4; ++e) { v0[e] = sigmoidf_fast(v0[e]); v1[e] = sigmoidf_fast(v1[e]); }
                        store8(G + (size_t)(row0 + ai * 128 + m * 16) * 2048 + gc0 + 128 * bj, v0, v1); } }
        } else if (pn == 0 || pn == 4) {
            bf16_t* O = pn == 0 ? CQ : QI;
#pragma unroll
            for (int ai = 0; ai < 2; ++ai)
#pragma unroll
                for (int m = 0; m < 4; ++m) { const int row = row0 + ai * 128 + m * 16; float s = 0.f;
#pragma unroll
                    for (int bj = 0; bj < 2; ++bj) { const f32x4 v0 = acc[ai][bj][m][0], v1 = acc[ai][bj][m][1];
                        store8(O + (size_t)row * 256 + 128 * bj + 32 * wc + 8 * fq, v0, v1);
                        s += (v0[0] * v0[0] + v0[1] * v0[1]) + (v0[2] * v0[2] + v0[3] * v0[3]) + (v1[0] * v1[0] + v1[1] * v1[1]) + (v1[2] * v1[2] + v1[3] * v1[3]); }
                    if (pn == 0) { s += __shfl_xor(s, 16); s += __shfl_xor(s, 32); if (fq == 0) SSQ[(size_t)row * 8 + wc] = s; } }
        } else if (pn == 2 || pn == 3) {
            const float sc = 0.125f * LOG2E;
#pragma unroll
            for (int ai = 0; ai < 2; ++ai)
#pragma unroll
                for (int m = 0; m < 4; ++m) { const int row = row0 + ai * 128 + m * 16;
#pragma unroll
                    for (int bj = 0; bj < 2; ++bj) store8(QB + (size_t)row * 512 + (pn - 2) * 256 + 128 * bj + 32 * wc + 8 * fq, acc[ai][bj][m][0] * sc, acc[ai][bj][m][1] * sc); }
        } else if (pn == 1) {
#pragma unroll
            for (int ai = 0; ai < 2; ++ai)
#pragma unroll
                for (int m = 0; m < 4; ++m) { const int row = row0 + ai * 128 + m * 16;
                    { const f32x4 v0 = acc[ai][0][m][0], v1 = acc[ai][0][m][1];
                      store8(CKV + (size_t)row * 128 + 32 * wc + 8 * fq, v0, v1);
                      float s = (v0[0] * v0[0] + v0[1] * v0[1]) + (v0[2] * v0[2] + v0[3] * v0[3]) + (v1[0] * v1[0] + v1[1] * v1[1]) + (v1[2] * v1[2] + v1[3] * v1[3]);
                      s += __shfl_xor(s, 16); s += __shfl_xor(s, 32); if (fq == 0) SSQ[(size_t)row * 8 + 4 + wc] = s; }
                    f32x4 v0 = acc[ai][1][m][0], v1 = acc[ai][1][m][1];
                    if (wc == 0) { rope8(v0, v1, rope + (size_t)row * 32, fq); store8(KR + (size_t)row * 32 + 8 * fq, v0, v1); }
                    else if (wc == 1) store8(KI + (size_t)row * 32 + 8 * fq, v0, v1);
                    else store8(KB + (size_t)row * 64 + 32 * (wc - 2) + 8 * fq, v0, v1); }
        } else {
            const float wsc = 0.35355339059327373f * 0.17677669529663687f;
#pragma unroll
            for (int ai = 0; ai < 2; ++ai)
#pragma unroll
                for (int m = 0; m < 4; ++m) { const int row = row0 + ai * 128 + m * 16;
                    if (wc < 2) store8(VB + (size_t)row * 64 + 32 * wc + 8 * fq, acc[ai][0][m][0], acc[ai][0][m][1]);
                    else if (wc == 2 && fq == 0) { *(f32x4*)(WI + (size_t)row * 8) = acc[ai][0][m][0] * wsc; *(f32x4*)(WI + (size_t)row * 8 + 4) = acc[ai][0][m][1] * wsc; } }
        }
    }
};
struct Epi2 {
    static constexpr bool PERM = true, MID = false;
    bf16_t* QM; const float* SSQ; const float* rope;
    DI void operator()(const f32x4 (&acc)[2][2][4][2], const Unit& u, int wr, int wc, int fr_, int fq_) const {
        int fr = fr_, fq = fq_; asm volatile("" : "+v"(fr), "+v"(fq));
        const int row0 = u.pm * 256 + wr * 64 + fr; const float sc = 0.10206207261596575f * LOG2E;
#pragma unroll
        for (int ai = 0; ai < 2; ++ai)
#pragma unroll
            for (int m = 0; m < 4; ++m) { const int row = row0 + ai * 128 + m * 16;
                const f32x4 q4 = *(const f32x4*)(SSQ + (size_t)row * 8); const float rs = sc / sqrtf(((q4[0] + q4[1]) + (q4[2] + q4[3])) * (1.f / 256.f) + RMS_EPS);
#pragma unroll
                for (int bj = 0; bj < 2; ++bj) { const int g32 = 8 * u.pn + 4 * bj + wc; f32x4 v0 = acc[ai][bj][m][0] * rs, v1 = acc[ai][bj][m][1] * rs;
                    if (g32 % 3 == 2) rope8(v0, v1, rope + (size_t)row * 32, fq);
                    store8(QM + (size_t)row * 768 + 32 * g32 + 8 * fq, v0, v1); } }
    }
};
struct Epi3 {
    static constexpr bool PERM = true, MID = false;
    bf16_t *KN, *VM; const float* SSQ;
    DI void operator()(const f32x4 (&acc)[2][2][4][2], const Unit& u, int wr, int wc, int fr_, int fq_) const {
        int fr = fr_, fq = fq_; asm volatile("" : "+v"(fr), "+v"(fq));
        const int row0 = u.pm * 256 + wr * 64 + fr; bf16_t* O = u.pn < 2 ? KN : VM; const int c0 = (u.pn & 1) * 256 + 32 * wc + 8 * fq;
#pragma unroll
        for (int ai = 0; ai < 2; ++ai)
#pragma unroll
            for (int m = 0; m < 4; ++m) { const int row = row0 + ai * 128 + m * 16;
                const f32x4 q4 = *(const f32x4*)(SSQ + (size_t)row * 8 + 4); const float rs = 1.f / sqrtf(((q4[0] + q4[1]) + (q4[2] + q4[3])) * (1.f / 128.f) + RMS_EPS);
#pragma unroll
                for (int bj = 0; bj < 2; ++bj) store8(O + (size_t)row * 512 + c0 + 128 * bj, acc[ai][bj][m][0] * rs, acc[ai][bj][m][1] * rs); }
    }
};
struct Epi4 {
    static constexpr bool PERM = true, MID = true;
    bf16_t* MIX; const bf16_t* G;
    DI void mid(f32x4 (&acc)[2][2][4][2], const Unit& u, int wr, int wc, int fr, int fq) const {
        const int row0 = u.pm * 256 + wr * 64 + fr, c0 = u.pn * 256 + 32 * wc + 8 * fq;
#pragma unroll
        for (int ai = 0; ai < 2; ++ai)
#pragma unroll
            for (int m = 0; m < 4; ++m) { const int row = row0 + ai * 128 + m * 16;
#pragma unroll
                for (int bj = 0; bj < 2; ++bj) { const int c = c0 + 128 * bj;
                    const u32x4 ga = *(const u32x4*)(G + (size_t)row * 2048 + c), gb = *(const u32x4*)(G + (size_t)row * 2048 + 1024 + c);
                    const unsigned gaw[4] = {ga.x, ga.y, ga.z, ga.w}, gbw[4] = {gb.x, gb.y, gb.z, gb.w};
#pragma unroll
                    for (int q = 0; q < 4; ++q) {
                        const float a0 = __uint_as_float(gaw[q] << 16), a1 = __uint_as_float(gaw[q] & 0xffff0000u), b0 = __uint_as_float(gbw[q] << 16), b1 = __uint_as_float(gbw[q] & 0xffff0000u);
                        const float r0 = a0 * fast_rcp(fmaxf(b0, 1e-30f)), r1 = a1 * fast_rcp(fmaxf(b1, 1e-30f));
                        acc[ai][bj][m][q >> 1][2 * (q & 1)] *= r0; acc[ai][bj][m][q >> 1][2 * (q & 1) + 1] *= r1; }
                }
                asm volatile("" ::: "memory"); }
    }
    DI void operator()(const f32x4 (&acc)[2][2][4][2], const Unit& u, int wr, int wc, int fr_, int fq_) const {
        int fr = fr_, fq = fq_; asm volatile("" : "+v"(fr), "+v"(fq));
        const int row0 = u.pm * 256 + wr * 64 + fr, c0 = u.pn * 256 + 32 * wc + 8 * fq;
#pragma unroll
        for (int ai = 0; ai < 2; ++ai)
#pragma unroll
            for (int m = 0; m < 4; ++m) { const int row = row0 + ai * 128 + m * 16;
#pragma unroll
                for (int bj = 0; bj < 2; ++bj) { const int c = c0 + 128 * bj;
                    const u32x4 gw = *(const u32x4*)(G + (size_t)row * 2048 + 1024 + c);
                    f32x4 v0 = acc[ai][bj][m][0], v1 = acc[ai][bj][m][1];
                    v0[0] *= __uint_as_float(gw.x << 16); v0[1] *= __uint_as_float(gw.x & 0xffff0000u); v0[2] *= __uint_as_float(gw.y << 16); v0[3] *= __uint_as_float(gw.y & 0xffff0000u);
                    v1[0] *= __uint_as_float(gw.z << 16); v1[1] *= __uint_as_float(gw.z & 0xffff0000u); v1[2] *= __uint_as_float(gw.w << 16); v1[3] *= __uint_as_float(gw.w & 0xffff0000u);
                    store8(MIX + (size_t)row * 1024 + c, v0, v1); } }
    }
};
struct Epi5 {
    static constexpr bool PERM = false, MID = false;
    float* Y1; const float *x, *ST, *g0, *b0;
    DI void operator()(const f32x4 (&acc)[2][2][4][2], const Unit& u, int wr, int wc, int fr_, int fq_) const {
        int fr = fr_, fq = fq_; asm volatile("" : "+v"(fr), "+v"(fq));
        const int row0 = u.pm * 256 + wr * 64 + fr, c0 = u.pn * 256 + 32 * wc + 4 * fq;
        f32x4 gv[2][2], bv[2][2];
#pragma unroll
        for (int bj = 0; bj < 2; ++bj)
#pragma unroll
            for (int n = 0; n < 2; ++n) { gv[bj][n] = *(const f32x4*)(g0 + c0 + 128 * bj + 16 * n) * ALPHA; bv[bj][n] = *(const f32x4*)(b0 + c0 + 128 * bj + 16 * n) * ALPHA; }
#pragma unroll
        for (int ai = 0; ai < 2; ++ai)
#pragma unroll
            for (int m = 0; m < 4; ++m) { const int row = row0 + ai * 128 + m * 16; const float mean = ST[2 * row], rstd = ST[2 * row + 1];
#pragma unroll
                for (int bj = 0; bj < 2; ++bj)
#pragma unroll
                    for (int n = 0; n < 2; ++n) { const size_t off = (size_t)row * 1024 + c0 + 128 * bj + 16 * n;
                        const f32x4 xv = *(const f32x4*)(x + off);
                        *(f32x4*)(Y1 + off) = (xv - mean) * rstd * gv[bj][n] + bv[bj][n] + acc[ai][bj][m][n]; } }
    }
};
struct MoeOrder {
    const LAS int* tstart;
    const LAS int* scnt;
    const int* LIST; int K2;
    int NT, G, c, ntiles;
    DI bool next(int i, Unit& u) const {
        const long L = (long)i * G + c; if (L >= (long)ntiles * NT) return false;
        const int tile = (int)(L / NT), pn = (int)(L - (long)tile * NT);
        int lo = 0, hi = NSEG;
#pragma unroll
        for (int s = 0; s < 6; ++s) { const int mid = (lo + hi) >> 1; if (tstart[mid] <= tile) lo = mid; else hi = mid; }
        const int ts = tstart[lo];
        u.pm = tile; u.pn = __builtin_amdgcn_readfirstlane((lo & 31) * NT + pn); u.a0 = __builtin_amdgcn_readfirstlane(lo); u.a1 = __builtin_amdgcn_readfirstlane(tile - ts); return true;
    }
    DI unsigned arow(const Unit& u, int r) const { const int idx = u.a1 * 256 + r; const int tok = LIST[(size_t)u.a0 * M + (idx < scnt[u.a0] ? idx : 0)]; return (unsigned)tok * (unsigned)K2; }
};
struct Epi7 {
    static constexpr bool PERM = true, MID = false;
    bf16_t* HID; const float* LISTW; const LAS int* scnt;
    DI void operator()(const f32x4 (&acc)[2][2][4][2], const Unit& u, int wr, int wc, int fr_, int fq_) const {
        int fr = fr_, fq = fq_; asm volatile("" : "+v"(fr), "+v"(fq));
        const int c0 = (u.pn & 1) * 128 + 32 * wc + 8 * fq, cnt = scnt[u.a0];
#pragma unroll
        for (int ai = 0; ai < 2; ++ai)
#pragma unroll
            for (int m = 0; m < 4; ++m) { const int r = ai * 128 + wr * 64 + m * 16 + fr, idx = u.a1 * 256 + r;
                const float w = idx < cnt ? LISTW[(size_t)u.a0 * M + idx] : 0.f;
                f32x4 v0, v1;
#pragma unroll
                for (int e = 0; e < 4; ++e) { const float a0 = acc[ai][0][m][0][e], a1 = acc[ai][0][m][1][e];
                    v0[e] = a0 * sigmoidf_fast(a0) * acc[ai][1][m][0][e] * w; v1[e] = a1 * sigmoidf_fast(a1) * acc[ai][1][m][1][e] * w; }
                store8(HID + ((size_t)u.pm * 256 + r) * 256 + c0, v0, v1); }
    }
};
struct Epi8 {
    static constexpr bool PERM = true, MID = false;
    bf16_t* PP; const int* LIST; const LAS int* scnt;
    DI void operator()(const f32x4 (&acc)[2][2][4][2], const Unit& u, int wr, int wc, int fr_, int fq_) const {
        int fr = fr_, fq = fq_; asm volatile("" : "+v"(fr), "+v"(fq));
        const int c0 = (u.pn & 3) * 256 + 32 * wc + 8 * fq, cnt = scnt[u.a0]; bf16_t* O = PP + (size_t)(u.a0 >> 5) * M * 1024;
#pragma unroll
        for (int ai = 0; ai < 2; ++ai)
#pragma unroll
            for (int m = 0; m < 4; ++m) { const int r = ai * 128 + wr * 64 + m * 16 + fr, idx = u.a1 * 256 + r;
                if (idx < cnt) { const int tok = LIST[(size_t)u.a0 * M + idx];
#pragma unroll
                    for (int bj = 0; bj < 2; ++bj) store8(O + (size_t)tok * 1024 + c0 + 128 * bj, acc[ai][bj][m][0], acc[ai][bj][m][1]); }
                asm volatile("" ::: "memory"); }
    }
};


DI void p6_ln1_router(const Ctx& X) {
    const int lane = lane_id(), wave = X.wid, tid = wave * 64 + lane, r = lane & 31, hh = lane >> 5;
    LAS unsigned char* HI = X.lds; LAS unsigned char* LO = X.lds + 65536;
    LAS float* LG = (LAS float*)(X.lds + LDS_LG);
    const float* Y1 = wsp<float>(X, WS_A); float* ST1 = wsp<float>(X, WS_STATS1); bf16_t* HB = wsp<bf16_t>(X, WS_B);
    const bf16_t* WR = wsp<bf16_t>(X, WS_WRT);
    unsigned* CNT = wsp<unsigned>(X, WS_CTL) + CW_CNT; int* LIST = wsp<int>(X, WS_LIST); float* LISTW = wsp<float>(X, WS_LISTW);
    f32x4 gv[4], bv[4];
#pragma unroll
    for (int j = 0; j < 4; ++j) { gv[j] = *(const f32x4*)(X.ln1_g + 4 * lane + 256 * j); bv[j] = *(const f32x4*)(X.ln1_b + 4 * lane + 256 * j); }
    LAS unsigned* RT_SP = (LAS unsigned*)(X.lds + LDS_RT); LAS float* RT_W = (LAS float*)(X.lds + LDS_RT + 2048); LAS int* RT_TOK = (LAS int*)(X.lds + LDS_RT + 4096 - 0);
    LAS unsigned* RT_CNT = (LAS unsigned*)(X.lds + LDS_MISC + 1024); LAS unsigned* RT_BASE = (LAS unsigned*)(X.lds + LDS_MISC + 1280);
    if (tid < NSEG) RT_CNT[tid] = 0u;
    int nbatch = 0;
    __syncthreads();
    for (int unit = X.bid; unit < M / 32; unit += X.G) {
        *(LAS f32x4*)(LG + tid * 4) = (f32x4){0.f, 0.f, 0.f, 0.f};
        f32x4 vv[4][4];
#pragma unroll
        for (int rr = 0; rr < 4; ++rr) { const f32x4* yr = (const f32x4*)(Y1 + (size_t)(unit * 32 + wave * 4 + rr) * D) + lane;
#pragma unroll
            for (int j = 0; j < 4; ++j) vv[rr][j] = yr[64 * j]; }
#pragma unroll
        for (int rr = 0; rr < 4; ++rr) {
            const int rl = wave * 4 + rr, m = unit * 32 + rl;
            f32x4 v[4]; float s = 0.f;
#pragma unroll
            for (int j = 0; j < 4; ++j) { v[j] = vv[rr][j]; s += (v[j].x + v[j].y) + (v[j].z + v[j].w); }
            const float mean = wave_sum(s) * (1.f / D); float s2 = 0.f;
#pragma unroll
            for (int j = 0; j < 4; ++j) { v[j] = v[j] - mean; s2 += (v[j].x * v[j].x + v[j].y * v[j].y) + (v[j].z * v[j].z + v[j].w * v[j].w); }
            const float rstd = 1.f / sqrtf(wave_sum(s2) * (1.f / D) + LN_EPS);
            if (lane == 0) { ST1[2 * m] = mean; ST1[2 * m + 1] = rstd; }
#pragma unroll
            for (int j = 0; j < 4; ++j) {
                const f32x4 y = v[j] * rstd * gv[j] + bv[j];
                u32x2 hi; hi.x = pk2(y.x, y.y); hi.y = pk2(y.z, y.w);
                *((u32x2*)(HB + (size_t)m * D) + lane + 64 * j) = hi;
                const float l0 = y.x - __uint_as_float(hi.x << 16), l1 = y.y - __uint_as_float(hi.x & 0xffff0000u), l2 = y.z - __uint_as_float(hi.y << 16), l3 = y.w - __uint_as_float(hi.y & 0xffff0000u);
                u32x2 lo; lo.x = pk2(l0, l1); lo.y = pk2(l2, l3);
                const int chunk = (lane >> 1) + 32 * j; const unsigned byte = (unsigned)rl * 2048u + (unsigned)((chunk ^ (rl & 15)) * 16) + 8u * (lane & 1);
                *(LAS u32x2*)(HI + byte) = hi; *(LAS u32x2*)(LO + byte) = lo;
            }
        }
        __syncthreads();
        {
            f32x16 a0, a1;
#pragma unroll
            for (int e = 0; e < 16; ++e) { a0[e] = 0.f; a1[e] = 0.f; }
#pragma unroll
            for (int ks = 0; ks < 8; ++ks) {
                const int ch = 16 * wave + 2 * ks + hh; const unsigned byte = (unsigned)r * 2048u + (unsigned)((ch ^ (r & 15)) * 16);
                const bf16x8 ahi = *(const LAS bf16x8*)(HI + byte), alo = *(const LAS bf16x8*)(LO + byte);
                const size_t ko = (size_t)(128 * wave + 16 * ks + 8 * hh);
                const bf16x8 bh0 = *(const bf16x8*)(WR + (size_t)r * 1024 + ko), bh1 = *(const bf16x8*)(WR + (size_t)(32 + r) * 1024 + ko);
                const bf16x8 bl0 = *(const bf16x8*)(WR + (size_t)(64 + r) * 1024 + ko), bl1 = *(const bf16x8*)(WR + (size_t)(96 + r) * 1024 + ko);
                a0 = __builtin_amdgcn_mfma_f32_32x32x16_bf16(ahi, bh0, a0, 0, 0, 0); a0 = __builtin_amdgcn_mfma_f32_32x32x16_bf16(ahi, bl0, a0, 0, 0, 0); a0 = __builtin_amdgcn_mfma_f32_32x32x16_bf16(alo, bh0, a0, 0, 0, 0);
                a1 = __builtin_amdgcn_mfma_f32_32x32x16_bf16(ahi, bh1, a1, 0, 0, 0); a1 = __builtin_amdgcn_mfma_f32_32x32x16_bf16(ahi, bl1, a1, 0, 0, 0); a1 = __builtin_amdgcn_mfma_f32_32x32x16_bf16(alo, bh1, a1, 0, 0, 0);
            }
#pragma unroll
            for (int e = 0; e < 16; ++e) { const int row = (e & 3) + 8 * (e >> 2) + 4 * hh;
                __hip_atomic_fetch_add(LG + row * 64 + r, a0[e], __ATOMIC_RELAXED, __HIP_MEMORY_SCOPE_WORKGROUP);
                if (r < 4) __hip_atomic_fetch_add(LG + row * 64 + 32 + r, a1[e], __ATOMIC_RELAXED, __HIP_MEMORY_SCOPE_WORKGROUP); }
        }
        __syncthreads();
        if (tid < 32) {
            const LAS float* lg = LG + tid * 64;
            float gl[4]; float gmax = -3.4e38f; int gsel = 0;
#pragma unroll
            for (int j = 0; j < 4; ++j) { gl[j] = lg[j] + X.b_grp[j]; if (gl[j] > gmax) { gmax = gl[j]; gsel = j; } }
            float gz = 0.f;
#pragma unroll
            for (int j = 0; j < 4; ++j) gz += expf(gl[j] - gmax);
            const float gw = 1.f / gz;
            float e0 = -3.4e38f, e1 = -3.4e38f; int i0 = 0, i1 = 0;
#pragma unroll
            for (int j = 0; j < 8; ++j) { const float v = lg[4 + gsel * 8 + j] + X.b_rt[gsel * 8 + j];
                if (v > e0) { e1 = e0; i1 = i0; e0 = v; i0 = j; } else if (v > e1) { e1 = v; i1 = j; } }
            const float t = expf(e1 - e0), c0 = gw / (1.f + t), c1 = gw * t / (1.f + t);
            const int s0 = gsel * 8 + i0, s1 = 32 + gsel * 8 + i1;
            const unsigned l0 = __hip_atomic_fetch_add(RT_CNT + s0, 1u, __ATOMIC_RELAXED, __HIP_MEMORY_SCOPE_WORKGROUP), l1 = __hip_atomic_fetch_add(RT_CNT + s1, 1u, __ATOMIC_RELAXED, __HIP_MEMORY_SCOPE_WORKGROUP);
            const int slot = nbatch * 32 + tid;
            RT_SP[slot * 2] = ((unsigned)s0 << 16) | l0; RT_SP[slot * 2 + 1] = ((unsigned)s1 << 16) | l1; RT_W[slot * 2] = c0; RT_W[slot * 2 + 1] = c1; RT_TOK[slot] = unit * 32 + tid;
        }
        ++nbatch;
        __syncthreads();
        if (nbatch == 8 || unit + X.G >= M / 32) {
            if (tid < NSEG) { const unsigned n = RT_CNT[tid]; RT_BASE[tid] = n ? __hip_atomic_fetch_add(CNT + tid, n, __ATOMIC_RELAXED, __HIP_MEMORY_SCOPE_AGENT) : 0u; }
            __syncthreads();
            if (tid < nbatch * 32) {
#pragma unroll
                for (int k = 0; k < 2; ++k) { const unsigned sp = RT_SP[tid * 2 + k], sg = sp >> 16, ps = RT_BASE[sg] + (sp & 0xffffu);
                    LIST[(size_t)sg * M + ps] = RT_TOK[tid]; LISTW[(size_t)sg * M + ps] = RT_W[tid * 2 + k]; }
            }
            __syncthreads();
            if (tid < NSEG) RT_CNT[tid] = 0u;
            nbatch = 0;
            __syncthreads();
        }
    }
}

DI void moe_prep(const Ctx& X) {
    const int tid = X.wid * 64 + lane_id();
    LAS int* tstart = (LAS int*)(X.lds + LDS_MISC + 64); LAS int* scnt = (LAS int*)(X.lds + LDS_MISC + 512);
    unsigned* CNT = wsp<unsigned>(X, WS_CTL) + CW_CNT;
    if (tid < NSEG) scnt[tid] = (int)__hip_atomic_load(CNT + tid, __ATOMIC_RELAXED, __HIP_MEMORY_SCOPE_AGENT);
    __syncthreads();
    if (tid == 0) { int a = 0; for (int s = 0; s < NSEG; ++s) { tstart[s] = a; a += (scnt[s] + 255) >> 8; } tstart[NSEG] = a; }
    __syncthreads();
}

DI void p9_ln2(const Ctx& X) {
    const int lane = lane_id(), wave = X.wid;
    const int gw = X.bid * 8 + wave, NGW = X.G * 8;
    const float* Y1 = wsp<float>(X, WS_A); const float* ST1 = wsp<float>(X, WS_STATS1); const bf16_t* PP0 = wsp<bf16_t>(X, WS_C); const bf16_t* PP1 = PP0 + (size_t)M * 1024;
    f32x4 gv[4], bv[4], g1[4], b1[4];
#pragma unroll
    for (int j = 0; j < 4; ++j) { gv[j] = *(const f32x4*)(X.ln2_g + 4 * lane + 256 * j); bv[j] = *(const f32x4*)(X.ln2_b + 4 * lane + 256 * j);
        g1[j] = *(const f32x4*)(X.ln1_g + 4 * lane + 256 * j) * ALPHA; b1[j] = *(const f32x4*)(X.ln1_b + 4 * lane + 256 * j) * ALPHA; }
    for (int m = gw; m < M; m += NGW) {
        f32x4 v[4]; float s = 0.f; const float mean1 = ST1[2 * m], rstd1 = ST1[2 * m + 1];
#pragma unroll
        for (int j = 0; j < 4; ++j) {
            const f32x4 yv = *((const f32x4*)(Y1 + (size_t)m * D) + lane + 64 * j);
            const u32x2 a = *((const u32x2*)(PP0 + (size_t)m * D) + lane + 64 * j), b = *((const u32x2*)(PP1 + (size_t)m * D) + lane + 64 * j);
            f32x4 y = (yv - mean1) * rstd1 * g1[j] + b1[j];
            y.x += __uint_as_float(a.x << 16) + __uint_as_float(b.x << 16); y.y += __uint_as_float(a.x & 0xffff0000u) + __uint_as_float(b.x & 0xffff0000u);
            y.z += __uint_as_float(a.y << 16) + __uint_as_float(b.y << 16); y.w += __uint_as_float(a.y & 0xffff0000u) + __uint_as_float(b.y & 0xffff0000u);
            v[j] = y; s += (y.x + y.y) + (y.z + y.w);
        }
        const float mean = wave_sum(s) * (1.f / D); float s2 = 0.f;
#pragma unroll
        for (int j = 0; j < 4; ++j) { v[j] = v[j] - mean; s2 += (v[j].x * v[j].x + v[j].y * v[j].y) + (v[j].z * v[j].z + v[j].w * v[j].w); }
        const float rstd = 1.f / sqrtf(wave_sum(s2) * (1.f / D) + LN_EPS);
#pragma unroll
        for (int j = 0; j < 4; ++j) *((f32x4*)(X.out + (size_t)m * D) + lane + 64 * j) = v[j] * rstd * gv[j] + bv[j];
    }
}

#define MFMA32(a, b, c) __builtin_amdgcn_mfma_f32_32x32x16_bf16((a), (b), (c), 0, 0, 0)
DI bf16x8 pack8(const f32x16& x, int s) {
    u32x4 p; p.x = pk2(x[8 * s + 0], x[8 * s + 1]); p.y = pk2(x[8 * s + 2], x[8 * s + 3]); p.z = pk2(x[8 * s + 4], x[8 * s + 5]); p.w = pk2(x[8 * s + 6], x[8 * s + 7]);
    return __builtin_bit_cast(bf16x8, p);
}
struct TrRegs { s16x4 t0, t1, t2, t3, t4, t5, t6, t7; };
DI void tr_issue8(unsigned addr, TrRegs& T) {
    asm volatile("ds_read_b64_tr_b16 %0, %8\n\tds_read_b64_tr_b16 %1, %8 offset:1024\n\tds_read_b64_tr_b16 %2, %8 offset:2048\n\tds_read_b64_tr_b16 %3, %8 offset:3072\n\t"
                 "ds_read_b64_tr_b16 %4, %8 offset:4096\n\tds_read_b64_tr_b16 %5, %8 offset:5120\n\tds_read_b64_tr_b16 %6, %8 offset:6144\n\tds_read_b64_tr_b16 %7, %8 offset:7168"
                 : "=&v"(T.t0), "=&v"(T.t1), "=&v"(T.t2), "=&v"(T.t3), "=&v"(T.t4), "=&v"(T.t5), "=&v"(T.t6), "=&v"(T.t7) : "v"(addr) : "memory");
}
DI void tr_wait(TrRegs& A, TrRegs& B) {
    asm volatile("s_waitcnt lgkmcnt(0)" : "+v"(A.t0), "+v"(A.t1), "+v"(A.t2), "+v"(A.t3), "+v"(A.t4), "+v"(A.t5), "+v"(A.t6), "+v"(A.t7),
                 "+v"(B.t0), "+v"(B.t1), "+v"(B.t2), "+v"(B.t3), "+v"(B.t4), "+v"(B.t5), "+v"(B.t6), "+v"(B.t7) :: "memory");
}
DI void tr_frags(const TrRegs& T, bf16x8 (&vf)[4]) {
    vf[0] = __builtin_shufflevector(T.t0, T.t1, 0, 1, 2, 3, 4, 5, 6, 7); vf[1] = __builtin_shufflevector(T.t2, T.t3, 0, 1, 2, 3, 4, 5, 6, 7);
    vf[2] = __builtin_shufflevector(T.t4, T.t5, 0, 1, 2, 3, 4, 5, 6, 7); vf[3] = __builtin_shufflevector(T.t6, T.t7, 0, 1, 2, 3, 4, 5, 6, 7);
}
DI float xhalf_max(float x) {
    const unsigned u = __float_as_uint(x);
    const auto r = __builtin_amdgcn_permlane32_swap(u, u, false, false);
    return fmaxf(__uint_as_float(r[0]), __uint_as_float(r[1]));
}
constexpr float M_FLOOR = -64.f, SM_THR = 4.f;
DI void softmax_tile(f32x16& s0, f32x16& s1, float& meff, float& lrun, f32x16& o0, f32x16& o1, bf16x8 (&pf)[4]) {
    float mx = fmaxf(s0[0], s1[0]);
#pragma unroll
    for (int e = 1; e < 16; ++e) mx = fmaxf(mx, fmaxf(s0[e], s1[e]));
    mx = xhalf_max(mx);
    if (__any(mx > SM_THR)) {
        const float delta = fmaxf(mx, 0.f), alpha = fast_exp2(-delta);
#pragma unroll
        for (int e = 0; e < 16; ++e) { s0[e] -= delta; s1[e] -= delta; o0[e] *= alpha; o1[e] *= alpha; }
        lrun *= alpha; meff += delta;
    }
    float ls = 0.f;
#pragma unroll
    for (int e = 0; e < 16; ++e) { s0[e] = fast_exp2(s0[e]); s1[e] = fast_exp2(s1[e]); ls += s0[e] + s1[e]; }
    lrun += ls;
    pf[0] = pack8(s0, 0); pf[1] = pack8(s0, 1); pf[2] = pack8(s1, 0); pf[3] = pack8(s1, 1);
}
DI int next_tile(const int* TS, int j, int qmax) { for (++j; j < 32; ++j) if (TS[j * 4] <= qmax) break; return j; }

DI void mla_unit(const Ctx& X, int b, int h, int qb) {
    const int lane = lane_id(), w = X.wid, tid = w * 64 + lane, r = lane & 31, hh = lane >> 5;
    LAS unsigned char* lds = X.lds; const unsigned ldsb = (unsigned)(uintptr_t)lds;
    const int tok0 = b * SEQ;
    const bf16_t* QM = wsp<bf16_t>(X, WS_QM); const bf16_t* KN = wsp<bf16_t>(X, WS_KN); const bf16_t* VM = wsp<bf16_t>(X, WS_VM); const bf16_t* KR = wsp<bf16_t>(X, WS_KR);
    bf16_t* OA = wsp<bf16_t>(X, WS_B);
    const int* TS = wsp<int>(X, WS_TSTAT) + (size_t)b * 32 * 4;
    const int qrow = tok0 + qb * 256 + w * 32 + r;
    bf16x8 qf[6];
#pragma unroll
    for (int s = 0; s < 6; ++s) qf[s] = *(const bf16x8*)(QM + (size_t)qrow * 768 + h * 96 + 16 * s + 8 * hh);
    const int qc = X.pos[qrow] >> 6;
    const i32x4 tsv = *(const i32x4*)(TS + 4 * (lane & 31));
    int qmin = 0x7fffffff, qmax = -0x7fffffff - 1;
#pragma unroll
    for (int t = 0; t < 4; ++t) { const int a = __builtin_amdgcn_readlane(tsv[0], qb * 4 + t), c = __builtin_amdgcn_readlane(tsv[1], qb * 4 + t); qmin = a < qmin ? a : qmin; qmax = c > qmax ? c : qmax; }
    unsigned procm = (unsigned)__ballot(lane < 32 && tsv[0] <= qmax);
    const unsigned maskm = (unsigned)__ballot(lane < 32 && tsv[1] > qmin);
    f32x16 o0, o1;
#pragma unroll
    for (int e = 0; e < 16; ++e) { o0[e] = 0.f; o1[e] = 0.f; }
    float mrun = M_FLOOR, lrun = 0.f;
    const int key_a = tid >> 3, ch_a = tid & 7, key_r = (tid >> 2) & 63, ch_r = tid & 3;
    const unsigned kdst = 192u * key_a + 16u * (ch_a ^ ((key_a >> 2) & 3)), vdst = 12288u + 128u * key_a + 16u * (ch_a ^ (((key_a >> 1) & 1) << 2));
    const unsigned rdst = 192u * key_r + 16u * ((8 + ch_r) ^ ((key_r >> 2) & 3));
    constexpr unsigned BUFB = 20736u;
    const int q4 = (lane & 15) >> 2, p4 = lane & 3, blk = (lane >> 4) & 1, sw = (q4 >> 1) & 1;
    const unsigned vbase = ldsb + 12288u + 128u * (4 * hh + q4) + 16u * (2 * blk + (p4 >> 1)) + 8u * (p4 & 1);
    const unsigned va0 = vbase + 64u * sw, va1 = vbase + 64u * (1 - sw);
    u32x4 rk, rv, rr = {0u, 0u, 0u, 0u}; int rkc = 0;
#define MLA_LOAD(j) do { const size_t t0_ = (size_t)tok0 + (size_t)(j) * 64; rk = *(const u32x4*)(KN + (t0_ + key_a) * 512 + h * 64 + ch_a * 8); rv = *(const u32x4*)(VM + (t0_ + key_a) * 512 + h * 64 + ch_a * 8); \
        if (tid < 256) rr = *(const u32x4*)(KR + (t0_ + key_r) * 32 + ch_r * 8); if (tid < 64) rkc = X.pos[t0_ + tid]; } while (0)
#define MLA_STORE(bo) do { *(LAS u32x4*)(lds + (bo) + kdst) = rk; *(LAS u32x4*)(lds + (bo) + vdst) = rv; if (tid < 256) *(LAS u32x4*)(lds + (bo) + rdst) = rr; if (tid < 64) *(LAS int*)(lds + (bo) + 20480u + 4u * tid) = rkc >> 6; } while (0)
    asm volatile("" :: "v"(qf[0]), "v"(qf[1]), "v"(qf[2]), "v"(qf[3]), "v"(qf[4]), "v"(qf[5]));
    int j = procm ? __builtin_ctz(procm) : 32; procm &= procm - 1u;
    unsigned cur = 0;
    if (j < 32) { MLA_LOAD(j); MLA_STORE(0u); }
    __syncthreads();
    f32x16 s0, s1; bf16x8 pf[4];
#define MLA_QK(bo_, j_) do { const float nm = -mrun; \
        if ((maskm >> (j_)) & 1u) { _Pragma("unroll") for (int g = 0; g < 4; ++g) { \
                const i32x4 c0 = *(const LAS i32x4*)(lds + (bo_) + 20480u + 4u * (8 * g + 4 * hh)), c1 = *(const LAS i32x4*)(lds + (bo_) + 20480u + 4u * (32 + 8 * g + 4 * hh)); \
                _Pragma("unroll") for (int e = 0; e < 4; ++e) { s0[4 * g + e] = c0[e] > qc ? NEGF : nm; s1[4 * g + e] = c1[e] > qc ? NEGF : nm; } } } \
        else { _Pragma("unroll") for (int e = 0; e < 16; ++e) { s0[e] = nm; s1[e] = nm; } } \
        _Pragma("unroll") for (int ks = 0; ks < 6; ++ks) { const unsigned ko = 192u * r + 16u * ((2 * ks + hh) ^ ((r >> 2) & 3)); \
            const bf16x8 a0 = *(const LAS bf16x8*)(lds + (bo_) + ko), a1 = *(const LAS bf16x8*)(lds + (bo_) + ko + 192u * 32u); \
            s0 = MFMA32(a0, qf[ks], s0); s1 = MFMA32(a1, qf[ks], s1); } } while (0)
#define MLA_PV(bo_) do { TrRegs TA, TB; tr_issue8(va0 + (bo_), TA); tr_issue8(va1 + (bo_), TB); tr_wait(TA, TB); bf16x8 vf[4]; tr_frags(TA, vf); \
        _Pragma("unroll") for (int k = 0; k < 4; ++k) o0 = MFMA32(vf[k], pf[k], o0); tr_frags(TB, vf); \
        _Pragma("unroll") for (int k = 0; k < 4; ++k) o1 = MFMA32(vf[k], pf[k], o1); } while (0)
    if (w < 4) {
        while (j < 32) {
            const int jn = procm ? __builtin_ctz(procm) : 32; procm &= procm - 1u;
            if (jn < 32) MLA_LOAD(jn);
            const unsigned bo = cur * BUFB;
            MLA_QK(bo, j);
            softmax_tile(s0, s1, mrun, lrun, o0, o1, pf);
            MLA_PV(bo);
            cur = cur == 2u ? 0u : cur + 1u;
            if (jn < 32) MLA_STORE(cur * BUFB);
            __syncthreads();
            j = jn;
        }
    } else {
        bool have = false; unsigned pbo = 0u;
        while (j < 32) {
            const int jn = procm ? __builtin_ctz(procm) : 32; procm &= procm - 1u;
            if (jn < 32) MLA_LOAD(jn);
            const unsigned bo = cur * BUFB;
            if (have) MLA_PV(pbo);
            MLA_QK(bo, j);
            softmax_tile(s0, s1, mrun, lrun, o0, o1, pf);
            pbo = bo; have = true;
            cur = cur == 2u ? 0u : cur + 1u;
            if (jn < 32) MLA_STORE(cur * BUFB);
            __syncthreads();
            j = jn;
        }
        if (have) MLA_PV(pbo);
    }
    __syncthreads();
#undef MLA_QK
#undef MLA_PV
#undef MLA_LOAD
#undef MLA_STORE
    const float inv = 1.f / (lrun + __shfl_xor(lrun, 32));
    bf16_t* op = OA + (size_t)qrow * 1024 + h * 64 + 4 * hh;
#pragma unroll
    for (int g = 0; g < 4; ++g) {
        u32x2 a, c; a.x = pk2(o0[4 * g] * inv, o0[4 * g + 1] * inv); a.y = pk2(o0[4 * g + 2] * inv, o0[4 * g + 3] * inv);
        c.x = pk2(o1[4 * g] * inv, o1[4 * g + 1] * inv); c.y = pk2(o1[4 * g + 2] * inv, o1[4 * g + 3] * inv);
        *(u32x2*)(op + 8 * g) = a; *(u32x2*)(op + 32 + 8 * g) = c;
    }
}

DI int t5_bucket(int rel) { const int n = rel < 0 ? -rel : rel;
    const int large = 8 + (n >= 12) + (n >= 16) + (n >= 23) + (n >= 32) + (n >= 46) + (n >= 64) + (n >= 91);
    return (rel > 0 ? 16 : 0) + (n < 8 ? n : large); }
DI void dsa_scan(LAS unsigned char* lds, int p, int lane, int w) {
    constexpr unsigned L_HIST = 17408u, L_PRE = 58368u, L_NEED = 58496u, L_ACT = 66944u;
    const int shift = 24 - 8 * p;
    const int ql = lane >> 4, part = lane & 15, q = 4 * w + ql;
    unsigned c[16]; unsigned sum = 0u;
#pragma unroll
    for (int t = 0; t < 16; ++t) { c[t] = *(const LAS unsigned*)(lds + L_HIST + 4u * ((16 * part + t) * 32 + q)); sum += c[t]; }
    unsigned sfx = sum;
#pragma unroll
    for (int d = 1; d < 16; d <<= 1) { const unsigned t = __shfl_down(sfx, d, 16); if (part + d < 16) sfx += t; }
    const unsigned total = __shfl(sfx, lane & ~15);
    const unsigned nd = *(const LAS unsigned*)(lds + L_NEED + 4u * q), pold = *(const LAS unsigned*)(lds + L_PRE + 4u * q);
    const unsigned excl = sfx - sum;
    if (nd != 0u && nd != 0xFFFFFFFFu) {
        if (total < nd) { if (part == 0) *(LAS unsigned*)(lds + L_NEED + 4u * q) = 0u; }
        else if (excl < nd && nd <= sfx) {
            unsigned run = excl, bsel = 0u, ndn = 0u, cb = 0u; bool found = false;
#pragma unroll
            for (int t = 15; t >= 0; --t) { if (!found && run + c[t] >= nd) { found = true; bsel = (unsigned)(16 * part + t); ndn = nd - run; cb = c[t]; } if (!found) run += c[t]; }
            const bool resolved = (ndn == cb);
            *(LAS unsigned*)(lds + L_PRE + 4u * q) = pold | (bsel << shift); *(LAS unsigned*)(lds + L_NEED + 4u * q) = resolved ? 0xFFFFFFFFu : ndn;
            if (!resolved) __hip_atomic_fetch_add((LAS unsigned*)(lds + L_ACT) + p, 1u, __ATOMIC_RELAXED, __HIP_MEMORY_SCOPE_WORKGROUP);
        }
    }
}
DI void dsa_attend(const Ctx& X, int b, int qt, int tid, unsigned proc);
template <bool ATTEND>
DI void dsa_unit(const Ctx& X, int b, int qt) {
    const int lane = lane_id(), w = X.wid, tid = w * 64 + lane, r = lane & 31, hh = lane >> 5;
    LAS unsigned char* lds = X.lds; const unsigned ldsb = (unsigned)(uintptr_t)lds;
    constexpr unsigned L_QIT = 0u  , L_HIST = 17408u, L_MSK = 50176u, L_PRE = 58368u, L_NEED = 58496u, L_BT = 58624u, L_KV = 67072u, KVB = 16640u;
    const int tok0 = b * SEQ, q0 = tok0 + qt * 32;
    const bf16_t* QI = wsp<bf16_t>(X, WS_QI); const bf16_t* KI = wsp<bf16_t>(X, WS_KI); const bf16_t* QB = wsp<bf16_t>(X, WS_QB);
    const bf16_t* KB = wsp<bf16_t>(X, WS_KB); const bf16_t* VB = wsp<bf16_t>(X, WS_VB); const float* WI = wsp<float>(X, WS_WI);
    bf16_t* OB = wsp<bf16_t>(X, WS_B) + (size_t)M * 512;
    const int* TS = wsp<int>(X, WS_TSTAT) + (size_t)b * 32 * 4;
    const i32x4 tsv = *(const i32x4*)(TS + 4 * (lane & 31));
    const int qmax = __builtin_amdgcn_readlane(tsv[1], qt >> 1);
    const unsigned proc = (unsigned)__ballot(lane < 32 && tsv[0] <= qmax);
#pragma unroll
    for (int i = 0; i < 2; ++i) { const int c = tid + 512 * i, row = c >> 5, ch = c & 31;
        *(LAS u32x4*)(lds + L_QIT + row * 528 + ch * 16) = *(const u32x4*)(QI + (size_t)(q0 + row) * 256 + ch * 8); }
    if (tid < 257) { const int bk = t5_bucket(tid - 128);
#pragma unroll
        for (int hd = 0; hd < 8; ++hd) *(LAS float*)(lds + L_BT + 4u * (hd * 260 + tid)) = LOG2E * (X.rel_bias[bk * 8 + hd] - X.rel_bias[15 * 8 + hd]); }
    if (tid < 32) { *(LAS unsigned*)(lds + L_PRE + 4u * tid) = 0u; *(LAS unsigned*)(lds + L_NEED + 4u * tid) = 256u; }
    if (tid < 4) *(LAS unsigned*)(lds + 66944u + 4u * tid) = 0u;
#pragma unroll
    for (int i = 0; i < 4; ++i) *(LAS u32x4*)(lds + L_HIST + 16u * (tid + 512 * i)) = (u32x4){0u, 0u, 0u, 0u};
    const int pos_q = X.pos[q0 + r], qc = pos_q >> 6;
    float wq[8];
    { const f32x4 wa = *(const f32x4*)(WI + (size_t)(q0 + r) * 8), wb = *(const f32x4*)(WI + (size_t)(q0 + r) * 8 + 4);
      wq[0] = wa[0]; wq[1] = wa[1]; wq[2] = wa[2]; wq[3] = wa[3]; wq[4] = wb[0]; wq[5] = wb[1]; wq[6] = wb[2]; wq[7] = wb[3]; }
    __syncthreads();
    unsigned keys[8][16];
    bf16x8 nka0, nka1; i32x4 npk[4];
#define DSA_PREF(i_) do { const int jt_ = w + 8 * (i_); if ((proc >> (jt_ >> 1)) & 1u) { const size_t kr_ = (size_t)tok0 + jt_ * 32; \
        nka0 = *(const bf16x8*)(KI + (kr_ + r) * 32 + 8 * hh); nka1 = *(const bf16x8*)(KI + (kr_ + r) * 32 + 16 + 8 * hh); \
        _Pragma("unroll") for (int g_ = 0; g_ < 4; ++g_) npk[g_] = *(const i32x4*)(X.pos + kr_ + 8 * g_ + 4 * hh); } } while (0)
    DSA_PREF(0);
#pragma unroll
    for (int i = 0; i < 8; ++i) {
        const int jt = w + 8 * i;
        const bf16x8 ka0 = nka0, ka1 = nka1; i32x4 pk4[4];
#pragma unroll
        for (int g = 0; g < 4; ++g) pk4[g] = npk[g];
        if (i < 7) DSA_PREF(i + 1);
        if ((proc >> (jt >> 1)) & 1u) {
            f32x16 sc;
#pragma unroll
            for (int e = 0; e < 16; ++e) sc[e] = 0.f;
#pragma unroll
            for (int hd = 0; hd < 8; ++hd) {
                f32x16 S;
#pragma unroll
                for (int e = 0; e < 16; ++e) S[e] = 0.f;
                const bf16x8 b0 = *(const LAS bf16x8*)(lds + L_QIT + r * 528 + hh * 16 + hd * 64), b1 = *(const LAS bf16x8*)(lds + L_QIT + r * 528 + hh * 16 + hd * 64 + 32);
                S = MFMA32(ka0, b0, S); S = MFMA32(ka1, b1, S);
#pragma unroll
                for (int e = 0; e < 16; ++e) sc[e] += wq[hd] * __builtin_amdgcn_fmed3f(S[e], 0.f, 3.0e38f);
                asm volatile("" : "+v"(sc));
            }
#pragma unroll
            for (int g = 0; g < 4; ++g) {
#pragma unroll
                for (int e = 0; e < 4; ++e) { const int sidx = jt * 32 + 8 * g + 4 * hh + e; const unsigned u = __float_as_uint(sc[4 * g + e]);
                    const unsigned srt = u ^ ((unsigned)((int)u >> 31) | 0x80000000u);
                    unsigned kk = (srt & 0xFFFFF800u) | (unsigned)(2047 - sidx); kk = ((pk4[g][e] >> 6) <= qc) ? kk : 0u; keys[i][4 * g + e] = kk;
                    __hip_atomic_fetch_add((LAS unsigned*)(lds + L_HIST) + r + (kk >> 24) * 32u, 1u, __ATOMIC_RELAXED, __HIP_MEMORY_SCOPE_WORKGROUP); }
            }
        } else {
#pragma unroll
            for (int e = 0; e < 16; ++e) keys[i][e] = 0u;
        }
        __builtin_amdgcn_sched_barrier(0);
    }
#undef DSA_PREF
    __syncthreads();
    dsa_scan(lds, 0, lane, w);
    __syncthreads();
#pragma unroll 1
    for (int p = 1; p < 4; ++p) {
        if (*(const LAS unsigned*)(lds + 66944u + 4u * (p - 1)) == 0u) break;
        const int shift = 24 - 8 * p;
#pragma unroll
        for (int i = 0; i < 4; ++i) *(LAS u32x4*)(lds + L_HIST + 16u * (tid + 512 * i)) = (u32x4){0u, 0u, 0u, 0u};
        __syncthreads();
        {
            const unsigned pre = *(const LAS unsigned*)(lds + L_PRE + 4u * r), ndq = *(const LAS unsigned*)(lds + L_NEED + 4u * r);
            unsigned P = pre, lim = (ndq == 0u || ndq == 0xFFFFFFFFu) ? 0u : (1u << (shift + 8));
            asm volatile("" : "+v"(P), "+v"(lim));
            LAS unsigned* hq = (LAS unsigned*)(lds + L_HIST) + r;
#pragma unroll
            for (int i = 0; i < 8; ++i) {
                if ((proc >> ((w + 8 * i) >> 1)) & 1u) {
                    unsigned mn = 0xFFFFFFFFu;
#pragma unroll
                    for (int e = 0; e < 16; ++e) { const unsigned x = keys[i][e] ^ P; mn = x < mn ? x : mn; }
                    if (__any(mn < lim)) {
                        unsigned P2 = P; asm volatile("" : "+v"(P2));
#pragma unroll
                        for (int e = 0; e < 16; ++e) { const unsigned x = keys[i][e] ^ P2;
                            if (x < lim) __hip_atomic_fetch_add(hq + ((x >> shift) & 255u) * 32u, 1u, __ATOMIC_RELAXED, __HIP_MEMORY_SCOPE_WORKGROUP); }
                    }
                }
                __builtin_amdgcn_sched_barrier(0);
            }
        }
        __syncthreads();
        dsa_scan(lds, p, lane, w);
        __syncthreads();
    }
    {
        const unsigned nd = *(const LAS unsigned*)(lds + L_NEED + 4u * r), pr = *(const LAS unsigned*)(lds + L_PRE + 4u * r);
        const unsigned T = nd == 0u ? 0u : pr, thr = T > 2048u ? T : 2048u;
#pragma unroll
        for (int i = 0; i < 8; ++i) { const int jt = w + 8 * i; unsigned bits = 0u;
#pragma unroll
            for (int e = 0; e < 16; ++e) bits |= (keys[i][e] >= thr ? 1u : 0u) << e;
            *(LAS unsigned short*)(lds + L_MSK + 2u * ((jt * 2 + hh) * 32 + r)) = (unsigned short)bits; }
    }
    __syncthreads();
    if constexpr (ATTEND) dsa_attend(X, b, qt, X.wid * 64 + lane_id(), proc); else __syncthreads();
}
DI void dsa_attend(const Ctx& X, int b, int qt, int tid, unsigned proc) {
    const int lane = tid & 63, w = X.wid, r = lane & 31, hh = lane >> 5;
    LAS unsigned char* lds = X.lds; const unsigned ldsb = (unsigned)(uintptr_t)lds;
    constexpr unsigned L_MSK = 50176u, L_BT = 58624u, L_KV = 67072u, KVB = 16640u;
    const int tok0 = b * SEQ, q0 = tok0 + qt * 32;
    const bf16_t* QB = wsp<bf16_t>(X, WS_QB); const bf16_t* KB = wsp<bf16_t>(X, WS_KB); const bf16_t* VB = wsp<bf16_t>(X, WS_VB);
    bf16_t* OB = wsp<bf16_t>(X, WS_B) + 512;
    const int* TS = wsp<int>(X, WS_TSTAT) + (size_t)b * 32 * 4;
    const i32x4 tsv = *(const i32x4*)(TS + 4 * (lane & 31));
    const int posmin_q = __builtin_amdgcn_readlane(tsv[2], qt >> 1);
    const unsigned nearm = (unsigned)__ballot(lane < 32 && tsv[3] - posmin_q > -128);
    unsigned procm = proc;
    const int pos_q = X.pos[q0 + r];
    bf16x8 qf[4];
#pragma unroll
    for (int s = 0; s < 4; ++s) qf[s] = *(const bf16x8*)(QB + (size_t)(q0 + r) * 512 + w * 64 + 16 * s + 8 * hh);
    f32x16 o0, o1;
#pragma unroll
    for (int e = 0; e < 16; ++e) { o0[e] = 0.f; o1[e] = 0.f; }
    float mrun = M_FLOOR, lrun = 0.f;
    const int key_a = tid >> 3, ch_a = tid & 7;
    const unsigned kdst = 128u * key_a + 16u * (ch_a ^ ((key_a >> 1) & 7)), vdst = 8192u + 128u * key_a + 16u * (ch_a ^ (((key_a >> 1) & 1) << 2));
    const int q4 = (lane & 15) >> 2, p4 = lane & 3, blk = (lane >> 4) & 1, sw = (q4 >> 1) & 1;
    const unsigned vbase = ldsb + L_KV + 8192u + 128u * (4 * hh + q4) + 16u * (2 * blk + (p4 >> 1)) + 8u * (p4 & 1);
    const unsigned va0 = vbase + 64u * sw, va1 = vbase + 64u * (1 - sw);
    u32x4 rk, rv; int rp = 0;
#define DSA_LOAD(j) do { const size_t t0_ = (size_t)tok0 + (size_t)(j) * 64; rk = *(const u32x4*)(KB + (t0_ + key_a) * 64 + ch_a * 8); rv = *(const u32x4*)(VB + (t0_ + key_a) * 64 + ch_a * 8); \
        if (tid < 64) rp = X.pos[t0_ + tid]; } while (0)
#define DSA_STORE(bo) do { *(LAS u32x4*)(lds + L_KV + (bo) + kdst) = rk; *(LAS u32x4*)(lds + L_KV + (bo) + vdst) = rv; if (tid < 64) *(LAS int*)(lds + L_KV + (bo) + 16384u + 4u * tid) = rp; } while (0)
    asm volatile("" :: "v"(qf[0]), "v"(qf[1]), "v"(qf[2]), "v"(qf[3]), "v"(pos_q));
    int j = procm ? __builtin_ctz(procm) : 32; procm &= procm - 1u;
    unsigned cur = 0;
    if (j < 32) { DSA_LOAD(j); DSA_STORE(0u); }
    __syncthreads();
    f32x16 s0, s1; bf16x8 pf[4];
#define DSA_QK(bo_, j_) do { const float nm = -mrun; \
        const unsigned m0 = *(const LAS unsigned short*)(lds + L_MSK + 2u * (((2 * (j_)) * 2 + hh) * 32 + r)), m1 = *(const LAS unsigned short*)(lds + L_MSK + 2u * (((2 * (j_) + 1) * 2 + hh) * 32 + r)); \
        if ((nearm >> (j_)) & 1u) { _Pragma("unroll") for (int g = 0; g < 4; ++g) { \
                const i32x4 c0 = *(const LAS i32x4*)(lds + L_KV + (bo_) + 16384u + 4u * (8 * g + 4 * hh)), c1 = *(const LAS i32x4*)(lds + L_KV + (bo_) + 16384u + 4u * (32 + 8 * g + 4 * hh)); \
                _Pragma("unroll") for (int e = 0; e < 4; ++e) { \
                    int d0 = c0[e] - pos_q, d1 = c1[e] - pos_q; d0 = d0 < -128 ? -128 : (d0 > 128 ? 128 : d0); d1 = d1 < -128 ? -128 : (d1 > 128 ? 128 : d1); \
                    const float b0 = *(const LAS float*)(lds + L_BT + 4u * (w * 260 + d0 + 128)) + nm, b1 = *(const LAS float*)(lds + L_BT + 4u * (w * 260 + d1 + 128)) + nm; \
                    s0[4 * g + e] = ((m0 >> (4 * g + e)) & 1u) ? b0 : NEGF; s1[4 * g + e] = ((m1 >> (4 * g + e)) & 1u) ? b1 : NEGF; } } } \
        else { _Pragma("unroll") for (int e = 0; e < 16; ++e) { s0[e] = ((m0 >> e) & 1u) ? nm : NEGF; s1[e] = ((m1 >> e) & 1u) ? nm : NEGF; } } \
        _Pragma("unroll") for (int ks = 0; ks < 4; ++ks) { const unsigned ko = 128u * r + 16u * ((2 * ks + hh) ^ ((r >> 1) & 7)); \
            const bf16x8 a0 = *(const LAS bf16x8*)(lds + L_KV + (bo_) + ko), a1 = *(const LAS bf16x8*)(lds + L_KV + (bo_) + ko + 128u * 32u); \
            s0 = MFMA32(a0, qf[ks], s0); s1 = MFMA32(a1, qf[ks], s1); } } while (0)
#define DSA_PV(bo_) do { TrRegs TA, TB; tr_issue8(va0 + (bo_), TA); tr_issue8(va1 + (bo_), TB); tr_wait(TA, TB); bf16x8 vf[4]; tr_frags(TA, vf); \
        _Pragma("unroll") for (int k = 0; k < 4; ++k) o0 = MFMA32(vf[k], pf[k], o0); tr_frags(TB, vf); \
        _Pragma("unroll") for (int k = 0; k < 4; ++k) o1 = MFMA32(vf[k], pf[k], o1); } while (0)
    if (w < 4) {
        while (j < 32) {
            const int jn = procm ? __builtin_ctz(procm) : 32; procm &= procm - 1u;
            if (jn < 32) DSA_LOAD(jn);
            const unsigned bo = cur * KVB;
            DSA_QK(bo, j);
            softmax_tile(s0, s1, mrun, lrun, o0, o1, pf);
            DSA_PV(bo);
            cur = cur == 2u ? 0u : cur + 1u;
            if (jn < 32) DSA_STORE(cur * KVB);
            __syncthreads();
            j = jn;
        }
    } else {
        bool have = false; unsigned pbo = 0u;
        while (j < 32) {
            const int jn = procm ? __builtin_ctz(procm) : 32; procm &= procm - 1u;
            if (jn < 32) DSA_LOAD(jn);
            const unsigned bo = cur * KVB;
            if (have) DSA_PV(pbo);
            DSA_QK(bo, j);
            softmax_tile(s0, s1, mrun, lrun, o0, o1, pf);
            pbo = bo; have = true;
            cur = cur == 2u ? 0u : cur + 1u;
            if (jn < 32) DSA_STORE(cur * KVB);
            __syncthreads();
            j = jn;
        }
        if (have) DSA_PV(pbo);
    }
#undef DSA_QK
#undef DSA_PV
#undef DSA_LOAD
#undef DSA_STORE
    const float inv = 1.f / (lrun + __shfl_xor(lrun, 32));
    bf16_t* op = OB + (size_t)(q0 + r) * 1024 + w * 64 + 4 * hh;
#pragma unroll
    for (int g = 0; g < 4; ++g) {
        u32x2 a, c; a.x = pk2(o0[4 * g] * inv, o0[4 * g + 1] * inv); a.y = pk2(o0[4 * g + 2] * inv, o0[4 * g + 3] * inv);
        c.x = pk2(o1[4 * g] * inv, o1[4 * g + 1] * inv); c.y = pk2(o1[4 * g + 2] * inv, o1[4 * g + 3] * inv);
        *(u32x2*)(op + 8 * g) = a; *(u32x2*)(op + 32 + 8 * g) = c;
    }
    __syncthreads();
}

constexpr int N_PHASES = 10;
template <int PHM>
__global__ void __launch_bounds__(512, 2) fwd_kernel(Args args) {
    extern __shared__ __attribute__((aligned(16))) unsigned char lds_raw[];
    Ctx X;
    X.x = (const float*)args.in[0]; X.pos = (const int*)args.in[1]; X.ln0_g = (const float*)args.in[2]; X.ln0_b = (const float*)args.in[3]; X.w_in = (const float*)args.in[4];
    X.q_norm_g = (const float*)args.in[5]; X.w_uq = (const float*)args.in[6]; X.kv_norm_g = (const float*)args.in[7]; X.w_uk = (const float*)args.in[8]; X.w_uv = (const float*)args.in[9];
    X.rel_bias = (const float*)args.in[10]; X.w_up_a = (const float*)args.in[11]; X.w_up_b = (const float*)args.in[12]; X.w_gate = (const float*)args.in[13]; X.b_gate = (const float*)args.in[14];
    X.w_o = (const float*)args.in[15]; X.ln1_g = (const float*)args.in[16]; X.ln1_b = (const float*)args.in[17]; X.w_grp = (const float*)args.in[18]; X.b_grp = (const float*)args.in[19];
    X.w_rt = (const float*)args.in[20]; X.b_rt = (const float*)args.in[21]; X.w_eg = (const float*)args.in[22]; X.w_eu = (const float*)args.in[23]; X.w_ed = (const float*)args.in[24];
    X.ln2_g = (const float*)args.in[25]; X.ln2_b = (const float*)args.in[26];
    X.out = args.out; X.ws = args.ws; X.lds = (LAS unsigned char*)lds_raw; X.G = gridDim.x; X.bid = blockIdx.x; X.wid = __builtin_amdgcn_readfirstlane((int)(threadIdx.x >> 6));
    if (threadIdx.x < 16) ((LAS unsigned*)(X.lds + LDS_MISC))[threadIdx.x] = 0u;
    __syncthreads();
    const int lo = args.ph_lo, hi = args.ph_hi;
    XcdBarrier bar; bar.bar = wsp<unsigned>(X, WS_CTL) + CW_BAR; bar.x = 0; bar.st = nullptr;
    if (hi - lo > 1) bar = xcd_barrier_post(wsp<unsigned>(X, WS_CTL) + CW_BAR, (volatile LAS unsigned*)(X.lds + LDS_MISC));
#define IN(k) (((PHM >> (k)) & 1) && lo <= (k) && (k) < hi)
#define SEAM(k) do { if (IN(k) && IN((k) + 1)) xcd_barrier(bar); } while (0)

    if (IN(0)) { p0_prologue(X); }
    SEAM(0);
#if DBG_STAGE >= 2
    if (IN(1)) {
        pg8::Gemm g{wsp<bf16_t>(X, WS_B), wsp<bf16_t>(X, WS_WT1), 1024}; pg8::StaticOrder S; S.init(M, NW1, X.G, X.bid);
        Epi1 E{wsp<bf16_t>(X, WS_CQ), wsp<bf16_t>(X, WS_CKV), wsp<bf16_t>(X, WS_KR), wsp<bf16_t>(X, WS_KI), wsp<bf16_t>(X, WS_KB), wsp<bf16_t>(X, WS_VB), wsp<bf16_t>(X, WS_QB), wsp<bf16_t>(X, WS_QI),
               wsp<bf16_t>(X, WS_A), wsp<float>(X, WS_WI), wsp<float>(X, WS_SSQ), wsp<float>(X, WS_ROPE), X.b_gate};
        pg8::gemm_phase<Epi1, pg8::StaticOrder, true, false>(X.lds, g, S, E, X.wid);
    }
    SEAM(1);
    if (IN(2)) {
        { pg8::Gemm g{wsp<bf16_t>(X, WS_CKV), wsp<bf16_t>(X, WS_WUKVT), 128}; pg8::StaticOrder S; S.init(M, 1024, X.G, X.bid);
          Epi3 E{wsp<bf16_t>(X, WS_KN), wsp<bf16_t>(X, WS_VM), wsp<float>(X, WS_SSQ)};
          pg8::gemm_phase<Epi3, pg8::StaticOrder, true, false>(X.lds, g, S, E, X.wid); }
        { pg8::Gemm g{wsp<bf16_t>(X, WS_CQ), wsp<bf16_t>(X, WS_WUQT), 256}; pg8::StaticOrder S; S.init(M, 768, X.G, X.bid);
          Epi2 E{wsp<bf16_t>(X, WS_QM), wsp<float>(X, WS_SSQ), wsp<float>(X, WS_ROPE)};
          pg8::gemm_phase<Epi2, pg8::StaticOrder, true, false>(X.lds, g, S, E, X.wid); }
    }
    SEAM(2);
    if (IN(3)) {
        for (int i = 0;; ++i) { const long L = (long)i * X.G + X.bid; if (L >= 1024) break; const int c = (int)(L & 255), ii = (int)(L >> 8);
            const int bh = c >> 1; const int tab[2][4] = {{7, 0, 5, 2}, {6, 1, 4, 3}}; int qb = tab[0][0];
#pragma unroll
            for (int a = 0; a < 2; ++a)
#pragma unroll
                for (int t = 0; t < 4; ++t) if (a == (c & 1) && t == ii) qb = tab[a][t];
#ifndef NO_MLA
            mla_unit(X, bh >> 3, bh & 7, qb);
#endif
#ifdef REP_MLA
            mla_unit(X, bh >> 3, bh & 7, qb);
#endif
        }
        for (int i = 0;; ++i) { const long L = (long)i * X.G + X.bid; if (L >= 1024) break; const int c = (int)(L & 255), ii = (int)(L >> 8);
            const int b = c >> 4, idx = c & 15; const int qt = ii == 0 ? 63 - idx : (ii == 1 ? idx : (ii == 2 ? 47 - idx : 16 + idx));
#ifdef REP_DSA_SEL
            dsa_unit<false>(X, b, qt);
#endif
#ifndef NO_DSA
            dsa_unit<true>(X, b, qt);
#endif
#ifdef REP_DSA
            dsa_unit<true>(X, b, qt);
#endif
        }
    }
    SEAM(3);
    if (IN(4)) {
        pg8::Gemm g{wsp<bf16_t>(X, WS_B), wsp<bf16_t>(X, WS_WUPT), 1024}; pg8::StaticOrder S; S.init(M, 1024, X.G, X.bid);
        Epi4 E{wsp<bf16_t>(X, WS_MIXPRE), wsp<bf16_t>(X, WS_A)};
        pg8::gemm_phase<Epi4, pg8::StaticOrder, true, false>(X.lds, g, S, E, X.wid);
    }
    SEAM(4);
    if (IN(5)) {
        pg8::Gemm g{wsp<bf16_t>(X, WS_MIXPRE), wsp<bf16_t>(X, WS_WOT), 1024}; pg8::StaticOrder S; S.init(M, 1024, X.G, X.bid);
        Epi5 E{wsp<float>(X, WS_A), X.x, wsp<float>(X, WS_STATS0), X.ln0_g, X.ln0_b};
        pg8::gemm_phase<Epi5, pg8::StaticOrder, true, false>(X.lds, g, S, E, X.wid);
    }
    SEAM(5);
#endif
    if (IN(6)) { p6_ln1_router(X); }
    SEAM(6);
    if (IN(7)) {
        moe_prep(X);
        const LAS int* tstart = (const LAS int*)(X.lds + LDS_MISC + 64); const LAS int* scnt = (const LAS int*)(X.lds + LDS_MISC + 512);
        pg8::Gemm g{wsp<bf16_t>(X, WS_B), wsp<bf16_t>(X, WS_WEGUT), 1024}; MoeOrder S{tstart, scnt, wsp<int>(X, WS_LIST), 2048, 2, X.G, X.bid, __builtin_amdgcn_readfirstlane(tstart[NSEG])};
        Epi7 E{wsp<bf16_t>(X, WS_HID), wsp<float>(X, WS_LISTW), scnt};
        pg8::gemm_phase<Epi7, MoeOrder, true, true>(X.lds, g, S, E, X.wid);
    }
    SEAM(7);
    if (IN(8)) {
        moe_prep(X);
        const LAS int* tstart = (const LAS int*)(X.lds + LDS_MISC + 64); const LAS int* scnt = (const LAS int*)(X.lds + LDS_MISC + 512);
        pg8::Gemm g{wsp<bf16_t>(X, WS_HID), wsp<bf16_t>(X, WS_WEDT), 256}; MoeOrder S{tstart, scnt, wsp<int>(X, WS_LIST), 0, 4, X.G, X.bid, __builtin_amdgcn_readfirstlane(tstart[NSEG])};
        Epi8 E{wsp<bf16_t>(X, WS_C), wsp<int>(X, WS_LIST), scnt};
        pg8::gemm_phase<Epi8, MoeOrder, true, false>(X.lds, g, S, E, X.wid);
    }
    SEAM(8);
    if (IN(9)) { p9_ln2(X); }
#undef IN
#undef SEAM
}

#ifndef PH_MASK
#define PH_MASK 0x3ff
#endif
template <int PHM> static bool setup_kernel(int& per_cu) {
    if (hipFuncSetAttribute((const void*)fwd_kernel<PHM>, hipFuncAttributeMaxDynamicSharedMemorySize, LDS_BYTES) != hipSuccess) return false;
    if (hipOccupancyMaxActiveBlocksPerMultiprocessor(&per_cu, (const void*)fwd_kernel<PHM>, 512, LDS_BYTES) != hipSuccess) per_cu = 0;
    (void)hipGetLastError(); return true;
}
template <int P> static void launch_phase(int grid, hipStream_t stream, Args a) {
    if (!((PH_MASK >> P) & 1)) return;
    a.ph_lo = P; a.ph_hi = P + 1;
    hipLaunchKernelGGL(fwd_kernel<(1 << P)>, dim3(grid), dim3(512), LDS_BYTES, stream, a);
#ifdef REP_MASK
    if ((REP_MASK >> P) & 1) hipLaunchKernelGGL(fwd_kernel<(1 << P)>, dim3(grid), dim3(512), LDS_BYTES, stream, a);
#endif
}
extern "C" void kernel_launch(void* const* d_in, const int* in_sizes, int n_in, void* d_out, int out_size, void* d_ws, size_t ws_size, hipStream_t stream) {
    static int grid = 0;
    if (grid == 0) {
        if (n_in != 27 || in_sizes[0] != M * D || out_size != M * D || ws_size < WS_END) { fprintf(stderr, "kernel_launch: unexpected shapes (n_in %d, ws %zu); nothing launched\n", n_in, ws_size); grid = -1; return; }
        int dev = 0, cus = 0, per_cu = 0; bool ok = true;
        if (hipGetDevice(&dev) != hipSuccess || hipDeviceGetAttribute(&cus, hipDeviceAttributeMultiprocessorCount, dev) != hipSuccess) { grid = -1; return; }
#if N_LAUNCH_MODE == 1
        ok = setup_kernel<PH_MASK>(per_cu);
#else
        ok = setup_kernel<1>(per_cu) && setup_kernel<2>(per_cu) && setup_kernel<4>(per_cu) && setup_kernel<8>(per_cu) && setup_kernel<16>(per_cu) && setup_kernel<32>(per_cu) &&
             setup_kernel<64>(per_cu) && setup_kernel<128>(per_cu) && setup_kernel<256>(per_cu) && setup_kernel<512>(per_cu);
#endif
        if (!ok) { fprintf(stderr, "kernel_launch: hipFuncSetAttribute failed\n"); grid = -1; return; }
        if (per_cu < 1) fprintf(stderr, "kernel_launch: occupancy query says %d\n", per_cu);
        grid = cus;
    }
    if (grid < 0) return;
    if (hipMemsetAsync((char*)d_ws + WS_CTL, 0, CTL_ZERO_BYTES, stream) != hipSuccess) return;
    Args a{};
    for (int i = 0; i < 27; ++i) a.in[i] = d_in[i];
    a.out = (float*)d_out; a.ws = (unsigned char*)d_ws;
#if N_LAUNCH_MODE == 1
    a.ph_lo = 0; a.ph_hi = N_PHASES;
    hipLaunchKernelGGL(fwd_kernel<PH_MASK>, dim3(grid), dim3(512), LDS_BYTES, stream, a);
#else
    launch_phase<0>(grid, stream, a);
#if DBG_STAGE >= 2
    launch_phase<1>(grid, stream, a); launch_phase<2>(grid, stream, a); launch_phase<3>(grid, stream, a); launch_phase<4>(grid, stream, a); launch_phase<5>(grid, stream, a);
#endif
    launch_phase<6>(grid, stream, a); launch_phase<7>(grid, stream, a); launch_phase<8>(grid, stream, a); launch_phase<9>(grid, stream, a);
#endif
}
```

```cpp
#include <hip/hip_runtime.h>
#include <cstdio>
#include <cstdint>

#ifndef N_LAUNCH_MODE
#define N_LAUNCH_MODE 1
#endif

#define LAS __attribute__((address_space(3)))
#define GAS __attribute__((address_space(1)))
typedef unsigned short bf16_t;
typedef short bf16x8 __attribute__((ext_vector_type(8)));
typedef short s16x4 __attribute__((ext_vector_type(4)));
typedef float f32x2 __attribute__((ext_vector_type(2)));
typedef float f32x4 __attribute__((ext_vector_type(4)));
typedef float f32x16 __attribute__((ext_vector_type(16)));
typedef unsigned u32x2 __attribute__((ext_vector_type(2)));
typedef unsigned u32x4 __attribute__((ext_vector_type(4)));
typedef int i32x4 __attribute__((ext_vector_type(4)));
typedef __bf16 bf16x2_t __attribute__((ext_vector_type(2)));
#define DI __device__ __forceinline__

constexpr int BATCH = 16, SEQ = 2048, D = 1024, M = BATCH * SEQ;
constexpr int NW1 = 3584;
constexpr int NSEG = 64;
constexpr int MAXTILES = 320;
constexpr float LN_EPS = 1e-5f, RMS_EPS = 1e-6f;
constexpr float ALPHA = 1.189207115002721f;
constexpr float LOG2E = 1.4426950408889634f;
constexpr float NEGF = -1e30f;

constexpr size_t MiB = 1u << 20;
constexpr size_t WS_CTL = 0, CTL_ZERO_BYTES = 1 * MiB;
constexpr size_t WS_WT1 = 1 * MiB;
constexpr size_t WS_WUQT = 8 * MiB;
constexpr size_t WS_WUKVT = WS_WUQT + 768 * 256 * 2;
constexpr size_t WS_WRT = WS_WUKVT + 1024 * 128 * 2;
constexpr size_t WS_WUPT = 9 * MiB;
constexpr size_t WS_WOT = 11 * MiB;
constexpr size_t WS_WEGUT = 13 * MiB;
constexpr size_t WS_WEDT = 45 * MiB;
constexpr size_t WS_STATS0 = 61 * MiB;
constexpr size_t WS_SSQ = WS_STATS0 + (size_t)M * 8;
constexpr size_t WS_TSTAT = WS_SSQ + (size_t)M * 32;
constexpr size_t WS_STATS1 = WS_TSTAT + 8192;
constexpr size_t WS_A = 64 * MiB;
constexpr size_t WS_B = 192 * MiB;
constexpr size_t WS_C = 256 * MiB;
constexpr size_t WS_Dr = 384 * MiB;
constexpr size_t WS_END = 512 * MiB;
constexpr size_t WS_QB = WS_C, WS_QI = WS_QB + 32 * MiB, WS_CQ = WS_QI + 16 * MiB, WS_CKV = WS_CQ + 16 * MiB, WS_KB = WS_CKV + 8 * MiB, WS_VB = WS_KB + 4 * MiB,
                 WS_KR = WS_VB + 4 * MiB, WS_KI = WS_KR + 2 * MiB, WS_WI = WS_KI + 2 * MiB;
constexpr size_t WS_QM = WS_Dr, WS_KN = WS_QM + 48 * MiB, WS_VM = WS_KN + 32 * MiB;
constexpr size_t WS_MIXPRE = WS_Dr;
constexpr size_t WS_HID = WS_Dr + 64 * MiB;
constexpr size_t WS_LIST = WS_Dr + 104 * MiB;
constexpr size_t WS_LISTW = WS_Dr + 112 * MiB;
constexpr size_t WS_ROPE = WS_Dr + 120 * MiB;
constexpr int CW_BAR = 4096;
constexpr int CW_CNT = 16384;

DI unsigned pk2(float lo, float hi) { f32x2 v = {lo, hi}; bf16x2_t r = __builtin_convertvector(v, bf16x2_t); return __builtin_bit_cast(unsigned, r); }
DI float bf2f(unsigned short b) { return __uint_as_float((unsigned)b << 16); }
DI float wave_sum(float v) {
#pragma unroll
    for (int o = 1; o < 64; o <<= 1) v += __shfl_xor(v, o);
    return v;
}
DI int wave_min_i(int v) {
#pragma unroll
    for (int o = 1; o < 64; o <<= 1) { const int t = __shfl_xor(v, o); v = t < v ? t : v; }
    return v;
}
DI int wave_max_i(int v) {
#pragma unroll
    for (int o = 1; o < 64; o <<= 1) { const int t = __shfl_xor(v, o); v = t > v ? t : v; }
    return v;
}
DI int lane_id() { int l; asm volatile("v_mbcnt_lo_u32_b32 %0, -1, 0\n\tv_mbcnt_hi_u32_b32 %0, -1, %0" : "=v"(l)); return l; }
DI float fast_exp2(float x) { return __builtin_amdgcn_exp2f(x); }
DI float fast_rcp(float x) { return __builtin_amdgcn_rcpf(x); }
DI float sigmoidf_fast(float v) { return fast_rcp(1.0f + fast_exp2(-v * LOG2E)); }
DI void rope_sincos(int pos, int j, float& sn, float& cs) {
    const double invd[16] = {1.0, 0.5623413251903491, 0.31622776601683794, 0.1778279410038923, 0.1, 0.05623413251903491, 0.03162277660168379, 0.01778279410038923,
                             0.01, 0.005623413251903491, 0.0031622776601683794, 0.001778279410038923, 0.001, 0.0005623413251903491, 0.00031622776601683794, 0.0001778279410038923};
    double inv = invd[0];
#pragma unroll
    for (int t = 1; t < 16; ++t) inv = (j == t) ? invd[t] : inv;
    const double rev = (double)pos * (double)(float)inv * 0.15915494309189535;
    const float fr = (float)(rev - __builtin_floor(rev));
    sn = __builtin_amdgcn_sinf(fr); cs = __builtin_amdgcn_cosf(fr);
}

#define XB_TMO      128
#define XB_XCNT(j)  (256  + 64 * (j))
#define XB_XSUB(j)  (1280 + 64 * (j))
#define XB_XGEN(j)  (2304 + 64 * (j))
#define XB_TOP      3328
#define XB_TOPGEN   3392
#define XCD_BAR_WORDS 3456
#define XB_SPIN_CAP (1u << 18)
DI unsigned xb_ld(unsigned* p)              { return __hip_atomic_load(p, __ATOMIC_RELAXED, __HIP_MEMORY_SCOPE_AGENT); }
DI unsigned xb_add(unsigned* p, unsigned v) { return __hip_atomic_fetch_add(p, v, __ATOMIC_RELAXED, __HIP_MEMORY_SCOPE_AGENT); }
DI unsigned xb_xcc_id() { return (unsigned)__builtin_amdgcn_s_getreg((3 << 11) | 20) & 0xFu; }
#define XB_SPIN(cond, bar) do { unsigned _sp = 0; while (cond) { __builtin_amdgcn_s_sleep(1); \
    if ((++_sp & 255u) == 0u) { if (xb_ld(&(bar)[XB_TMO])) break; if (_sp > XB_SPIN_CAP) { atomicAdd(&(bar)[XB_TMO], 1u); break; } } } } while (0)
struct XcdBarrier { unsigned* bar; unsigned x; volatile LAS unsigned* st; };
DI XcdBarrier xcd_barrier_post(unsigned* bar, volatile LAS unsigned* st) {
    XcdBarrier b; b.bar = bar; b.x = xb_xcc_id(); b.st = st;
    if (threadIdx.x == 0) (void)xb_add(&bar[XB_XCNT(b.x)], 1u);
    return b;
}
DI void xcd_barrier_complete(unsigned* bar, unsigned x, unsigned& nloc, unsigned& nx) {
    const unsigned G = gridDim.x * gridDim.y * gridDim.z;
    unsigned sum, cnt, mine, sp = 0u;
    for (;;) {
        sum = 0u; cnt = 0u; mine = 0u;
#pragma unroll
        for (unsigned j = 0; j < 16; ++j) { const unsigned c = xb_ld(&bar[XB_XCNT(j)]); sum += c; cnt += (c > 0u) ? 1u : 0u; mine = (j == x) ? c : mine; }
        if (sum == G) break;
        __builtin_amdgcn_s_sleep(1);
        if ((++sp & 255u) == 0u) { if (xb_ld(&bar[XB_TMO])) break; if (sp > XB_SPIN_CAP) { atomicAdd(&bar[XB_TMO], 1u); break; } }
    }
    nloc = mine > 0u ? mine : 1u; nx = cnt > 0u ? cnt : 1u;
}
DI void xcd_barrier(const XcdBarrier& b) {
    asm volatile("s_waitcnt vmcnt(0)" ::: "memory");
    __syncthreads();
    if (threadIdx.x == 0) {
        unsigned* bar = b.bar;
        __builtin_amdgcn_s_waitcnt(0);
        unsigned nloc = b.st[0], nx = b.st[1];
        if (nloc == 0u) { xcd_barrier_complete(bar, b.x, nloc, nx); b.st[0] = nloc; b.st[1] = nx; }
        const unsigned old = xb_add(&bar[XB_XSUB(b.x)], 1u);
        const unsigned gen = old / nloc;
        if (old + 1u == (gen + 1u) * nloc) {
            __builtin_amdgcn_fence(__ATOMIC_RELEASE, "agent");
            asm volatile("s_waitcnt vmcnt(0)" ::: "memory");
            const unsigned og = xb_add(&bar[XB_TOP], 1u);
            const unsigned tg = og / nx;
            if (og + 1u == (tg + 1u) * nx) xb_add(&bar[XB_TOPGEN], 1u);
            else XB_SPIN(xb_ld(&bar[XB_TOPGEN]) == tg, bar);
            __builtin_amdgcn_fence(__ATOMIC_ACQUIRE, "agent");
            xb_add(&bar[XB_XGEN(b.x)], 1u);
            asm volatile("s_waitcnt vmcnt(0)" ::: "memory");
        } else {
            XB_SPIN(xb_ld(&bar[XB_XGEN(b.x)]) == gen, bar);
            __builtin_amdgcn_fence(__ATOMIC_ACQUIRE, "agent");
            asm volatile("s_waitcnt vmcnt(0)" ::: "memory");
        }
    }
    __syncthreads();
}

namespace pg8 {
constexpr int BM = 256, BK = 64, HALF = 128, HTB = HALF * BK * 2, STAGE_BYTES = 8 * HTB, NXCD = 8, WGM = 8;
__host__ __device__ __forceinline__ int lds_byte(int r, int c) { const int st = (r >> 4) * 2 + (c >> 5), rr = r & 15, cc = c & 31, ob = rr * 64 + cc * 2; return st * 1024 + (ob ^ (((ob >> 9) & 1) << 5)); }
__host__ __device__ __forceinline__ void stage_rc(int b, int& R, int& C) { const int st = b / 1024, sb = b % 1024, swz = sb ^ (((sb >> 9) & 1) << 5); R = (st >> 1) * 16 + swz / 64; C = (st & 1) * 32 + (swz % 64) / 2; }
__host__ __device__ __forceinline__ int perm32(int rho) { const int n = rho >> 4, i = rho & 15; return 8 * (i >> 2) + 4 * n + (i & 3); }
struct Unit { int pm, pn, a0, a1; };
struct Gemm { const bf16_t* A; const bf16_t* Bt; int K; };

DI void tile_of(int L, int nM, int nN, int& pm, int& pn) {
    const int nwg = nM * nN; int wgid = L;
    { const int q = nwg / NXCD, r = nwg % NXCD, xcd = wgid % NXCD, off = wgid / NXCD; wgid = (xcd < r ? xcd * (q + 1) : r * (q + 1) + (xcd - r) * q) + off; }
    const int nig = WGM * nN, gid = wgid / nig, fm = gid * WGM, gsz = (nM - fm) < WGM ? (nM - fm) : WGM;
    pm = fm + ((wgid % nig) % gsz); pn = (wgid % nig) / gsz;
}
struct StaticOrder {
    int nM, nN, nwg, G, c;
    DI void init(int Mrows, int N, int G_, int c_) { nM = Mrows / BM; nN = N / BM; nwg = nM * nN; G = G_; c = c_; }
    DI bool next(int i, Unit& u) const {
        const long L = (long)i * G + c; if (L >= nwg) return false;
        tile_of((int)L, nM, nN, u.pm, u.pn); u.a0 = 0; u.a1 = 0; return true;
    }
    DI unsigned arow(const Unit&, int) const { return 0u; }
};

template <class Epi, class Sched, bool ALIGN_EPI, bool GATHER>
DI void gemm_phase(LAS unsigned char* lds, const Gemm g, const Sched& S, const Epi& E, int wid) {
    const int lane = lane_id(), tid = wid * 64 + lane, wr = wid >> 2, wc = wid & 3, fr = lane & 15, fq = lane >> 4;
    int K = g.K; asm volatile("" : "+s"(K));
    const int nt = K / BK;
    unsigned voffA[2], voffB[2]; int RA[2];
#pragma unroll
    for (int i = 0; i < 2; ++i) { int R, C; stage_rc(tid * 16 + i * 8192, R, C); const int Rb = Epi::PERM ? ((R & ~31) + perm32(R & 31)) : R;
        voffA[i] = GATHER ? (unsigned)(C * 2) : (unsigned)(R * K + C) * 2u; voffB[i] = (unsigned)(Rb * K + C) * 2u; RA[i] = R; }
    const size_t kstep = (size_t)(BK * 2);
    const size_t hstep = (size_t)HALF * K * 2;
    const size_t tstep = 2 * hstep;
    const unsigned ldsw = (unsigned)wid * 1024u;
    const int aoff = lds_byte(wr * 64 + fr, fq * 8), boff = lds_byte(wc * 32 + fr, fq * 8);
#define PG8_SA(b, h) (((b) * 2 + (h)) * HTB)
#define PG8_SB(b, h) ((4 + (b) * 2 + (h)) * HTB)
#define PG8_STAGE(bufoff, gbase, voff) do { _Pragma("unroll") for (int _i = 0; _i < 2; ++_i) \
        __builtin_amdgcn_global_load_lds((const unsigned*)((const char*)(gbase) + (voff)[_i]), (LAS unsigned*)(lds + (bufoff) + ldsw + _i * 8192), 16, 0, 0); } while (0)
#define PG8_STAGE_A(bufoff, plainptr, hh, kptr, go) do { if constexpr (GATHER) { _Pragma("unroll") for (int _i = 0; _i < 2; ++_i) \
        __builtin_amdgcn_global_load_lds((const unsigned*)((kptr) + (go)[hh][_i]), (LAS unsigned*)(lds + (bufoff) + ldsw + _i * 8192), 16, 0, 0); } \
        else { PG8_STAGE(bufoff, (plainptr) + (hh) * hstep, voffA); } } while (0)
#define PG8_LDA(dst, b, h) do { _Pragma("unroll") for (int m = 0; m < 4; ++m) _Pragma("unroll") for (int k = 0; k < 2; ++k) dst[m][k] = *(const LAS bf16x8*)(lds + PG8_SA(b, h) + aoff + m * 2048 + k * 1024); } while (0)
#define PG8_LDB(dst, b, h) do { _Pragma("unroll") for (int n = 0; n < 2; ++n) _Pragma("unroll") for (int k = 0; k < 2; ++k) dst[n][k] = *(const LAS bf16x8*)(lds + PG8_SB(b, h) + boff + n * 2048 + k * 1024); } while (0)
#define PG8_MMA(ai, bj, At, Bt) do { __builtin_amdgcn_s_setprio(1); _Pragma("unroll") for (int m = 0; m < 4; ++m) _Pragma("unroll") for (int n = 0; n < 2; ++n) _Pragma("unroll") for (int k = 0; k < 2; ++k) \
        acc[ai][bj][m][n] = __builtin_amdgcn_mfma_f32_16x16x32_bf16(Bt[n][k], At[m][k], acc[ai][bj][m][n], 0, 0, 0); __builtin_amdgcn_s_setprio(0); } while (0)
#define PG8_WAIT_V(n) asm volatile("s_waitcnt vmcnt(" #n ")" ::: "memory")
#define PG8_WAIT_L(n) asm volatile("s_waitcnt lgkmcnt(" #n ")" ::: "memory")
#define PG8_BAR __builtin_amdgcn_s_barrier()
#define PG8_SCHED __builtin_amdgcn_sched_barrier(0)
    Unit cur, nxt; int ui = 0;
    if (!S.next(0, cur)) return;
    f32x4 acc[2][2][4][2];
#pragma unroll
    for (int a = 0; a < 2; ++a)
#pragma unroll
        for (int b = 0; b < 2; ++b)
#pragma unroll
            for (int m = 0; m < 4; ++m)
#pragma unroll
                for (int n = 0; n < 2; ++n) acc[a][b][m][n] = (f32x4){0.f, 0.f, 0.f, 0.f};
    bf16x8 At[4][2], B0[2][2], B1[2][2];
    const char* A0 = (const char*)g.A;
    const char* cA = A0 + (GATHER ? (size_t)0 : (size_t)cur.pm * tstep); const char* cB = (const char*)g.Bt + (size_t)cur.pn * tstep;
    unsigned gc[2][2], gn[2][2];
#pragma unroll
    for (int hh = 0; hh < 2; ++hh)
#pragma unroll
        for (int i = 0; i < 2; ++i) { gc[hh][i] = GATHER ? S.arow(cur, hh * HALF + RA[i]) + voffA[i] : 0u; gn[hh][i] = gc[hh][i]; }
    PG8_STAGE(PG8_SB(0, 0), cB, voffB); PG8_STAGE(PG8_SB(0, 1), cB + hstep, voffB); PG8_STAGE_A(PG8_SA(0, 0), cA, 0, A0, gc); PG8_STAGE_A(PG8_SA(0, 1), cA, 1, A0, gc);
    if (wr == 1) PG8_BAR;
    PG8_WAIT_V(2); PG8_BAR;
    PG8_STAGE(PG8_SB(1, 0), cB + kstep, voffB); PG8_STAGE_A(PG8_SA(1, 0), cA + kstep, 0, A0 + kstep, gc); PG8_STAGE(PG8_SB(1, 1), cB + hstep + kstep, voffB);
    PG8_WAIT_V(6); PG8_BAR;
    for (;;) {
        const bool has_next = S.next(ui + 1, nxt);
        const char* nA = has_next ? A0 + (GATHER ? (size_t)0 : (size_t)nxt.pm * tstep) : cA; const char* nB = has_next ? (const char*)g.Bt + (size_t)nxt.pn * tstep : cB;
        if constexpr (GATHER) {
#pragma unroll
            for (int hh = 0; hh < 2; ++hh)
#pragma unroll
                for (int i = 0; i < 2; ++i) gn[hh][i] = has_next ? S.arow(nxt, hh * HALF + RA[i]) + voffA[i] : gc[hh][i];
        }
        for (int t = 0; t < nt; t += 2) {
            if constexpr (Epi::MID) { if (t == (nt >> 1)) { const int l2 = lane_id(); E.mid(acc, cur, wr, wc, l2 & 15, l2 >> 4); } }
            const bool last = (t == nt - 2);
            const char* a1 = cA + (size_t)(t + 1) * kstep;
            const char* a2 = last ? nA : cA + (size_t)(t + 2) * kstep; const char* b2 = last ? nB : cB + (size_t)(t + 2) * kstep;
            const char* a3 = a2 + kstep; const char* b3 = b2 + kstep;
            const char* k1 = A0 + (size_t)(t + 1) * kstep; const char* k2 = A0 + (last ? (size_t)0 : (size_t)(t + 2) * kstep); const char* k3 = k2 + kstep;
            unsigned g2[2][2];
#pragma unroll
            for (int hh = 0; hh < 2; ++hh)
#pragma unroll
                for (int i = 0; i < 2; ++i) g2[hh][i] = last ? gn[hh][i] : gc[hh][i];
            PG8_LDB(B0, 0, 0); PG8_LDB(B1, 0, 1); PG8_SCHED; PG8_LDA(At, 0, 0); PG8_STAGE_A(PG8_SA(1, 1), a1, 1, k1, gc);
            PG8_WAIT_V(8); PG8_WAIT_L(0); PG8_BAR; PG8_MMA(0, 0, At, B0); PG8_MMA(0, 1, At, B1); PG8_BAR; PG8_SCHED;
            PG8_LDA(At, 0, 1); PG8_STAGE(PG8_SB(0, 0), b2, voffB); PG8_STAGE(PG8_SB(0, 1), b2 + hstep, voffB); PG8_STAGE_A(PG8_SA(0, 0), a2, 0, k2, g2);
            PG8_WAIT_V(8); PG8_WAIT_L(0); PG8_BAR; PG8_MMA(1, 0, At, B0); PG8_MMA(1, 1, At, B1); PG8_BAR; PG8_SCHED;
            PG8_LDB(B0, 1, 0); PG8_LDB(B1, 1, 1); PG8_SCHED; PG8_LDA(At, 1, 0); PG8_STAGE_A(PG8_SA(0, 1), a2, 1, k2, g2);
            PG8_WAIT_V(8); PG8_WAIT_L(0); PG8_BAR; PG8_MMA(0, 0, At, B0); PG8_MMA(0, 1, At, B1); PG8_BAR; PG8_SCHED;
            PG8_LDA(At, 1, 1); PG8_STAGE(PG8_SB(1, 0), b3, voffB); PG8_STAGE(PG8_SB(1, 1), b3 + hstep, voffB); PG8_STAGE_A(PG8_SA(1, 0), a3, 0, k3, g2);
            PG8_WAIT_V(8); PG8_WAIT_L(0); PG8_BAR; PG8_MMA(1, 0, At, B0); PG8_MMA(1, 1, At, B1); PG8_BAR; PG8_SCHED;
        }
        if constexpr (ALIGN_EPI) { if (wr == 0) PG8_BAR; }
        { const int l2 = lane_id(); E(acc, cur, wr, wc, l2 & 15, l2 >> 4); }
        if (!has_next) break;
#pragma unroll
        for (int a = 0; a < 2; ++a)
#pragma unroll
            for (int b = 0; b < 2; ++b)
#pragma unroll
                for (int m = 0; m < 4; ++m)
#pragma unroll
                    for (int n = 0; n < 2; ++n) acc[a][b][m][n] = (f32x4){0.f, 0.f, 0.f, 0.f};
        cur = nxt; cA = nA; cB = nB; ++ui;
#pragma unroll
        for (int hh = 0; hh < 2; ++hh)
#pragma unroll
            for (int i = 0; i < 2; ++i) gc[hh][i] = gn[hh][i];
        if constexpr (ALIGN_EPI) { if (wr == 1) PG8_BAR; }
    }
    PG8_WAIT_V(0);
    if constexpr (!ALIGN_EPI) { if (wr == 0) PG8_BAR; }
    PG8_BAR;
#undef PG8_SA
#undef PG8_SB
#undef PG8_STAGE
#undef PG8_STAGE_A
#undef PG8_LDA
#undef PG8_LDB
#undef PG8_MMA
#undef PG8_WAIT_V
#undef PG8_WAIT_L
#undef PG8_BAR
#undef PG8_SCHED
}
}
using pg8::Unit;

struct Args { const void* in[27]; float* out; unsigned char* ws; int ph_lo, ph_hi; };
struct Ctx {
    const float *x, *ln0_g, *ln0_b, *w_in, *q_norm_g, *w_uq, *kv_norm_g, *w_uk, *w_uv, *rel_bias, *w_up_a, *w_up_b, *w_gate, *b_gate, *w_o, *ln1_g, *ln1_b,
                *w_grp, *b_grp, *w_rt, *b_rt, *w_eg, *w_eu, *w_ed, *ln2_g, *ln2_b;
    const int* pos;
    float* out; unsigned char* ws;
    LAS unsigned char* lds;
    int G, bid, wid;
};
constexpr int LDS_RING = 131072;
constexpr int LDS_MISC = LDS_RING;
constexpr int LDS_LG = LDS_RING + 4096;
constexpr int LDS_RT = LDS_LG + 8192;
constexpr int LDS_BYTES = LDS_RING + 4096 + 8192 + 5120;
template <class T> DI T* wsp(const Ctx& X, size_t off) { return (T*)(X.ws + off); }

DI void tr_item(const float* W, int ld, int K, int ncols, bf16_t* WT, const float* scale, LAS float* scr, int item, int lane, int ldd = 0) {
    if (ldd == 0) ldd = K;
    const int nblk = (ncols + 31) >> 5, kb = item / nblk, nb = item - kb * nblk, k0 = 64 * kb, n0 = 32 * nb;
    const int n4 = 4 * (lane & 7), kr = lane >> 3;
    f32x4 v[8];
#pragma unroll
    for (int i = 0; i < 8; ++i) { const int kk = 8 * i + kr; v[i] = (n0 + n4 + 3 < ncols) ? *(const f32x4*)(W + (size_t)(k0 + kk) * ld + n0 + n4) : (f32x4){0.f, 0.f, 0.f, 0.f}; }
#pragma unroll
    for (int i = 0; i < 8; ++i) { const int kk = 8 * i + kr; f32x4 t = v[i]; if (scale) t = t * scale[k0 + kk];
        scr[kk * 33 + n4] = t[0]; scr[kk * 33 + n4 + 1] = t[1]; scr[kk * 33 + n4 + 2] = t[2]; scr[kk * 33 + n4 + 3] = t[3]; }
    asm volatile("s_waitcnt lgkmcnt(0)" ::: "memory");
    const int c = lane & 7;
#pragma unroll
    for (int j = 0; j < 4; ++j) { const int n = (lane >> 3) + 8 * j; const LAS float* s = scr + (8 * c) * 33 + n;
        u32x4 o; o.x = pk2(s[0 * 33], s[1 * 33]); o.y = pk2(s[2 * 33], s[3 * 33]); o.z = pk2(s[4 * 33], s[5 * 33]); o.w = pk2(s[6 * 33], s[7 * 33]);
        if (n0 + n < ncols) *(u32x4*)(WT + (size_t)(n0 + n) * ldd + k0 + 8 * c) = o; }
    asm volatile("s_waitcnt lgkmcnt(0)" ::: "memory");
}
constexpr int tr_items(int K, int ncols) { return (K / 64) * ((ncols + 31) / 32); }

DI void p0_prologue(const Ctx& X) {
    const int lane = lane_id(), wave = X.wid, tid = wave * 64 + lane;
    LAS float* scr = (LAS float*)(X.lds + wave * 16384);
    const int gw = X.bid * 8 + wave, NGW = X.G * 8;
    bf16_t* WT1 = wsp<bf16_t>(X, WS_WT1);
    {
        constexpr int seg_c0[9] = {0, 256, 384, 1312, 928, 416, 1056, 992, 1344};
        constexpr int seg_nc[9] = {256, 128, 32, 32, 64, 512, 256, 64, 8};
        constexpr int seg_d0[9] = {0, 256, 384, 416, 448, 512, 1024, 1280, 1344};
        constexpr int N_GU = 128 * tr_items(1024, 128), N_DN = 32 * tr_items(256, 1024);
        constexpr int N_IN = tr_items(1024, 256) + tr_items(1024, 128) + tr_items(1024, 32) * 2 + tr_items(1024, 64) * 2 + tr_items(1024, 512) + tr_items(1024, 256) + tr_items(1024, 8);
        constexpr int N_NAMED = N_IN + tr_items(1024, 2048) + tr_items(256, 768) + 2 * tr_items(128, 512) + 2 * tr_items(512, 1024) + tr_items(1024, 1024);
        constexpr int N_ALL = N_GU + N_DN + N_NAMED;
        for (int it = gw; it < N_ALL; it += NGW) {
            int r = it;
            if (r < N_GU) { constexpr int per = tr_items(1024, 128); const int job = r / per, rr = r - job * per, e = job >> 2, pn = (job >> 1) & 1, bj = job & 1;
                tr_item((bj ? X.w_eu : X.w_eg) + (size_t)e * 1024 * 256 + 128 * pn, 256, 1024, 128, wsp<bf16_t>(X, WS_WEGUT) + ((size_t)e * 512 + 256 * pn + 128 * bj) * 1024, nullptr, scr, rr, lane); continue; }
            r -= N_GU;
            if (r < N_DN) { constexpr int per = tr_items(256, 1024); const int e = r / per, rr = r - e * per;
                tr_item(X.w_ed + (size_t)e * 256 * 1024, 1024, 256, 1024, wsp<bf16_t>(X, WS_WEDT) + (size_t)e * 1024 * 256, nullptr, scr, rr, lane); continue; }
            r -= N_DN;
            bool done = false;
#pragma unroll
            for (int sg = 0; sg < 9; ++sg) { const int n = tr_items(1024, seg_nc[sg]);
                if (!done && r < n) { tr_item(X.w_in + seg_c0[sg], 1352, 1024, seg_nc[sg], WT1 + (size_t)seg_d0[sg] * 1024, nullptr, scr, r, lane); done = true; }
                if (!done) r -= n; }
            if (done) continue;
            if (r < tr_items(1024, 2048)) { tr_item(X.w_gate, 2048, 1024, 2048, WT1 + (size_t)1536 * 1024, nullptr, scr, r, lane); continue; } r -= tr_items(1024, 2048);
            if (r < tr_items(256, 768)) { tr_item(X.w_uq, 768, 256, 768, wsp<bf16_t>(X, WS_WUQT), X.q_norm_g, scr, r, lane); continue; } r -= tr_items(256, 768);
            if (r < tr_items(128, 512)) { tr_item(X.w_uk, 512, 128, 512, wsp<bf16_t>(X, WS_WUKVT), X.kv_norm_g, scr, r, lane); continue; } r -= tr_items(128, 512);
            if (r < tr_items(128, 512)) { tr_item(X.w_uv, 512, 128, 512, wsp<bf16_t>(X, WS_WUKVT) + 512 * 128, X.kv_norm_g, scr, r, lane); continue; } r -= tr_items(128, 512);
            if (r < tr_items(512, 1024)) { tr_item(X.w_up_a, 1024, 512, 1024, wsp<bf16_t>(X, WS_WUPT), nullptr, scr, r, lane, 1024); continue; } r -= tr_items(512, 1024);
            if (r < tr_items(512, 1024)) { tr_item(X.w_up_b, 1024, 512, 1024, wsp<bf16_t>(X, WS_WUPT) + 512, nullptr, scr, r, lane, 1024); continue; } r -= tr_items(512, 1024);
            tr_item(X.w_o, 1024, 1024, 1024, wsp<bf16_t>(X, WS_WOT), nullptr, scr, r, lane);
        }
    }
    { const int gt = X.bid * 512 + tid, NT = X.G * 512; u32x4 z = {0u, 0u, 0u, 0u};
      for (int i = gt; i < 184 * 1024 / 8; i += NT) *(u32x4*)(WT1 + (size_t)1352 * 1024 + (size_t)i * 8) = z; }
    { const int gt = X.bid * 512 + tid, NT = X.G * 512; bf16_t* WR = wsp<bf16_t>(X, WS_WRT);
      for (int i = gt; i < 64 * 1024; i += NT) { const int j = i >> 10, k = i & 1023;
          const float v = (j < 4) ? X.w_grp[k * 4 + j] : (j < 36 ? X.w_rt[k * 32 + (j - 4)] : 0.f);
          const unsigned hi = pk2(v, 0.f) & 0xffffu; const float lo = v - bf2f((unsigned short)hi);
          WR[(size_t)j * 1024 + k] = (bf16_t)hi; WR[(size_t)(64 + j) * 1024 + k] = (bf16_t)(pk2(lo, 0.f) & 0xffffu); } }
    { const int gt = X.bid * 512 + tid, NT = X.G * 512; float* RT = wsp<float>(X, WS_ROPE);
      for (int i = gt; i < M * 16; i += NT) { const int row = i >> 4, j = i & 15; float sn, cs; rope_sincos(X.pos[row], j, sn, cs); RT[(size_t)row * 32 + j] = cs; RT[(size_t)row * 32 + 16 + j] = sn; } }
    { int* TS = wsp<int>(X, WS_TSTAT);
      for (int t = gw; t < M / 64; t += NGW) { const int p = X.pos[t * 64 + lane]; const int pmin = wave_min_i(p), pmax = wave_max_i(p);
          if (lane == 0) { TS[t * 4 + 0] = pmin >> 6; TS[t * 4 + 1] = pmax >> 6; TS[t * 4 + 2] = pmin; TS[t * 4 + 3] = pmax; } } }
    { bf16_t* XN = wsp<bf16_t>(X, WS_B); float* ST = wsp<float>(X, WS_STATS0);
      f32x4 gv[4], bv[4];
#pragma unroll
      for (int j = 0; j < 4; ++j) { gv[j] = *(const f32x4*)(X.ln0_g + 4 * lane + 256 * j); bv[j] = *(const f32x4*)(X.ln0_b + 4 * lane + 256 * j); }
      f32x4 nx[4];
      if (gw < M) { const f32x4* xr = (const f32x4*)(X.x + (size_t)gw * D) + lane;
#pragma unroll
          for (int j = 0; j < 4; ++j) nx[j] = xr[64 * j]; }
      for (int m = gw; m < M; m += NGW) {
          f32x4 v[4]; float s = 0.f;
#pragma unroll
          for (int j = 0; j < 4; ++j) { v[j] = nx[j]; s += (v[j].x + v[j].y) + (v[j].z + v[j].w); }
          if (m + NGW < M) { const f32x4* xr = (const f32x4*)(X.x + (size_t)(m + NGW) * D) + lane;
#pragma unroll
              for (int j = 0; j < 4; ++j) nx[j] = xr[64 * j]; }
          const float mean = wave_sum(s) * (1.f / D); float s2 = 0.f;
#pragma unroll
          for (int j = 0; j < 4; ++j) { v[j] = v[j] - mean; s2 += (v[j].x * v[j].x + v[j].y * v[j].y) + (v[j].z * v[j].z + v[j].w * v[j].w); }
          const float rstd = 1.f / sqrtf(wave_sum(s2) * (1.f / D) + LN_EPS);
          if (lane == 0) { ST[2 * m] = mean; ST[2 * m + 1] = rstd; }
          u32x2* o8 = (u32x2*)(XN + (size_t)m * D) + lane;
#pragma unroll
          for (int j = 0; j < 4; ++j) { const f32x4 y = v[j] * rstd * gv[j] + bv[j]; u32x2 o; o.x = pk2(y.x, y.y); o.y = pk2(y.z, y.w); o8[64 * j] = o;
          }
      } }
}

DI void store8(bf16_t* p, const f32x4& a, const f32x4& b) { u32x4 w; w.x = pk2(a[0], a[1]); w.y = pk2(a[2], a[3]); w.z = pk2(b[0], b[1]); w.w = pk2(b[2], b[3]); *(u32x4*)p = w; }
DI void rope8(f32x4& v0, f32x4& v1, const float* tab, int fq) {
    const float sg = (fq < 2) ? -1.f : 1.f; const int j0 = 8 * (fq & 1);
    const f32x4 c0 = *(const f32x4*)(tab + j0), c1 = *(const f32x4*)(tab + j0 + 4), s0 = *(const f32x4*)(tab + 16 + j0), s1 = *(const f32x4*)(tab + 16 + j0 + 4);
#pragma unroll
    for (int e = 0; e < 4; ++e) {
        const float o0 = __shfl_xor(v0[e], 32), o1 = __shfl_xor(v1[e], 32);
        v0[e] = v0[e] * c0[e] + sg * o0 * s0[e];
        v1[e] = v1[e] * c1[e] + sg * o1 * s1[e];
    }
}
struct Epi1 {
    static constexpr bool PERM = true, MID = false;
    bf16_t *CQ, *CKV, *KR, *KI, *KB, *VB, *QB, *QI, *G; float *WI, *SSQ; const float* rope; const float* bgate;
    DI void operator()(const f32x4 (&acc)[2][2][4][2], const Unit& u, int wr, int wc, int fr_, int fq_) const {
        int fr = fr_, fq = fq_; asm volatile("" : "+v"(fr), "+v"(fq));
        const int pn = u.pn; const int row0 = u.pm * 256 + wr * 64 + fr;
        if (pn >= 6) {
            const int gc0 = (pn - 6) * 256 + 32 * wc + 8 * fq;
#pragma unroll
            for (int bj = 0; bj < 2; ++bj) { const f32x4 b0 = *(const f32x4*)(bgate + gc0 + 128 * bj), b1 = *(const f32x4*)(bgate + gc0 + 128 * bj + 4);
#pragma unroll
                for (int ai = 0; ai < 2; ++ai)
#pragma unroll
                    for (int m = 0; m < 4; ++m) { f32x4 v0 = acc[ai][bj][m][0] + b0, v1 = acc[ai][bj][m][1] + b1;
#pragma unroll
                        for (int e = 0; e < 4; ++e) { v0[e] = sigmoidf_fast(v0[e]); v1[e] = sigmoidf_fast(v1[e]); }
                        store8(G + (size_t)(row0 + ai * 128 + m * 16) * 2048 + gc0 + 128 * bj, v0, v1); } }
        } else if (pn == 0 || pn == 4) {
            bf16_t* O = pn == 0 ? CQ : QI;
#pragma unroll
            for (int ai = 0; ai < 2; ++ai)
#pragma unroll
                for (int m = 0; m < 4; ++m) { const int row = row0 + ai * 128 + m * 16; float s = 0.f;
#pragma unroll
                    for (int bj = 0; bj < 2; ++bj) { const f32x4 v0 = acc[ai][bj][m][0], v1 = acc[ai][bj][m][1];
                        store8(O + (size_t)row * 256 + 128 * bj + 32 * wc + 8 * fq, v0, v1);
                        s += (v0[0] * v0[0] + v0[1] * v0[1]) + (v0[2] * v0[2] + v0[3] * v0[3]) + (v1[0] * v1[0] + v1[1] * v1[1]) + (v1[2] * v1[2] + v1[3] * v1[3]); }
                    if (pn == 0) { s += __shfl_xor(s, 16); s += __shfl_xor(s, 32); if (fq == 0) SSQ[(size_t)row * 8 + wc] = s; } }
        } else if (pn == 2 || pn == 3) {
            const float sc = 0.125f * LOG2E;
#pragma unroll
            for (int ai = 0; ai < 2; ++ai)
#pragma unroll
                for (int m = 0; m < 4; ++m) { const int row = row0 + ai * 128 + m * 16;
#pragma unroll
                    for (int bj = 0; bj < 2; ++bj) store8(QB + (size_t)row * 512 + (pn - 2) * 256 + 128 * bj + 32 * wc + 8 * fq, acc[ai][bj][m][0] * sc, acc[ai][bj][m][1] * sc); }
        } else if (pn == 1) {
#pragma unroll
            for (int ai = 0; ai < 2; ++ai)
#pragma unroll
                for (int m = 0; m < 4; ++m) { const int row = row0 + ai * 128 + m * 16;
                    { const f32x4 v0 = acc[ai][0][m][0], v1 = acc[ai][0][m][1];
                      store8(CKV + (size_t)row * 128 + 32 * wc + 8 * fq, v0, v1);
                      float s = (v0[0] * v0[0] + v0[1] * v0[1]) + (v0[2] * v0[2] + v0[3] * v0[3]) + (v1[0] * v1[0] + v1[1] * v1[1]) + (v1[2] * v1[2] + v1[3] * v1[3]);
                      s += __shfl_xor(s, 16); s += __shfl_xor(s, 32); if (fq == 0) SSQ[(size_t)row * 8 + 4 + wc] = s; }
                    f32x4 v0 = acc[ai][1][m][0], v1 = acc[ai][1][m][1];
                    if (wc == 0) { rope8(v0, v1, rope + (size_t)row * 32, fq); store8(KR + (size_t)row * 32 + 8 * fq, v0, v1); }
                    else if (wc == 1) store8(KI + (size_t)row * 32 + 8 * fq, v0, v1);
                    else store8(KB + (size_t)row * 64 + 32 * (wc - 2) + 8 * fq, v0, v1); }
        } else {
            const float wsc = 0.35355339059327373f * 0.17677669529663687f;
#pragma unroll
            for (int ai = 0; ai < 2; ++ai)
#pragma unroll
                for (int m = 0; m < 4; ++m) { const int row = row0 + ai * 128 + m * 16;
                    if (wc < 2) store8(VB + (size_t)row * 64 + 32 * wc + 8 * fq, acc[ai][0][m][0], acc[ai][0][m][1]);
                    else if (wc == 2 && fq == 0) { *(f32x4*)(WI + (size_t)row * 8) = acc[ai][0][m][0] * wsc; *(f32x4*)(WI + (size_t)row * 8 + 4) = acc[ai][0][m][1] * wsc; } }
        }
    }
};
struct Epi2 {
    static constexpr bool PERM = true, MID = false;
    bf16_t* QM; const float* SSQ; const float* rope;
    DI void operator()(const f32x4 (&acc)[2][2][4][2], const Unit& u, int wr, int wc, int fr_, int fq_) const {
        int fr = fr_, fq = fq_; asm volatile("" : "+v"(fr), "+v"(fq));
        const int row0 = u.pm * 256 + wr * 64 + fr; const float sc = 0.10206207261596575f * LOG2E;
#pragma unroll
        for (int ai = 0; ai < 2; ++ai)
#pragma unroll
            for (int m = 0; m < 4; ++m) { const int row = row0 + ai * 128 + m * 16;
                const f32x4 q4 = *(const f32x4*)(SSQ + (size_t)row * 8); const float rs = sc / sqrtf(((q4[0] + q4[1]) + (q4[2] + q4[3])) * (1.f / 256.f) + RMS_EPS);
#pragma unroll
                for (int bj = 0; bj < 2; ++bj) { const int g32 = 8 * u.pn + 4 * bj + wc; f32x4 v0 = acc[ai][bj][m][0] * rs, v1 = acc[ai][bj][m][1] * rs;
                    if (g32 % 3 == 2) rope8(v0, v1, rope + (size_t)row * 32, fq);
                    store8(QM + (size_t)row * 768 + 32 * g32 + 8 * fq, v0, v1); } }
    }
};
struct Epi3 {
    static constexpr bool PERM = true, MID = false;
    bf16_t *KN, *VM; const float* SSQ;
    DI void operator()(const f32x4 (&acc)[2][2][4][2], const Unit& u, int wr, int wc, int fr_, int fq_) const {
        int fr = fr_, fq = fq_; asm volatile("" : "+v"(fr), "+v"(fq));
        const int row0 = u.pm * 256 + wr * 64 + fr; bf16_t* O = u.pn < 2 ? KN : VM; const int c0 = (u.pn & 1) * 256 + 32 * wc + 8 * fq;
#pragma unroll
        for (int ai = 0; ai < 2; ++ai)
#pragma unroll
            for (int m = 0; m < 4; ++m) { const int row = row0 + ai * 128 + m * 16;
                const f32x4 q4 = *(const f32x4*)(SSQ + (size_t)row * 8 + 4); const float rs = 1.f / sqrtf(((q4[0] + q4[1]) + (q4[2] + q4[3])) * (1.f / 128.f) + RMS_EPS);
#pragma unroll
                for (int bj = 0; bj < 2; ++bj) store8(O + (size_t)row * 512 + c0 + 128 * bj, acc[ai][bj][m][0] * rs, acc[ai][bj][m][1] * rs); }
    }
};
struct Epi4 {
    static constexpr bool PERM = true, MID = true;
    bf16_t* MIX; const bf16_t* G;
    DI void mid(f32x4 (&acc)[2][2][4][2], const Unit& u, int wr, int wc, int fr, int fq) const {
        const int row0 = u.pm * 256 + wr * 64 + fr, c0 = u.pn * 256 + 32 * wc + 8 * fq;
#pragma unroll
        for (int ai = 0; ai < 2; ++ai) {
            u32x4 ga[4][2], gb[4][2];
#pragma unroll
            for (int m = 0; m < 4; ++m)
#pragma unroll
                for (int bj = 0; bj < 2; ++bj) { const size_t o = (size_t)(row0 + ai * 128 + m * 16) * 2048 + c0 + 128 * bj; ga[m][bj] = *(const u32x4*)(G + o); gb[m][bj] = *(const u32x4*)(G + o + 1024); }
#pragma unroll
            for (int m = 0; m < 4; ++m)
#pragma unroll
                for (int bj = 0; bj < 2; ++bj) {
                    const unsigned gaw[4] = {ga[m][bj].x, ga[m][bj].y, ga[m][bj].z, ga[m][bj].w}, gbw[4] = {gb[m][bj].x, gb[m][bj].y, gb[m][bj].z, gb[m][bj].w};
#pragma unroll
                    for (int q = 0; q < 4; ++q) {
                        const float a0 = __uint_as_float(gaw[q] << 16), a1 = __uint_as_float(gaw[q] & 0xffff0000u), b0 = __uint_as_float(gbw[q] << 16), b1 = __uint_as_float(gbw[q] & 0xffff0000u);
                        const float r0 = a0 * fast_rcp(fmaxf(b0, 1e-30f)), r1 = a1 * fast_rcp(fmaxf(b1, 1e-30f));
                        acc[ai][bj][m][q >> 1][2 * (q & 1)] *= r0; acc[ai][bj][m][q >> 1][2 * (q & 1) + 1] *= r1; }
                }
            asm volatile("" ::: "memory");
        }
    }
    DI void operator()(const f32x4 (&acc)[2][2][4][2], const Unit& u, int wr, int wc, int fr_, int fq_) const {
        int fr = fr_, fq = fq_; asm volatile("" : "+v"(fr), "+v"(fq));
        const int row0 = u.pm * 256 + wr * 64 + fr, c0 = u.pn * 256 + 32 * wc + 8 * fq;
#pragma unroll
        for (int ai = 0; ai < 2; ++ai)
#pragma unroll
            for (int m = 0; m < 4; ++m) { const int row = row0 + ai * 128 + m * 16;
#pragma unroll
                for (int bj = 0; bj < 2; ++bj) { const int c = c0 + 128 * bj;
                    const u32x4 gw = *(const u32x4*)(G + (size_t)row * 2048 + 1024 + c);
                    f32x4 v0 = acc[ai][bj][m][0], v1 = acc[ai][bj][m][1];
                    v0[0] *= __uint_as_float(gw.x << 16); v0[1] *= __uint_as_float(gw.x & 0xffff0000u); v0[2] *= __uint_as_float(gw.y << 16); v0[3] *= __uint_as_float(gw.y & 0xffff0000u);
                    v1[0] *= __uint_as_float(gw.z << 16); v1[1] *= __uint_as_float(gw.z & 0xffff0000u); v1[2] *= __uint_as_float(gw.w << 16); v1[3] *= __uint_as_float(gw.w & 0xffff0000u);
                    store8(MIX + (size_t)row * 1024 + c, v0, v1); } }
    }
};
struct Epi5 {
    static constexpr bool PERM = false, MID = false;
    float* Y1; const float *x, *ST, *g0, *b0;
    DI void operator()(const f32x4 (&acc)[2][2][4][2], const Unit& u, int wr, int wc, int fr_, int fq_) const {
        int fr = fr_, fq = fq_; asm volatile("" : "+v"(fr), "+v"(fq));
        const int row0 = u.pm * 256 + wr * 64 + fr, c0 = u.pn * 256 + 32 * wc + 4 * fq;
        f32x4 gv[2][2], bv[2][2];
#pragma unroll
        for (int bj = 0; bj < 2; ++bj)
#pragma unroll
            for (int n = 0; n < 2; ++n) { gv[bj][n] = *(const f32x4*)(g0 + c0 + 128 * bj + 16 * n) * ALPHA; bv[bj][n] = *(const f32x4*)(b0 + c0 + 128 * bj + 16 * n) * ALPHA; }
#pragma unroll
        for (int ai = 0; ai < 2; ++ai)
#pragma unroll
            for (int m = 0; m < 4; ++m) { const int row = row0 + ai * 128 + m * 16; const float mean = ST[2 * row], rstd = ST[2 * row + 1];
#pragma unroll
                for (int bj = 0; bj < 2; ++bj)
#pragma unroll
                    for (int n = 0; n < 2; ++n) { const size_t off = (size_t)row * 1024 + c0 + 128 * bj + 16 * n;
                        const f32x4 xv = *(const f32x4*)(x + off);
                        *(f32x4*)(Y1 + off) = (xv - mean) * rstd * gv[bj][n] + bv[bj][n] + acc[ai][bj][m][n]; } }
    }
};
struct MoeOrder {
    const LAS int* tstart;
    const LAS int* scnt;
    const int* LIST; int K2;
    int NT, G, c, ntiles;
    DI bool next(int i, Unit& u) const {
        const long L = (long)i * G + c; if (L >= (long)ntiles * NT) return false;
        const int tile = (int)(L / NT), pn = (int)(L - (long)tile * NT);
        int lo = 0, hi = NSEG;
#pragma unroll
        for (int s = 0; s < 6; ++s) { const int mid = (lo + hi) >> 1; if (tstart[mid] <= tile) lo = mid; else hi = mid; }
        const int ts = tstart[lo];
        u.pm = tile; u.pn = __builtin_amdgcn_readfirstlane((lo & 31) * NT + pn); u.a0 = __builtin_amdgcn_readfirstlane(lo); u.a1 = __builtin_amdgcn_readfirstlane(tile - ts); return true;
    }
    DI unsigned arow(const Unit& u, int r) const { const int idx = u.a1 * 256 + r; const int tok = LIST[(size_t)u.a0 * M + (idx < scnt[u.a0] ? idx : 0)]; return (unsigned)tok * (unsigned)K2; }
};
struct Epi7 {
    static constexpr bool PERM = true, MID = false;
    bf16_t* HID; const float* LISTW; const LAS int* scnt;
    DI void operator()(const f32x4 (&acc)[2][2][4][2], const Unit& u, int wr, int wc, int fr_, int fq_) const {
        int fr = fr_, fq = fq_; asm volatile("" : "+v"(fr), "+v"(fq));
        const int c0 = (u.pn & 1) * 128 + 32 * wc + 8 * fq, cnt = scnt[u.a0];
#pragma unroll
        for (int ai = 0; ai < 2; ++ai)
#pragma unroll
            for (int m = 0; m < 4; ++m) { const int r = ai * 128 + wr * 64 + m * 16 + fr, idx = u.a1 * 256 + r;
                const float w = idx < cnt ? LISTW[(size_t)u.a0 * M + idx] : 0.f;
                f32x4 v0, v1;
#pragma unroll
                for (int e = 0; e < 4; ++e) { const float a0 = acc[ai][0][m][0][e], a1 = acc[ai][0][m][1][e];
                    v0[e] = a0 * sigmoidf_fast(a0) * acc[ai][1][m][0][e] * w; v1[e] = a1 * sigmoidf_fast(a1) * acc[ai][1][m][1][e] * w; }
                store8(HID + ((size_t)u.pm * 256 + r) * 256 + c0, v0, v1); }
    }
};
struct Epi8 {
    static constexpr bool PERM = true, MID = false;
    bf16_t* PP; const int* LIST; const LAS int* scnt;
    DI void operator()(const f32x4 (&acc)[2][2][4][2], const Unit& u, int wr, int wc, int fr_, int fq_) const {
        int fr = fr_, fq = fq_; asm volatile("" : "+v"(fr), "+v"(fq));
        const int c0 = (u.pn & 3) * 256 + 32 * wc + 8 * fq, cnt = scnt[u.a0]; bf16_t* O = PP + (size_t)(u.a0 >> 5) * M * 1024;
        int tok[2][4];
#pragma unroll
        for (int ai = 0; ai < 2; ++ai)
#pragma unroll
            for (int m = 0; m < 4; ++m) { const int r = ai * 128 + wr * 64 + m * 16 + fr, idx = u.a1 * 256 + r; tok[ai][m] = idx < cnt ? LIST[(size_t)u.a0 * M + idx] : -1; }
#pragma unroll
        for (int ai = 0; ai < 2; ++ai)
#pragma unroll
            for (int m = 0; m < 4; ++m) {
                if (tok[ai][m] >= 0) {
#pragma unroll
                    for (int bj = 0; bj < 2; ++bj) store8(O + (size_t)tok[ai][m] * 1024 + c0 + 128 * bj, acc[ai][bj][m][0], acc[ai][bj][m][1]); } }
    }
};


DI void p6_ln1_router(const Ctx& X) {
    const int lane = lane_id(), wave = X.wid, tid = wave * 64 + lane, r = lane & 31, hh = lane >> 5;
    LAS unsigned char* HI = X.lds; LAS unsigned char* LO = X.lds + 65536;
    LAS float* LG = (LAS float*)(X.lds + LDS_LG);
    const float* Y1 = wsp<float>(X, WS_A); float* ST1 = wsp<float>(X, WS_STATS1); bf16_t* HB = wsp<bf16_t>(X, WS_B);
    const bf16_t* WR = wsp<bf16_t>(X, WS_WRT);
    unsigned* CNT = wsp<unsigned>(X, WS_CTL) + CW_CNT; int* LIST = wsp<int>(X, WS_LIST); float* LISTW = wsp<float>(X, WS_LISTW);
    f32x4 gv[4], bv[4];
#pragma unroll
    for (int j = 0; j < 4; ++j) { gv[j] = *(const f32x4*)(X.ln1_g + 4 * lane + 256 * j); bv[j] = *(const f32x4*)(X.ln1_b + 4 * lane + 256 * j); }
    LAS unsigned* RT_SP = (LAS unsigned*)(X.lds + LDS_RT); LAS float* RT_W = (LAS float*)(X.lds + LDS_RT + 2048); LAS int* RT_TOK = (LAS int*)(X.lds + LDS_RT + 4096 - 0);
    LAS unsigned* RT_CNT = (LAS unsigned*)(X.lds + LDS_MISC + 1024); LAS unsigned* RT_BASE = (LAS unsigned*)(X.lds + LDS_MISC + 1280);
    if (tid < NSEG) RT_CNT[tid] = 0u;
    int nbatch = 0;
    __syncthreads();
    for (int unit = X.bid; unit < M / 32; unit += X.G) {
        *(LAS f32x4*)(LG + tid * 4) = (f32x4){0.f, 0.f, 0.f, 0.f};
        f32x4 vv[4][4];
#pragma unroll
        for (int rr = 0; rr < 4; ++rr) { const f32x4* yr = (const f32x4*)(Y1 + (size_t)(unit * 32 + wave * 4 + rr) * D) + lane;
#pragma unroll
            for (int j = 0; j < 4; ++j) vv[rr][j] = yr[64 * j]; }
#pragma unroll
        for (int rr = 0; rr < 4; ++rr) {
            const int rl = wave * 4 + rr, m = unit * 32 + rl;
            f32x4 v[4]; float s = 0.f;
#pragma unroll
            for (int j = 0; j < 4; ++j) { v[j] = vv[rr][j]; s += (v[j].x + v[j].y) + (v[j].z + v[j].w); }
            const float mean = wave_sum(s) * (1.f / D); float s2 = 0.f;
#pragma unroll
            for (int j = 0; j < 4; ++j) { v[j] = v[j] - mean; s2 += (v[j].x * v[j].x + v[j].y * v[j].y) + (v[j].z * v[j].z + v[j].w * v[j].w); }
            const float rstd = 1.f / sqrtf(wave_sum(s2) * (1.f / D) + LN_EPS);
            if (lane == 0) { ST1[2 * m] = mean; ST1[2 * m + 1] = rstd; }
#pragma unroll
            for (int j = 0; j < 4; ++j) {
                const f32x4 y = v[j] * rstd * gv[j] + bv[j];
                u32x2 hi; hi.x = pk2(y.x, y.y); hi.y = pk2(y.z, y.w);
                *((u32x2*)(HB + (size_t)m * D) + lane + 64 * j) = hi;
                const float l0 = y.x - __uint_as_float(hi.x << 16), l1 = y.y - __uint_as_float(hi.x & 0xffff0000u), l2 = y.z - __uint_as_float(hi.y << 16), l3 = y.w - __uint_as_float(hi.y & 0xffff0000u);
                u32x2 lo; lo.x = pk2(l0, l1); lo.y = pk2(l2, l3);
                const int chunk = (lane >> 1) + 32 * j; const unsigned byte = (unsigned)rl * 2048u + (unsigned)((chunk ^ (rl & 15)) * 16) + 8u * (lane & 1);
                *(LAS u32x2*)(HI + byte) = hi; *(LAS u32x2*)(LO + byte) = lo;
            }
        }
        __syncthreads();
        {
            f32x16 a0, a1;
#pragma unroll
            for (int e = 0; e < 16; ++e) { a0[e] = 0.f; a1[e] = 0.f; }
#pragma unroll
            for (int ks = 0; ks < 8; ++ks) {
                const int ch = 16 * wave + 2 * ks + hh; const unsigned byte = (unsigned)r * 2048u + (unsigned)((ch ^ (r & 15)) * 16);
                const bf16x8 ahi = *(const LAS bf16x8*)(HI + byte), alo = *(const LAS bf16x8*)(LO + byte);
                const size_t ko = (size_t)(128 * wave + 16 * ks + 8 * hh);
                const bf16x8 bh0 = *(const bf16x8*)(WR + (size_t)r * 1024 + ko), bh1 = *(const bf16x8*)(WR + (size_t)(32 + r) * 1024 + ko);
                const bf16x8 bl0 = *(const bf16x8*)(WR + (size_t)(64 + r) * 1024 + ko), bl1 = *(const bf16x8*)(WR + (size_t)(96 + r) * 1024 + ko);
                a0 = __builtin_amdgcn_mfma_f32_32x32x16_bf16(ahi, bh0, a0, 0, 0, 0); a0 = __builtin_amdgcn_mfma_f32_32x32x16_bf16(ahi, bl0, a0, 0, 0, 0); a0 = __builtin_amdgcn_mfma_f32_32x32x16_bf16(alo, bh0, a0, 0, 0, 0);
                a1 = __builtin_amdgcn_mfma_f32_32x32x16_bf16(ahi, bh1, a1, 0, 0, 0); a1 = __builtin_amdgcn_mfma_f32_32x32x16_bf16(ahi, bl1, a1, 0, 0, 0); a1 = __builtin_amdgcn_mfma_f32_32x32x16_bf16(alo, bh1, a1, 0, 0, 0);
            }
#pragma unroll
            for (int e = 0; e < 16; ++e) { const int row = (e & 3) + 8 * (e >> 2) + 4 * hh;
                __hip_atomic_fetch_add(LG + row * 64 + r, a0[e], __ATOMIC_RELAXED, __HIP_MEMORY_SCOPE_WORKGROUP);
                if (r < 4) __hip_atomic_fetch_add(LG + row * 64 + 32 + r, a1[e], __ATOMIC_RELAXED, __HIP_MEMORY_SCOPE_WORKGROUP); }
        }
        __syncthreads();
        if (tid < 32) {
            const LAS float* lg = LG + tid * 64;
            float gl[4]; float gmax = -3.4e38f; int gsel = 0;
#pragma unroll
            for (int j = 0; j < 4; ++j) { gl[j] = lg[j] + X.b_grp[j]; if (gl[j] > gmax) { gmax = gl[j]; gsel = j; } }
            float gz = 0.f;
#pragma unroll
            for (int j = 0; j < 4; ++j) gz += expf(gl[j] - gmax);
            const float gw = 1.f / gz;
            float e0 = -3.4e38f, e1 = -3.4e38f; int i0 = 0, i1 = 0;
#pragma unroll
            for (int j = 0; j < 8; ++j) { const float v = lg[4 + gsel * 8 + j] + X.b_rt[gsel * 8 + j];
                if (v > e0) { e1 = e0; i1 = i0; e0 = v; i0 = j; } else if (v > e1) { e1 = v; i1 = j; } }
            const float t = expf(e1 - e0), c0 = gw / (1.f + t), c1 = gw * t / (1.f + t);
            const int s0 = gsel * 8 + i0, s1 = 32 + gsel * 8 + i1;
            const unsigned l0 = __hip_atomic_fetch_add(RT_CNT + s0, 1u, __ATOMIC_RELAXED, __HIP_MEMORY_SCOPE_WORKGROUP), l1 = __hip_atomic_fetch_add(RT_CNT + s1, 1u, __ATOMIC_RELAXED, __HIP_MEMORY_SCOPE_WORKGROUP);
            const int slot = nbatch * 32 + tid;
            RT_SP[slot * 2] = ((unsigned)s0 << 16) | l0; RT_SP[slot * 2 + 1] = ((unsigned)s1 << 16) | l1; RT_W[slot * 2] = c0; RT_W[slot * 2 + 1] = c1; RT_TOK[slot] = unit * 32 + tid;
        }
        ++nbatch;
        __syncthreads();
        if (nbatch == 8 || unit + X.G >= M / 32) {
            if (tid < NSEG) { const unsigned n = RT_CNT[tid]; RT_BASE[tid] = n ? __hip_atomic_fetch_add(CNT + tid, n, __ATOMIC_RELAXED, __HIP_MEMORY_SCOPE_AGENT) : 0u; }
            __syncthreads();
            if (tid < nbatch * 32) {
#pragma unroll
                for (int k = 0; k < 2; ++k) { const unsigned sp = RT_SP[tid * 2 + k], sg = sp >> 16, ps = RT_BASE[sg] + (sp & 0xffffu);
                    LIST[(size_t)sg * M + ps] = RT_TOK[tid]; LISTW[(size_t)sg * M + ps] = RT_W[tid * 2 + k]; }
            }
            __syncthreads();
            if (tid < NSEG) RT_CNT[tid] = 0u;
            nbatch = 0;
            __syncthreads();
        }
    }
}

DI void moe_prep(const Ctx& X) {
    const int tid = X.wid * 64 + lane_id();
    LAS int* tstart = (LAS int*)(X.lds + LDS_MISC + 64); LAS int* scnt = (LAS int*)(X.lds + LDS_MISC + 512);
    unsigned* CNT = wsp<unsigned>(X, WS_CTL) + CW_CNT;
    if (tid < NSEG) {
        const int c = (int)__hip_atomic_load(CNT + tid, __ATOMIC_RELAXED, __HIP_MEMORY_SCOPE_AGENT); scnt[tid] = c;
        const int nt = (c + 255) >> 8; int inc = nt;
#pragma unroll
        for (int d = 1; d < 64; d <<= 1) { const int t = __shfl_up(inc, d); if (tid >= d) inc += t; }
        tstart[tid] = inc - nt; if (tid == NSEG - 1) tstart[NSEG] = inc;
    }
    __syncthreads();
}

DI void p9_ln2(const Ctx& X) {
    const int lane = lane_id(), wave = X.wid;
    const int gw = X.bid * 8 + wave, NGW = X.G * 8;
    const float* Y1 = wsp<float>(X, WS_A); const float* ST1 = wsp<float>(X, WS_STATS1); const bf16_t* PP0 = wsp<bf16_t>(X, WS_C); const bf16_t* PP1 = PP0 + (size_t)M * 1024;
    f32x4 gv[4], bv[4], g1[4], b1[4];
#pragma unroll
    for (int j = 0; j < 4; ++j) { gv[j] = *(const f32x4*)(X.ln2_g + 4 * lane + 256 * j); bv[j] = *(const f32x4*)(X.ln2_b + 4 * lane + 256 * j);
        g1[j] = *(const f32x4*)(X.ln1_g + 4 * lane + 256 * j) * ALPHA; b1[j] = *(const f32x4*)(X.ln1_b + 4 * lane + 256 * j) * ALPHA; }
    f32x4 ny[4]; u32x2 na[4], nb[4]; float nmean = 0.f, nrstd = 0.f;
#define P9_LOAD(mm) do { _Pragma("unroll") for (int j = 0; j < 4; ++j) { ny[j] = *((const f32x4*)(Y1 + (size_t)(mm) * D) + lane + 64 * j); \
        na[j] = *((const u32x2*)(PP0 + (size_t)(mm) * D) + lane + 64 * j); nb[j] = *((const u32x2*)(PP1 + (size_t)(mm) * D) + lane + 64 * j); } nmean = ST1[2 * (mm)]; nrstd = ST1[2 * (mm) + 1]; } while (0)
    if (gw < M) P9_LOAD(gw);
    for (int m = gw; m < M; m += NGW) {
        f32x4 v[4]; float s = 0.f; const float mean1 = nmean, rstd1 = nrstd;
        f32x4 yv4[4]; u32x2 a4[4], b4[4];
#pragma unroll
        for (int j = 0; j < 4; ++j) { yv4[j] = ny[j]; a4[j] = na[j]; b4[j] = nb[j]; }
        if (m + NGW < M) P9_LOAD(m + NGW);
#pragma unroll
        for (int j = 0; j < 4; ++j) {
            const f32x4 yv = yv4[j]; const u32x2 a = a4[j], b = b4[j];
            f32x4 y = (yv - mean1) * rstd1 * g1[j] + b1[j];
            y.x += __uint_as_float(a.x << 16) + __uint_as_float(b.x << 16); y.y += __uint_as_float(a.x & 0xffff0000u) + __uint_as_float(b.x & 0xffff0000u);
            y.z += __uint_as_float(a.y << 16) + __uint_as_float(b.y << 16); y.w += __uint_as_float(a.y & 0xffff0000u) + __uint_as_float(b.y & 0xffff0000u);
            v[j] = y; s += (y.x + y.y) + (y.z + y.w);
        }
        const float mean = wave_sum(s) * (1.f / D); float s2 = 0.f;
#pragma unroll
        for (int j = 0; j < 4; ++j) { v[j] = v[j] - mean; s2 += (v[j].x * v[j].x + v[j].y * v[j].y) + (v[j].z * v[j].z + v[j].w * v[j].w); }
        const float rstd = 1.f / sqrtf(wave_sum(s2) * (1.f / D) + LN_EPS);
#pragma unroll
        for (int j = 0; j < 4; ++j) *((f32x4*)(X.out + (size_t)m * D) + lane + 64 * j) = v[j] * rstd * gv[j] + bv[j];
    }
#undef P9_LOAD
}

#define MFMA32(a, b, c) __builtin_amdgcn_mfma_f32_32x32x16_bf16((a), (b), (c), 0, 0, 0)
DI bf16x8 pack8(const f32x16& x, int s) {
    u32x4 p; p.x = pk2(x[8 * s + 0], x[8 * s + 1]); p.y = pk2(x[8 * s + 2], x[8 * s + 3]); p.z = pk2(x[8 * s + 4], x[8 * s + 5]); p.w = pk2(x[8 * s + 6], x[8 * s + 7]);
    return __builtin_bit_cast(bf16x8, p);
}
struct TrRegs { s16x4 t0, t1, t2, t3, t4, t5, t6, t7; };
DI void tr_issue8(unsigned addr, TrRegs& T) {
    asm volatile("ds_read_b64_tr_b16 %0, %8\n\tds_read_b64_tr_b16 %1, %8 offset:1024\n\tds_read_b64_tr_b16 %2, %8 offset:2048\n\tds_read_b64_tr_b16 %3, %8 offset:3072\n\t"
                 "ds_read_b64_tr_b16 %4, %8 offset:4096\n\tds_read_b64_tr_b16 %5, %8 offset:5120\n\tds_read_b64_tr_b16 %6, %8 offset:6144\n\tds_read_b64_tr_b16 %7, %8 offset:7168"
                 : "=&v"(T.t0), "=&v"(T.t1), "=&v"(T.t2), "=&v"(T.t3), "=&v"(T.t4), "=&v"(T.t5), "=&v"(T.t6), "=&v"(T.t7) : "v"(addr) : "memory");
}
DI void tr_wait(TrRegs& A, TrRegs& B) {
    asm volatile("s_waitcnt lgkmcnt(0)" : "+v"(A.t0), "+v"(A.t1), "+v"(A.t2), "+v"(A.t3), "+v"(A.t4), "+v"(A.t5), "+v"(A.t6), "+v"(A.t7),
                 "+v"(B.t0), "+v"(B.t1), "+v"(B.t2), "+v"(B.t3), "+v"(B.t4), "+v"(B.t5), "+v"(B.t6), "+v"(B.t7) :: "memory");
}
DI void tr_frags(const TrRegs& T, bf16x8 (&vf)[4]) {
    vf[0] = __builtin_shufflevector(T.t0, T.t1, 0, 1, 2, 3, 4, 5, 6, 7); vf[1] = __builtin_shufflevector(T.t2, T.t3, 0, 1, 2, 3, 4, 5, 6, 7);
    vf[2] = __builtin_shufflevector(T.t4, T.t5, 0, 1, 2, 3, 4, 5, 6, 7); vf[3] = __builtin_shufflevector(T.t6, T.t7, 0, 1, 2, 3, 4, 5, 6, 7);
}
DI float xhalf_max(float x) {
    const unsigned u = __float_as_uint(x);
    const auto r = __builtin_amdgcn_permlane32_swap(u, u, false, false);
    return fmaxf(__uint_as_float(r[0]), __uint_as_float(r[1]));
}
constexpr float M_FLOOR = -64.f, SM_THR = 4.f;
DI void softmax_tile(f32x16& s0, f32x16& s1, float& meff, float& lrun, f32x16& o0, f32x16& o1, bf16x8 (&pf)[4]) {
    float mx = fmaxf(s0[0], s1[0]);
#pragma unroll
    for (int e = 1; e < 16; ++e) mx = fmaxf(mx, fmaxf(s0[e], s1[e]));
    mx = xhalf_max(mx);
    if (__any(mx > SM_THR)) {
        const float delta = fmaxf(mx, 0.f), alpha = fast_exp2(-delta);
#pragma unroll
        for (int e = 0; e < 16; ++e) { s0[e] -= delta; s1[e] -= delta; o0[e] *= alpha; o1[e] *= alpha; }
        lrun *= alpha; meff += delta;
    }
    float ls = 0.f;
#pragma unroll
    for (int e = 0; e < 16; ++e) { s0[e] = fast_exp2(s0[e]); s1[e] = fast_exp2(s1[e]); ls += s0[e] + s1[e]; }
    lrun += ls;
    pf[0] = pack8(s0, 0); pf[1] = pack8(s0, 1); pf[2] = pack8(s1, 0); pf[3] = pack8(s1, 1);
}

DI void mla_unit(const Ctx& X, int b, int h, int qb) {
    const int lane = lane_id(), w = X.wid, tid = w * 64 + lane, r = lane & 31, hh = lane >> 5;
    LAS unsigned char* lds = X.lds; const unsigned ldsb = (unsigned)(uintptr_t)lds;
    const int tok0 = b * SEQ;
    const bf16_t* QM = wsp<bf16_t>(X, WS_QM); const bf16_t* KN = wsp<bf16_t>(X, WS_KN); const bf16_t* VM = wsp<bf16_t>(X, WS_VM); const bf16_t* KR = wsp<bf16_t>(X, WS_KR);
    bf16_t* OA = wsp<bf16_t>(X, WS_B);
    const int* TS = wsp<int>(X, WS_TSTAT) + (size_t)b * 32 * 4;
    const int qrow = tok0 + qb * 256 + w * 32 + r;
    bf16x8 qf[6];
#pragma unroll
    for (int s = 0; s < 6; ++s) qf[s] = *(const bf16x8*)(QM + (size_t)qrow * 768 + h * 96 + 16 * s + 8 * hh);
    const int qc = X.pos[qrow] >> 6;
    const i32x4 tsv = *(const i32x4*)(TS + 4 * (lane & 31));
    int qmin = 0x7fffffff, qmax = -0x7fffffff - 1;
#pragma unroll
    for (int t = 0; t < 4; ++t) { const int a = __builtin_amdgcn_readlane(tsv[0], qb * 4 + t), c = __builtin_amdgcn_readlane(tsv[1], qb * 4 + t); qmin = a < qmin ? a : qmin; qmax = c > qmax ? c : qmax; }
    unsigned procm = (unsigned)__ballot(lane < 32 && tsv[0] <= qmax);
    const unsigned maskm = (unsigned)__ballot(lane < 32 && tsv[1] > qmin);
    f32x16 o0, o1;
#pragma unroll
    for (int e = 0; e < 16; ++e) { o0[e] = 0.f; o1[e] = 0.f; }
    float mrun = M_FLOOR, lrun = 0.f;
    const int key_a = tid >> 3, ch_a = tid & 7, key_r = (tid >> 2) & 63, ch_r = tid & 3;
    const unsigned kdst = 192u * key_a + 16u * (ch_a ^ ((key_a >> 2) & 3)), vdst = 12288u + 128u * key_a + 16u * (ch_a ^ (((key_a >> 1) & 1) << 2));
    const unsigned rdst = 192u * key_r + 16u * ((8 + ch_r) ^ ((key_r >> 2) & 3));
    constexpr unsigned BUFB = 20736u;
    const int q4 = (lane & 15) >> 2, p4 = lane & 3, blk = (lane >> 4) & 1, sw = (q4 >> 1) & 1;
    const unsigned vbase = ldsb + 12288u + 128u * (4 * hh + q4) + 16u * (2 * blk + (p4 >> 1)) + 8u * (p4 & 1);
    const unsigned va0 = vbase + 64u * sw, va1 = vbase + 64u * (1 - sw);
    u32x4 rk, rv, rr = {0u, 0u, 0u, 0u}; int rkc = 0;
#define MLA_LOAD(j) do { const size_t t0_ = (size_t)tok0 + (size_t)(j) * 64; rk = *(const u32x4*)(KN + (t0_ + key_a) * 512 + h * 64 + ch_a * 8); rv = *(const u32x4*)(VM + (t0_ + key_a) * 512 + h * 64 + ch_a * 8); \
        if (tid < 256) rr = *(const u32x4*)(KR + (t0_ + key_r) * 32 + ch_r * 8); if (tid < 64) rkc = X.pos[t0_ + tid]; } while (0)
#define MLA_STORE(bo) do { *(LAS u32x4*)(lds + (bo) + kdst) = rk; *(LAS u32x4*)(lds + (bo) + vdst) = rv; if (tid < 256) *(LAS u32x4*)(lds + (bo) + rdst) = rr; if (tid < 64) *(LAS int*)(lds + (bo) + 20480u + 4u * tid) = rkc >> 6; } while (0)
    asm volatile("" :: "v"(qf[0]), "v"(qf[1]), "v"(qf[2]), "v"(qf[3]), "v"(qf[4]), "v"(qf[5]));
    int j = procm ? __builtin_ctz(procm) : 32; procm &= procm - 1u;
    unsigned cur = 0;
    if (j < 32) { MLA_LOAD(j); MLA_STORE(0u); }
    __syncthreads();
    f32x16 s0, s1; bf16x8 pf[4];
#define MLA_QK(bo_, j_) do { const float nm = -mrun; \
        if ((maskm >> (j_)) & 1u) { _Pragma("unroll") for (int g = 0; g < 4; ++g) { \
                const i32x4 c0 = *(const LAS i32x4*)(lds + (bo_) + 20480u + 4u * (8 * g + 4 * hh)), c1 = *(const LAS i32x4*)(lds + (bo_) + 20480u + 4u * (32 + 8 * g + 4 * hh)); \
                _Pragma("unroll") for (int e = 0; e < 4; ++e) { s0[4 * g + e] = c0[e] > qc ? NEGF : nm; s1[4 * g + e] = c1[e] > qc ? NEGF : nm; } } } \
        else { _Pragma("unroll") for (int e = 0; e < 16; ++e) { s0[e] = nm; s1[e] = nm; } } \
        _Pragma("unroll") for (int ks = 0; ks < 6; ++ks) { const unsigned ko = 192u * r + 16u * ((2 * ks + hh) ^ ((r >> 2) & 3)); \
            const bf16x8 a0 = *(const LAS bf16x8*)(lds + (bo_) + ko), a1 = *(const LAS bf16x8*)(lds + (bo_) + ko + 192u * 32u); \
            s0 = MFMA32(a0, qf[ks], s0); s1 = MFMA32(a1, qf[ks], s1); } } while (0)
#define MLA_PV(bo_) do { TrRegs TA, TB; tr_issue8(va0 + (bo_), TA); tr_issue8(va1 + (bo_), TB); tr_wait(TA, TB); bf16x8 vf[4]; tr_frags(TA, vf); \
        _Pragma("unroll") for (int k = 0; k < 4; ++k) o0 = MFMA32(vf[k], pf[k], o0); tr_frags(TB, vf); \
        _Pragma("unroll") for (int k = 0; k < 4; ++k) o1 = MFMA32(vf[k], pf[k], o1); } while (0)
    if (w < 4) {
        while (j < 32) {
            const int jn = procm ? __builtin_ctz(procm) : 32; procm &= procm - 1u;
            if (jn < 32) MLA_LOAD(jn);
            const unsigned bo = cur * BUFB;
            MLA_QK(bo, j);
            softmax_tile(s0, s1, mrun, lrun, o0, o1, pf);
            MLA_PV(bo);
            cur = cur == 2u ? 0u : cur + 1u;
            if (jn < 32) MLA_STORE(cur * BUFB);
            __syncthreads();
            j = jn;
        }
    } else {
        bool have = false; unsigned pbo = 0u;
        while (j < 32) {
            const int jn = procm ? __builtin_ctz(procm) : 32; procm &= procm - 1u;
            if (jn < 32) MLA_LOAD(jn);
            const unsigned bo = cur * BUFB;
            if (have) MLA_PV(pbo);
            MLA_QK(bo, j);
            softmax_tile(s0, s1, mrun, lrun, o0, o1, pf);
            pbo = bo; have = true;
            cur = cur == 2u ? 0u : cur + 1u;
            if (jn < 32) MLA_STORE(cur * BUFB);
            __syncthreads();
            j = jn;
        }
        if (have) MLA_PV(pbo);
    }
    __syncthreads();
#undef MLA_QK
#undef MLA_PV
#undef MLA_LOAD
#undef MLA_STORE
    const float inv = 1.f / (lrun + __shfl_xor(lrun, 32));
    bf16_t* op = OA + (size_t)qrow * 1024 + h * 64 + 4 * hh;
#pragma unroll
    for (int g = 0; g < 4; ++g) {
        u32x2 a, c; a.x = pk2(o0[4 * g] * inv, o0[4 * g + 1] * inv); a.y = pk2(o0[4 * g + 2] * inv, o0[4 * g + 3] * inv);
        c.x = pk2(o1[4 * g] * inv, o1[4 * g + 1] * inv); c.y = pk2(o1[4 * g + 2] * inv, o1[4 * g + 3] * inv);
        *(u32x2*)(op + 8 * g) = a; *(u32x2*)(op + 32 + 8 * g) = c;
    }
}

DI int t5_bucket(int rel) { const int n = rel < 0 ? -rel : rel;
    const int large = 8 + (n >= 12) + (n >= 16) + (n >= 23) + (n >= 32) + (n >= 46) + (n >= 64) + (n >= 91);
    return (rel > 0 ? 16 : 0) + (n < 8 ? n : large); }
DI void dsa_scan(LAS unsigned char* lds, int p, int lane, int w) {
    constexpr unsigned L_HIST = 17408u, L_PRE = 58368u, L_NEED = 58496u, L_ACT = 66944u;
    const int shift = 24 - 8 * p;
    const int ql = lane >> 4, part = lane & 15, q = 4 * w + ql;
    unsigned c[16]; unsigned sum = 0u;
#pragma unroll
    for (int t = 0; t < 16; ++t) { c[t] = *(const LAS unsigned*)(lds + L_HIST + 4u * ((16 * part + t) * 32 + q)); sum += c[t]; }
    unsigned sfx = sum;
#pragma unroll
    for (int d = 1; d < 16; d <<= 1) { const unsigned t = __shfl_down(sfx, d, 16); if (part + d < 16) sfx += t; }
    const unsigned total = __shfl(sfx, lane & ~15);
    const unsigned nd = *(const LAS unsigned*)(lds + L_NEED + 4u * q), pold = *(const LAS unsigned*)(lds + L_PRE + 4u * q);
    const unsigned excl = sfx - sum;
    if (nd != 0u && nd != 0xFFFFFFFFu) {
        if (total < nd) { if (part == 0) *(LAS unsigned*)(lds + L_NEED + 4u * q) = 0u; }
        else if (excl < nd && nd <= sfx) {
            unsigned run = excl, bsel = 0u, ndn = 0u, cb = 0u; bool found = false;
#pragma unroll
            for (int t = 15; t >= 0; --t) { if (!found && run + c[t] >= nd) { found = true; bsel = (unsigned)(16 * part + t); ndn = nd - run; cb = c[t]; } if (!found) run += c[t]; }
            const bool resolved = (ndn == cb);
            *(LAS unsigned*)(lds + L_PRE + 4u * q) = pold | (bsel << shift); *(LAS unsigned*)(lds + L_NEED + 4u * q) = resolved ? 0xFFFFFFFFu : ndn;
            if (!resolved) __hip_atomic_fetch_add((LAS unsigned*)(lds + L_ACT) + p, 1u, __ATOMIC_RELAXED, __HIP_MEMORY_SCOPE_WORKGROUP);
        }
    }
}
DI void dsa_attend(const Ctx& X, int b, int qt, int tid, unsigned proc);
template <bool ATTEND>
DI void dsa_unit(const Ctx& X, int b, int qt) {
    const int lane = lane_id(), w = X.wid, tid = w * 64 + lane, r = lane & 31, hh = lane >> 5;
    LAS unsigned char* lds = X.lds; const unsigned ldsb = (unsigned)(uintptr_t)lds;
    constexpr unsigned L_QIT = 0u  , L_HIST = 17408u, L_MSK = 50176u, L_PRE = 58368u, L_NEED = 58496u, L_BT = 58624u, L_KV = 67072u, KVB = 16640u;
    const int tok0 = b * SEQ, q0 = tok0 + qt * 32;
    const bf16_t* QI = wsp<bf16_t>(X, WS_QI); const bf16_t* KI = wsp<bf16_t>(X, WS_KI); const bf16_t* QB = wsp<bf16_t>(X, WS_QB);
    const bf16_t* KB = wsp<bf16_t>(X, WS_KB); const bf16_t* VB = wsp<bf16_t>(X, WS_VB); const float* WI = wsp<float>(X, WS_WI);
    const int* TS = wsp<int>(X, WS_TSTAT) + (size_t)b * 32 * 4;
    const i32x4 tsv = *(const i32x4*)(TS + 4 * (lane & 31));
    const int qmax = __builtin_amdgcn_readlane(tsv[1], qt >> 1);
    const unsigned proc = (unsigned)__ballot(lane < 32 && tsv[0] <= qmax);
#pragma unroll
    for (int i = 0; i < 2; ++i) { const int c = tid + 512 * i, row = c >> 5, ch = c & 31;
        *(LAS u32x4*)(lds + L_QIT + row * 528 + ch * 16) = *(const u32x4*)(QI + (size_t)(q0 + row) * 256 + ch * 8); }
    if (tid < 257) { const int bk = t5_bucket(tid - 128);
#pragma unroll
        for (int hd = 0; hd < 8; ++hd) *(LAS float*)(lds + L_BT + 4u * (hd * 260 + tid)) = LOG2E * (X.rel_bias[bk * 8 + hd] - X.rel_bias[15 * 8 + hd]); }
    if (tid < 32) { *(LAS unsigned*)(lds + L_PRE + 4u * tid) = 0u; *(LAS unsigned*)(lds + L_NEED + 4u * tid) = 256u; }
    if (tid < 4) *(LAS unsigned*)(lds + 66944u + 4u * tid) = 0u;
#pragma unroll
    for (int i = 0; i < 4; ++i) *(LAS u32x4*)(lds + L_HIST + 16u * (tid + 512 * i)) = (u32x4){0u, 0u, 0u, 0u};
    const int pos_q = X.pos[q0 + r], qc = pos_q >> 6;
    float wq[8];
    { const f32x4 wa = *(const f32x4*)(WI + (size_t)(q0 + r) * 8), wb = *(const f32x4*)(WI + (size_t)(q0 + r) * 8 + 4);
      wq[0] = wa[0]; wq[1] = wa[1]; wq[2] = wa[2]; wq[3] = wa[3]; wq[4] = wb[0]; wq[5] = wb[1]; wq[6] = wb[2]; wq[7] = wb[3]; }
    __syncthreads();
    unsigned keys[8][16];
    bf16x8 nka0, nka1; i32x4 npk[4];
#define DSA_PREF(i_) do { const int jt_ = w + 8 * (i_); if ((proc >> (jt_ >> 1)) & 1u) { const size_t kr_ = (size_t)tok0 + jt_ * 32; \
        nka0 = *(const bf16x8*)(KI + (kr_ + r) * 32 + 8 * hh); nka1 = *(const bf16x8*)(KI + (kr_ + r) * 32 + 16 + 8 * hh); \
        _Pragma("unroll") for (int g_ = 0; g_ < 4; ++g_) npk[g_] = *(const i32x4*)(X.pos + kr_ + 8 * g_ + 4 * hh); } } while (0)
    DSA_PREF(0);
#pragma unroll
    for (int i = 0; i < 8; ++i) {
        const int jt = w + 8 * i;
        const bf16x8 ka0 = nka0, ka1 = nka1; i32x4 pk4[4];
#pragma unroll
        for (int g = 0; g < 4; ++g) pk4[g] = npk[g];
        if (i < 7) DSA_PREF(i + 1);
        if ((proc >> (jt >> 1)) & 1u) {
            f32x16 sc;
#pragma unroll
            for (int e = 0; e < 16; ++e) sc[e] = 0.f;
#pragma unroll
            for (int hd = 0; hd < 8; ++hd) {
                f32x16 S;
#pragma unroll
                for (int e = 0; e < 16; ++e) S[e] = 0.f;
                const bf16x8 b0 = *(const LAS bf16x8*)(lds + L_QIT + r * 528 + hh * 16 + hd * 64), b1 = *(const LAS bf16x8*)(lds + L_QIT + r * 528 + hh * 16 + hd * 64 + 32);
                S = MFMA32(ka0, b0, S); S = MFMA32(ka1, b1, S);
#pragma unroll
                for (int e = 0; e < 16; ++e) sc[e] += wq[hd] * __builtin_amdgcn_fmed3f(S[e], 0.f, 3.0e38f);
                asm volatile("" : "+v"(sc));
            }
#pragma unroll
            for (int g = 0; g < 4; ++g) {
#pragma unroll
                for (int e = 0; e < 4; ++e) { const int sidx = jt * 32 + 8 * g + 4 * hh + e; const unsigned u = __float_as_uint(sc[4 * g + e]);
                    const unsigned srt = u ^ ((unsigned)((int)u >> 31) | 0x80000000u);
                    unsigned kk = (srt & 0xFFFFF800u) | (unsigned)(2047 - sidx); kk = ((pk4[g][e] >> 6) <= qc) ? kk : 0u; keys[i][4 * g + e] = kk;
                    __hip_atomic_fetch_add((LAS unsigned*)(lds + L_HIST) + r + (kk >> 24) * 32u, 1u, __ATOMIC_RELAXED, __HIP_MEMORY_SCOPE_WORKGROUP); }
            }
        } else {
#pragma unroll
            for (int e = 0; e < 16; ++e) keys[i][e] = 0u;
        }
        __builtin_amdgcn_sched_barrier(0);
    }
#undef DSA_PREF
    __syncthreads();
    dsa_scan(lds, 0, lane, w);
    __syncthreads();
#pragma unroll 1
    for (int p = 1; p < 4; ++p) {
        if (*(const LAS unsigned*)(lds + 66944u + 4u * (p - 1)) == 0u) break;
        const int shift = 24 - 8 * p;
#pragma unroll
        for (int i = 0; i < 4; ++i) *(LAS u32x4*)(lds + L_HIST + 16u * (tid + 512 * i)) = (u32x4){0u, 0u, 0u, 0u};
        __syncthreads();
        {
            const unsigned pre = *(const LAS unsigned*)(lds + L_PRE + 4u * r), ndq = *(const LAS unsigned*)(lds + L_NEED + 4u * r);
            unsigned P = pre, lim = (ndq == 0u || ndq == 0xFFFFFFFFu) ? 0u : (1u << (shift + 8));
            asm volatile("" : "+v"(P), "+v"(lim));
            LAS unsigned* hq = (LAS unsigned*)(lds + L_HIST) + r;
#pragma unroll
            for (int i = 0; i < 8; ++i) {
                if ((proc >> ((w + 8 * i) >> 1)) & 1u) {
                    unsigned mn = 0xFFFFFFFFu;
#pragma unroll
                    for (int e = 0; e < 16; ++e) { const unsigned x = keys[i][e] ^ P; mn = x < mn ? x : mn; }
                    if (__any(mn < lim)) {
                        unsigned P2 = P; asm volatile("" : "+v"(P2));
#pragma unroll
                        for (int e = 0; e < 16; ++e) { const unsigned x = keys[i][e] ^ P2;
                            if (x < lim) __hip_atomic_fetch_add(hq + ((x >> shift) & 255u) * 32u, 1u, __ATOMIC_RELAXED, __HIP_MEMORY_SCOPE_WORKGROUP); }
                    }
                }
                __builtin_amdgcn_sched_barrier(0);
            }
        }
        __syncthreads();
        dsa_scan(lds, p, lane, w);
        __syncthreads();
    }
    {
        const unsigned nd = *(const LAS unsigned*)(lds + L_NEED + 4u * r), pr = *(const LAS unsigned*)(lds + L_PRE + 4u * r);
        const unsigned T = nd == 0u ? 0u : pr, thr = T > 2048u ? T : 2048u;
#pragma unroll
        for (int i = 0; i < 8; ++i) { const int jt = w + 8 * i; unsigned bits = 0u;
#pragma unroll
            for (int e = 0; e < 16; ++e) bits |= (keys[i][e] >= thr ? 1u : 0u) << e;
            *(LAS unsigned short*)(lds + L_MSK + 2u * ((jt * 2 + hh) * 32 + r)) = (unsigned short)bits; }
    }
    __syncthreads();
    if constexpr (ATTEND) dsa_attend(X, b, qt, X.wid * 64 + lane_id(), proc); else __syncthreads();
}
DI void dsa_attend(const Ctx& X, int b, int qt, int tid, unsigned proc) {
    const int lane = tid & 63, w = X.wid, r = lane & 31, hh = lane >> 5;
    LAS unsigned char* lds = X.lds; const unsigned ldsb = (unsigned)(uintptr_t)lds;
    constexpr unsigned L_MSK = 50176u, L_BT = 58624u, L_KV = 67072u, KVB = 16640u;
    const int tok0 = b * SEQ, q0 = tok0 + qt * 32;
    const bf16_t* QB = wsp<bf16_t>(X, WS_QB); const bf16_t* KB = wsp<bf16_t>(X, WS_KB); const bf16_t* VB = wsp<bf16_t>(X, WS_VB);
    bf16_t* OB = wsp<bf16_t>(X, WS_B) + 512;
    const int* TS = wsp<int>(X, WS_TSTAT) + (size_t)b * 32 * 4;
    const i32x4 tsv = *(const i32x4*)(TS + 4 * (lane & 31));
    const int posmin_q = __builtin_amdgcn_readlane(tsv[2], qt >> 1);
    const unsigned nearm = (unsigned)__ballot(lane < 32 && tsv[3] - posmin_q > -128);
    unsigned procm = proc;
    const int pos_q = X.pos[q0 + r];
    bf16x8 qf[4];
#pragma unroll
    for (int s = 0; s < 4; ++s) qf[s] = *(const bf16x8*)(QB + (size_t)(q0 + r) * 512 + w * 64 + 16 * s + 8 * hh);
    f32x16 o0, o1;
#pragma unroll
    for (int e = 0; e < 16; ++e) { o0[e] = 0.f; o1[e] = 0.f; }
    float mrun = M_FLOOR, lrun = 0.f;
    const int key_a = tid >> 3, ch_a = tid & 7;
    const unsigned kdst = 128u * key_a + 16u * (ch_a ^ ((key_a >> 1) & 7)), vdst = 8192u + 128u * key_a + 16u * (ch_a ^ (((key_a >> 1) & 1) << 2));
    const int q4 = (lane & 15) >> 2, p4 = lane & 3, blk = (lane >> 4) & 1, sw = (q4 >> 1) & 1;
    const unsigned vbase = ldsb + L_KV + 8192u + 128u * (4 * hh + q4) + 16u * (2 * blk + (p4 >> 1)) + 8u * (p4 & 1);
    const unsigned va0 = vbase + 64u * sw, va1 = vbase + 64u * (1 - sw);
    u32x4 rk, rv; int rp = 0;
#define DSA_LOAD(j) do { const size_t t0_ = (size_t)tok0 + (size_t)(j) * 64; rk = *(const u32x4*)(KB + (t0_ + key_a) * 64 + ch_a * 8); rv = *(const u32x4*)(VB + (t0_ + key_a) * 64 + ch_a * 8); \
        if (tid < 64) rp = X.pos[t0_ + tid]; } while (0)
#define DSA_STORE(bo) do { *(LAS u32x4*)(lds + L_KV + (bo) + kdst) = rk; *(LAS u32x4*)(lds + L_KV + (bo) + vdst) = rv; if (tid < 64) *(LAS int*)(lds + L_KV + (bo) + 16384u + 4u * tid) = rp; } while (0)
    asm volatile("" :: "v"(qf[0]), "v"(qf[1]), "v"(qf[2]), "v"(qf[3]), "v"(pos_q));
    int j = procm ? __builtin_ctz(procm) : 32; procm &= procm - 1u;
    unsigned cur = 0;
    if (j < 32) { DSA_LOAD(j); DSA_STORE(0u); }
    __syncthreads();
    f32x16 s0, s1; bf16x8 pf[4];
#define DSA_QK(bo_, j_) do { const float nm = -mrun; \
        const unsigned m0 = *(const LAS unsigned short*)(lds + L_MSK + 2u * (((2 * (j_)) * 2 + hh) * 32 + r)), m1 = *(const LAS unsigned short*)(lds + L_MSK + 2u * (((2 * (j_) + 1) * 2 + hh) * 32 + r)); \
        if ((nearm >> (j_)) & 1u) { _Pragma("unroll") for (int g = 0; g < 4; ++g) { \
                const i32x4 c0 = *(const LAS i32x4*)(lds + L_KV + (bo_) + 16384u + 4u * (8 * g + 4 * hh)), c1 = *(const LAS i32x4*)(lds + L_KV + (bo_) + 16384u + 4u * (32 + 8 * g + 4 * hh)); \
                _Pragma("unroll") for (int e = 0; e < 4; ++e) { \
                    int d0 = c0[e] - pos_q, d1 = c1[e] - pos_q; d0 = d0 < -128 ? -128 : (d0 > 128 ? 128 : d0); d1 = d1 < -128 ? -128 : (d1 > 128 ? 128 : d1); \
                    const float b0 = *(const LAS float*)(lds + L_BT + 4u * (w * 260 + d0 + 128)) + nm, b1 = *(const LAS float*)(lds + L_BT + 4u * (w * 260 + d1 + 128)) + nm; \
                    s0[4 * g + e] = ((m0 >> (4 * g + e)) & 1u) ? b0 : NEGF; s1[4 * g + e] = ((m1 >> (4 * g + e)) & 1u) ? b1 : NEGF; } } } \
        else { _Pragma("unroll") for (int e = 0; e < 16; ++e) { s0[e] = ((m0 >> e) & 1u) ? nm : NEGF; s1[e] = ((m1 >> e) & 1u) ? nm : NEGF; } } \
        _Pragma("unroll") for (int ks = 0; ks < 4; ++ks) { const unsigned ko = 128u * r + 16u * ((2 * ks + hh) ^ ((r >> 1) & 7)); \
            const bf16x8 a0 = *(const LAS bf16x8*)(lds + L_KV + (bo_) + ko), a1 = *(const LAS bf16x8*)(lds + L_KV + (bo_) + ko + 128u * 32u); \
            s0 = MFMA32(a0, qf[ks], s0); s1 = MFMA32(a1, qf[ks], s1); } } while (0)
#define DSA_PV(bo_) do { TrRegs TA, TB; tr_issue8(va0 + (bo_), TA); tr_issue8(va1 + (bo_), TB); tr_wait(TA, TB); bf16x8 vf[4]; tr_frags(TA, vf); \
        _Pragma("unroll") for (int k = 0; k < 4; ++k) o0 = MFMA32(vf[k], pf[k], o0); tr_frags(TB, vf); \
        _Pragma("unroll") for (int k = 0; k < 4; ++k) o1 = MFMA32(vf[k], pf[k], o1); } while (0)
    if (w < 4) {
        while (j < 32) {
            const int jn = procm ? __builtin_ctz(procm) : 32; procm &= procm - 1u;
            if (jn < 32) DSA_LOAD(jn);
            const unsigned bo = cur * KVB;
            DSA_QK(bo, j);
            softmax_tile(s0, s1, mrun, lrun, o0, o1, pf);
            DSA_PV(bo);
            cur = cur == 2u ? 0u : cur + 1u;
            if (jn < 32) DSA_STORE(cur * KVB);
            __syncthreads();
            j = jn;
        }
    } else {
        bool have = false; unsigned pbo = 0u;
        while (j < 32) {
            const int jn = procm ? __builtin_ctz(procm) : 32; procm &= procm - 1u;
            if (jn < 32) DSA_LOAD(jn);
            const unsigned bo = cur * KVB;
            if (have) DSA_PV(pbo);
            DSA_QK(bo, j);
            softmax_tile(s0, s1, mrun, lrun, o0, o1, pf);
            pbo = bo; have = true;
            cur = cur == 2u ? 0u : cur + 1u;
            if (jn < 32) DSA_STORE(cur * KVB);
            __syncthreads();
            j = jn;
        }
        if (have) DSA_PV(pbo);
    }
#undef DSA_QK
#undef DSA_PV
#undef DSA_LOAD
#undef DSA_STORE
    const float inv = 1.f / (lrun + __shfl_xor(lrun, 32));
    bf16_t* op = OB + (size_t)(q0 + r) * 1024 + w * 64 + 4 * hh;
#pragma unroll
    for (int g = 0; g < 4; ++g) {
        u32x2 a, c; a.x = pk2(o0[4 * g] * inv, o0[4 * g + 1] * inv); a.y = pk2(o0[4 * g + 2] * inv, o0[4 * g + 3] * inv);
        c.x = pk2(o1[4 * g] * inv, o1[4 * g + 1] * inv); c.y = pk2(o1[4 * g + 2] * inv, o1[4 * g + 3] * inv);
        *(u32x2*)(op + 8 * g) = a; *(u32x2*)(op + 32 + 8 * g) = c;
    }
    __syncthreads();
}

constexpr int N_PHASES = 10;
template <int PHM>
__global__ void __launch_bounds__(512, 2) fwd_kernel(Args args) {
    extern __shared__ __attribute__((aligned(16))) unsigned char lds_raw[];
    Ctx X;
    X.x = (const float*)args.in[0]; X.pos = (const int*)args.in[1]; X.ln0_g = (const float*)args.in[2]; X.ln0_b = (const float*)args.in[3]; X.w_in = (const float*)args.in[4];
    X.q_norm_g = (const float*)args.in[5]; X.w_uq = (const float*)args.in[6]; X.kv_norm_g = (const float*)args.in[7]; X.w_uk = (const float*)args.in[8]; X.w_uv = (const float*)args.in[9];
    X.rel_bias = (const float*)args.in[10]; X.w_up_a = (const float*)args.in[11]; X.w_up_b = (const float*)args.in[12]; X.w_gate = (const float*)args.in[13]; X.b_gate = (const float*)args.in[14];
    X.w_o = (const float*)args.in[15]; X.ln1_g = (const float*)args.in[16]; X.ln1_b = (const float*)args.in[17]; X.w_grp = (const float*)args.in[18]; X.b_grp = (const float*)args.in[19];
    X.w_rt = (const float*)args.in[20]; X.b_rt = (const float*)args.in[21]; X.w_eg = (const float*)args.in[22]; X.w_eu = (const float*)args.in[23]; X.w_ed = (const float*)args.in[24];
    X.ln2_g = (const float*)args.in[25]; X.ln2_b = (const float*)args.in[26];
    X.out = args.out; X.ws = args.ws; X.lds = (LAS unsigned char*)lds_raw; X.G = gridDim.x; X.bid = blockIdx.x; X.wid = __builtin_amdgcn_readfirstlane((int)(threadIdx.x >> 6));
    if (threadIdx.x < 16) ((LAS unsigned*)(X.lds + LDS_MISC))[threadIdx.x] = 0u;
    __syncthreads();
    const int lo = args.ph_lo, hi = args.ph_hi;
    XcdBarrier bar; bar.bar = wsp<unsigned>(X, WS_CTL) + CW_BAR; bar.x = 0; bar.st = nullptr;
    if (hi - lo > 1) bar = xcd_barrier_post(wsp<unsigned>(X, WS_CTL) + CW_BAR, (volatile LAS unsigned*)(X.lds + LDS_MISC));
#define IN(k) (((PHM >> (k)) & 1) && lo <= (k) && (k) < hi)
#define SEAM(k) do { if (IN(k) && IN((k) + 1)) xcd_barrier(bar); } while (0)

    if (IN(0)) { p0_prologue(X); }
    SEAM(0);
    if (IN(1)) {
        pg8::Gemm g{wsp<bf16_t>(X, WS_B), wsp<bf16_t>(X, WS_WT1), 1024}; pg8::StaticOrder S; S.init(M, NW1, X.G, X.bid);
        Epi1 E{wsp<bf16_t>(X, WS_CQ), wsp<bf16_t>(X, WS_CKV), wsp<bf16_t>(X, WS_KR), wsp<bf16_t>(X, WS_KI), wsp<bf16_t>(X, WS_KB), wsp<bf16_t>(X, WS_VB), wsp<bf16_t>(X, WS_QB), wsp<bf16_t>(X, WS_QI),
               wsp<bf16_t>(X, WS_A), wsp<float>(X, WS_WI), wsp<float>(X, WS_SSQ), wsp<float>(X, WS_ROPE), X.b_gate};
        pg8::gemm_phase<Epi1, pg8::StaticOrder, true, false>(X.lds, g, S, E, X.wid);
    }
    SEAM(1);
    if (IN(2)) {
        { pg8::Gemm g{wsp<bf16_t>(X, WS_CKV), wsp<bf16_t>(X, WS_WUKVT), 128}; pg8::StaticOrder S; S.init(M, 1024, X.G, X.bid);
          Epi3 E{wsp<bf16_t>(X, WS_KN), wsp<bf16_t>(X, WS_VM), wsp<float>(X, WS_SSQ)};
          pg8::gemm_phase<Epi3, pg8::StaticOrder, true, false>(X.lds, g, S, E, X.wid); }
        { pg8::Gemm g{wsp<bf16_t>(X, WS_CQ), wsp<bf16_t>(X, WS_WUQT), 256}; pg8::StaticOrder S; S.init(M, 768, X.G, X.bid);
          Epi2 E{wsp<bf16_t>(X, WS_QM), wsp<float>(X, WS_SSQ), wsp<float>(X, WS_ROPE)};
          pg8::gemm_phase<Epi2, pg8::StaticOrder, true, false>(X.lds, g, S, E, X.wid); }
    }
    SEAM(2);
    if (IN(3)) {
        for (int i = 0;; ++i) { const long L = (long)i * X.G + X.bid; if (L >= 1024) break; const int c = (int)(L & 255), ii = (int)(L >> 8);
            const int bh = c >> 1; const int tab[2][4] = {{7, 0, 5, 2}, {6, 1, 4, 3}}; int qb = tab[0][0];
#pragma unroll
            for (int a = 0; a < 2; ++a)
#pragma unroll
                for (int t = 0; t < 4; ++t) if (a == (c & 1) && t == ii) qb = tab[a][t];
            mla_unit(X, bh >> 3, bh & 7, qb);
        }
        for (int i = 0;; ++i) { const long L = (long)i * X.G + X.bid; if (L >= 1024) break; const int c = (int)(L & 255), ii = (int)(L >> 8);
            const int b = c >> 4, idx = c & 15; const int qt = ii == 0 ? 63 - idx : (ii == 1 ? idx : (ii == 2 ? 47 - idx : 16 + idx));
            dsa_unit<true>(X, b, qt);
        }
    }
    SEAM(3);
    if (IN(4)) {
        pg8::Gemm g{wsp<bf16_t>(X, WS_B), wsp<bf16_t>(X, WS_WUPT), 1024}; pg8::StaticOrder S; S.init(M, 1024, X.G, X.bid);
        Epi4 E{wsp<bf16_t>(X, WS_MIXPRE), wsp<bf16_t>(X, WS_A)};
        pg8::gemm_phase<Epi4, pg8::StaticOrder, true, false>(X.lds, g, S, E, X.wid);
    }
    SEAM(4);
    if (IN(5)) {
        pg8::Gemm g{wsp<bf16_t>(X, WS_MIXPRE), wsp<bf16_t>(X, WS_WOT), 1024}; pg8::StaticOrder S; S.init(M, 1024, X.G, X.bid);
        Epi5 E{wsp<float>(X, WS_A), X.x, wsp<float>(X, WS_STATS0), X.ln0_g, X.ln0_b};
        pg8::gemm_phase<Epi5, pg8::StaticOrder, true, false>(X.lds, g, S, E, X.wid);
    }
    SEAM(5);
    if (IN(6)) { p6_ln1_router(X); }
    SEAM(6);
    if (IN(7)) {
        moe_prep(X);
        const LAS int* tstart = (const LAS int*)(X.lds + LDS_MISC + 64); const LAS int* scnt = (const LAS int*)(X.lds + LDS_MISC + 512);
        pg8::Gemm g{wsp<bf16_t>(X, WS_B), wsp<bf16_t>(X, WS_WEGUT), 1024}; MoeOrder S{tstart, scnt, wsp<int>(X, WS_LIST), 2048, 2, X.G, X.bid, __builtin_amdgcn_readfirstlane(tstart[NSEG])};
        Epi7 E{wsp<bf16_t>(X, WS_HID), wsp<float>(X, WS_LISTW), scnt};
        pg8::gemm_phase<Epi7, MoeOrder, true, true>(X.lds, g, S, E, X.wid);
    }
    SEAM(7);
    if (IN(8)) {
        moe_prep(X);
        const LAS int* tstart = (const LAS int*)(X.lds + LDS_MISC + 64); const LAS int* scnt = (const LAS int*)(X.lds + LDS_MISC + 512);
        pg8::Gemm g{wsp<bf16_t>(X, WS_HID), wsp<bf16_t>(X, WS_WEDT), 256}; MoeOrder S{tstart, scnt, wsp<int>(X, WS_LIST), 0, 4, X.G, X.bid, __builtin_amdgcn_readfirstlane(tstart[NSEG])};
        Epi8 E{wsp<bf16_t>(X, WS_C), wsp<int>(X, WS_LIST), scnt};
        pg8::gemm_phase<Epi8, MoeOrder, true, false>(X.lds, g, S, E, X.wid);
    }
    SEAM(8);
    if (IN(9)) { p9_ln2(X); }
#undef IN
#undef SEAM
}

#ifndef PH_MASK
#define PH_MASK 0x3ff
#endif
template <int PHM> static bool setup_kernel(int& per_cu) {
    if (hipFuncSetAttribute((const void*)fwd_kernel<PHM>, hipFuncAttributeMaxDynamicSharedMemorySize, LDS_BYTES) != hipSuccess) return false;
    if (hipOccupancyMaxActiveBlocksPerMultiprocessor(&per_cu, (const void*)fwd_kernel<PHM>, 512, LDS_BYTES) != hipSuccess) per_cu = 0;
    (void)hipGetLastError(); return true;
}
template <int P> static void launch_phase(int grid, hipStream_t stream, Args a) {
    if (!((PH_MASK >> P) & 1)) return;
    a.ph_lo = P; a.ph_hi = P + 1;
    hipLaunchKernelGGL(fwd_kernel<(1 << P)>, dim3(grid), dim3(512), LDS_BYTES, stream, a);
}
extern "C" void kernel_launch(void* const* d_in, const int* in_sizes, int n_in, void* d_out, int out_size, void* d_ws, size_t ws_size, hipStream_t stream) {
    static int grid = 0;
    if (grid == 0) {
        if (n_in != 27 || in_sizes[0] != M * D || out_size != M * D || ws_size < WS_END) { fprintf(stderr, "kernel_launch: unexpected shapes (n_in %d, ws %zu); nothing launched\n", n_in, ws_size); grid = -1; return; }
        int dev = 0, cus = 0, per_cu = 0; bool ok = true;
        if (hipGetDevice(&dev) != hipSuccess || hipDeviceGetAttribute(&cus, hipDeviceAttributeMultiprocessorCount, dev) != hipSuccess) { grid = -1; return; }
#if N_LAUNCH_MODE == 1
        ok = setup_kernel<PH_MASK>(per_cu);
#else
        ok = setup_kernel<1>(per_cu) && setup_kernel<2>(per_cu) && setup_kernel<4>(per_cu) && setup_kernel<8>(per_cu) && setup_kernel<16>(per_cu) && setup_kernel<32>(per_cu) &&
             setup_kernel<64>(per_cu) && setup_kernel<128>(per_cu) && setup_kernel<256>(per_cu) && setup_kernel<512>(per_cu);
#endif
        if (!ok) { fprintf(stderr, "kernel_launch: hipFuncSetAttribute failed\n"); grid = -1; return; }
        if (per_cu < 1) fprintf(stderr, "kernel_launch: occupancy query says %d\n", per_cu);
        grid = cus;
    }
    if (grid < 0) return;
    if (hipMemsetAsync((char*)d_ws + WS_CTL, 0, CTL_ZERO_BYTES, stream) != hipSuccess) return;
    Args a{};
    for (int i = 0; i < 27; ++i) a.in[i] = d_in[i];
    a.out = (float*)d_out; a.ws = (unsigned char*)d_ws;
#if N_LAUNCH_MODE == 1
    a.ph_lo = 0; a.ph_hi = N_PHASES;
    hipLaunchKernelGGL(fwd_kernel<PH_MASK>, dim3(grid), dim3(512), LDS_BYTES, stream, a);
#else
    launch_phase<0>(grid, stream, a);
    launch_phase<1>(grid, stream, a); launch_phase<2>(grid, stream, a); launch_phase<3>(grid, stream, a); launch_phase<4>(grid, stream, a); launch_phase<5>(grid, stream, a);
    launch_phase<6>(grid, stream, a); launch_phase<7>(grid, stream, a); launch_phase<8>(grid, stream, a); launch_phase<9>(grid, stream, a);
#endif
}
```

```cpp
#include <hip/hip_runtime.h>
#include <cstdio>
#include <cstdint>

#ifndef N_LAUNCH_MODE
#define N_LAUNCH_MODE 1
#endif

#define LAS __attribute__((address_space(3)))
#define GAS __attribute__((address_space(1)))
typedef unsigned short bf16_t;
typedef short bf16x8 __attribute__((ext_vector_type(8)));
typedef short s16x4 __attribute__((ext_vector_type(4)));
typedef float f32x2 __attribute__((ext_vector_type(2)));
typedef float f32x4 __attribute__((ext_vector_type(4)));
typedef float f32x16 __attribute__((ext_vector_type(16)));
typedef unsigned u32x2 __attribute__((ext_vector_type(2)));
typedef unsigned u32x4 __attribute__((ext_vector_type(4)));
typedef int i32x4 __attribute__((ext_vector_type(4)));
typedef __bf16 bf16x2_t __attribute__((ext_vector_type(2)));
#define DI __device__ __forceinline__

constexpr int BATCH = 16, SEQ = 2048, D = 1024, M = BATCH * SEQ;
constexpr int NW1 = 3584;
constexpr int NSEG = 64;
constexpr int MAXTILES = 320;
constexpr float LN_EPS = 1e-5f, RMS_EPS = 1e-6f;
constexpr float ALPHA = 1.189207115002721f;
constexpr float LOG2E = 1.4426950408889634f;
constexpr float NEGF = -1e30f;

constexpr size_t MiB = 1u << 20;
constexpr size_t WS_CTL = 0, CTL_ZERO_BYTES = 1 * MiB;
constexpr size_t WS_WT1 = 1 * MiB;
constexpr size_t WS_WUQT = 8 * MiB;
constexpr size_t WS_WUKVT = WS_WUQT + 768 * 256 * 2;
constexpr size_t WS_WRT = WS_WUKVT + 1024 * 128 * 2;
constexpr size_t WS_WUPT = 9 * MiB;
constexpr size_t WS_WOT = 11 * MiB;
constexpr size_t WS_WEGUT = 13 * MiB;
constexpr size_t WS_WEDT = 45 * MiB;
constexpr size_t WS_STATS0 = 61 * MiB;
constexpr size_t WS_SSQ = WS_STATS0 + (size_t)M * 8;
constexpr size_t WS_TSTAT = WS_SSQ + (size_t)M * 32;
constexpr size_t WS_STATS1 = WS_TSTAT + 8192;
constexpr size_t WS_A = 64 * MiB;
constexpr size_t WS_B = 192 * MiB;
constexpr size_t WS_C = 256 * MiB;
constexpr size_t WS_Dr = 384 * MiB;
constexpr size_t WS_END = 512 * MiB;
constexpr size_t WS_QB = WS_C, WS_QI = WS_QB + 32 * MiB, WS_CQ = WS_QI + 16 * MiB, WS_CKV = WS_CQ + 16 * MiB, WS_KB = WS_CKV + 8 * MiB, WS_VB = WS_KB + 4 * MiB,
                 WS_KR = WS_VB + 4 * MiB, WS_KI = WS_KR + 2 * MiB, WS_WI = WS_KI + 2 * MiB;
constexpr size_t WS_QM = WS_Dr, WS_KN = WS_QM + 48 * MiB, WS_VM = WS_KN + 32 * MiB;
constexpr size_t WS_MIXPRE = WS_Dr;
constexpr size_t WS_HID = WS_Dr + 64 * MiB;
constexpr size_t WS_LIST = WS_Dr + 104 * MiB;
constexpr size_t WS_LISTW = WS_Dr + 112 * MiB;
constexpr size_t WS_ROPE = WS_Dr + 120 * MiB;
constexpr int CW_BAR = 4096;
constexpr int CW_CNT = 16384;

DI unsigned pk2(float lo, float hi) { f32x2 v = {lo, hi}; bf16x2_t r = __builtin_convertvector(v, bf16x2_t); return __builtin_bit_cast(unsigned, r); }
DI float bf2f(unsigned short b) { return __uint_as_float((unsigned)b << 16); }
DI float wave_sum(float v) {
#pragma unroll
    for (int o = 1; o < 64; o <<= 1) v += __shfl_xor(v, o);
    return v;
}
DI int wave_min_i(int v) {
#pragma unroll
    for (int o = 1; o < 64; o <<= 1) { const int t = __shfl_xor(v, o); v = t < v ? t : v; }
    return v;
}
DI int wave_max_i(int v) {
#pragma unroll
    for (int o = 1; o < 64; o <<= 1) { const int t = __shfl_xor(v, o); v = t > v ? t : v; }
    return v;
}
DI int lane_id() { int l; asm volatile("v_mbcnt_lo_u32_b32 %0, -1, 0\n\tv_mbcnt_hi_u32_b32 %0, -1, %0" : "=v"(l)); return l; }
DI float fast_exp2(float x) { return __builtin_amdgcn_exp2f(x); }
DI float fast_rcp(float x) { return __builtin_amdgcn_rcpf(x); }
DI float sigmoidf_fast(float v) { return fast_rcp(1.0f + fast_exp2(-v * LOG2E)); }
DI void rope_sincos(int pos, int j, float& sn, float& cs) {
    const double invd[16] = {1.0, 0.5623413251903491, 0.31622776601683794, 0.1778279410038923, 0.1, 0.05623413251903491, 0.03162277660168379, 0.01778279410038923,
                             0.01, 0.005623413251903491, 0.0031622776601683794, 0.001778279410038923, 0.001, 0.0005623413251903491, 0.00031622776601683794, 0.0001778279410038923};
    double inv = invd[0];
#pragma unroll
    for (int t = 1; t < 16; ++t) inv = (j == t) ? invd[t] : inv;
    const double rev = (double)pos * (double)(float)inv * 0.15915494309189535;
    const float fr = (float)(rev - __builtin_floor(rev));
    sn = __builtin_amdgcn_sinf(fr); cs = __builtin_amdgcn_cosf(fr);
}

#define XB_TMO      128
#define XB_XCNT(j)  (256  + 64 * (j))
#define XB_XSUB(j)  (1280 + 64 * (j))
#define XB_XGEN(j)  (2304 + 64 * (j))
#define XB_TOP      3328
#define XB_TOPGEN   3392
#define XCD_BAR_WORDS 3456
#define XB_SPIN_CAP (1u << 18)
DI unsigned xb_ld(unsigned* p)              { return __hip_atomic_load(p, __ATOMIC_RELAXED, __HIP_MEMORY_SCOPE_AGENT); }
DI unsigned xb_add(unsigned* p, unsigned v) { return __hip_atomic_fetch_add(p, v, __ATOMIC_RELAXED, __HIP_MEMORY_SCOPE_AGENT); }
DI unsigned xb_xcc_id() { return (unsigned)__builtin_amdgcn_s_getreg((3 << 11) | 20) & 0xFu; }
#define XB_SPIN(cond, bar) do { unsigned _sp = 0; while (cond) { __builtin_amdgcn_s_sleep(1); \
    if ((++_sp & 255u) == 0u) { if (xb_ld(&(bar)[XB_TMO])) break; if (_sp > XB_SPIN_CAP) { atomicAdd(&(bar)[XB_TMO], 1u); break; } } } } while (0)
struct XcdBarrier { unsigned* bar; unsigned x; volatile LAS unsigned* st; };
DI XcdBarrier xcd_barrier_post(unsigned* bar, volatile LAS unsigned* st) {
    XcdBarrier b; b.bar = bar; b.x = xb_xcc_id(); b.st = st;
    if (threadIdx.x == 0) (void)xb_add(&bar[XB_XCNT(b.x)], 1u);
    return b;
}
DI void xcd_barrier_complete(unsigned* bar, unsigned x, unsigned& nloc, unsigned& nx) {
    const unsigned G = gridDim.x * gridDim.y * gridDim.z;
    unsigned sum, cnt, mine, sp = 0u;
    for (;;) {
        sum = 0u; cnt = 0u; mine = 0u;
#pragma unroll
        for (unsigned j = 0; j < 16; ++j) { const unsigned c = xb_ld(&bar[XB_XCNT(j)]); sum += c; cnt += (c > 0u) ? 1u : 0u; mine = (j == x) ? c : mine; }
        if (sum == G) break;
        __builtin_amdgcn_s_sleep(1);
        if ((++sp & 255u) == 0u) { if (xb_ld(&bar[XB_TMO])) break; if (sp > XB_SPIN_CAP) { atomicAdd(&bar[XB_TMO], 1u); break; } }
    }
    nloc = mine > 0u ? mine : 1u; nx = cnt > 0u ? cnt : 1u;
}
DI void xcd_barrier(const XcdBarrier& b) {
    asm volatile("s_waitcnt vmcnt(0)" ::: "memory");
    __syncthreads();
    if (threadIdx.x == 0) {
        unsigned* bar = b.bar;
        __builtin_amdgcn_s_waitcnt(0);
        unsigned nloc = b.st[0], nx = b.st[1];
        if (nloc == 0u) { xcd_barrier_complete(bar, b.x, nloc, nx); b.st[0] = nloc; b.st[1] = nx; }
        const unsigned old = xb_add(&bar[XB_XSUB(b.x)], 1u);
        const unsigned gen = old / nloc;
        if (old + 1u == (gen + 1u) * nloc) {
            __builtin_amdgcn_fence(__ATOMIC_RELEASE, "agent");
            asm volatile("s_waitcnt vmcnt(0)" ::: "memory");
            const unsigned og = xb_add(&bar[XB_TOP], 1u);
            const unsigned tg = og / nx;
            if (og + 1u == (tg + 1u) * nx) xb_add(&bar[XB_TOPGEN], 1u);
            else XB_SPIN(xb_ld(&bar[XB_TOPGEN]) == tg, bar);
            __builtin_amdgcn_fence(__ATOMIC_ACQUIRE, "agent");
            xb_add(&bar[XB_XGEN(b.x)], 1u);
            asm volatile("s_waitcnt vmcnt(0)" ::: "memory");
        } else {
            XB_SPIN(xb_ld(&bar[XB_XGEN(b.x)]) == gen, bar);
            __builtin_amdgcn_fence(__ATOMIC_ACQUIRE, "agent");
            asm volatile("s_waitcnt vmcnt(0)" ::: "memory");
        }
    }
    __syncthreads();
}

namespace pg8 {
constexpr int BM = 256, BK = 64, HALF = 128, HTB = HALF * BK * 2, STAGE_BYTES = 8 * HTB, NXCD = 8, WGM = 8;
__host__ __device__ __forceinline__ int lds_byte(int r, int c) { const int st = (r >> 4) * 2 + (c >> 5), rr = r & 15, cc = c & 31, ob = rr * 64 + cc * 2; return st * 1024 + (ob ^ (((ob >> 9) & 1) << 5)); }
__host__ __device__ __forceinline__ void stage_rc(int b, int& R, int& C) { const int st = b / 1024, sb = b % 1024, swz = sb ^ (((sb >> 9) & 1) << 5); R = (st >> 1) * 16 + swz / 64; C = (st & 1) * 32 + (swz % 64) / 2; }
__host__ __device__ __forceinline__ int perm32(int rho) { const int n = rho >> 4, i = rho & 15; return 8 * (i >> 2) + 4 * n + (i & 3); }
struct Unit { int pm, pn, a0, a1; };
struct Gemm { const bf16_t* A; const bf16_t* Bt; int K; };

DI void tile_of(int L, int nM, int nN, int& pm, int& pn) {
    const int nwg = nM * nN; int wgid = L;
    { const int q = nwg / NXCD, r = nwg % NXCD, xcd = wgid % NXCD, off = wgid / NXCD; wgid = (xcd < r ? xcd * (q + 1) : r * (q + 1) + (xcd - r) * q) + off; }
    const int nig = WGM * nN, gid = wgid / nig, fm = gid * WGM, gsz = (nM - fm) < WGM ? (nM - fm) : WGM;
    pm = fm + ((wgid % nig) % gsz); pn = (wgid % nig) / gsz;
}
struct StaticOrder {
    int nM, nN, nwg, G, c;
    DI void init(int Mrows, int N, int G_, int c_) { nM = Mrows / BM; nN = N / BM; nwg = nM * nN; G = G_; c = c_; }
    DI bool next(int i, Unit& u) const {
        const long L = (long)i * G + c; if (L >= nwg) return false;
        tile_of((int)L, nM, nN, u.pm, u.pn); u.a0 = 0; u.a1 = 0; return true;
    }
    DI unsigned arow(const Unit&, int) const { return 0u; }
};

template <class Epi, class Sched, bool ALIGN_EPI, bool GATHER>
DI void gemm_phase(LAS unsigned char* lds, const Gemm g, const Sched& S, const Epi& E, int wid) {
    const int lane = lane_id(), tid = wid * 64 + lane, wr = wid >> 2, wc = wid & 3, fr = lane & 15, fq = lane >> 4;
    int K = g.K; asm volatile("" : "+s"(K));
    const int nt = K / BK;
    unsigned voffA[2], voffB[2]; int RA[2];
#pragma unroll
    for (int i = 0; i < 2; ++i) { int R, C; stage_rc(tid * 16 + i * 8192, R, C); const int Rb = Epi::PERM ? ((R & ~31) + perm32(R & 31)) : R;
        voffA[i] = GATHER ? (unsigned)(C * 2) : (unsigned)(R * K + C) * 2u; voffB[i] = (unsigned)(Rb * K + C) * 2u; RA[i] = R; }
    const size_t kstep = (size_t)(BK * 2);
    const size_t hstep = (size_t)HALF * K * 2;
    const size_t tstep = 2 * hstep;
    const unsigned ldsw = (unsigned)wid * 1024u;
    const int aoff = lds_byte(wr * 64 + fr, fq * 8), boff = lds_byte(wc * 32 + fr, fq * 8);
#define PG8_SA(b, h) (((b) * 2 + (h)) * HTB)
#define PG8_SB(b, h) ((4 + (b) * 2 + (h)) * HTB)
#define PG8_STAGE(bufoff, gbase, voff) do { _Pragma("unroll") for (int _i = 0; _i < 2; ++_i) \
        __builtin_amdgcn_global_load_lds((const unsigned*)((const char*)(gbase) + (voff)[_i]), (LAS unsigned*)(lds + (bufoff) + ldsw + _i * 8192), 16, 0, 0); } while (0)
#define PG8_STAGE_A(bufoff, plainptr, hh, kptr, go) do { if constexpr (GATHER) { _Pragma("unroll") for (int _i = 0; _i < 2; ++_i) \
        __builtin_amdgcn_global_load_lds((const unsigned*)((kptr) + (go)[hh][_i]), (LAS unsigned*)(lds + (bufoff) + ldsw + _i * 8192), 16, 0, 0); } \
        else { PG8_STAGE(bufoff, (plainptr) + (hh) * hstep, voffA); } } while (0)
#define PG8_LDA(dst, b, h) do { _Pragma("unroll") for (int m = 0; m < 4; ++m) _Pragma("unroll") for (int k = 0; k < 2; ++k) dst[m][k] = *(const LAS bf16x8*)(lds + PG8_SA(b, h) + aoff + m * 2048 + k * 1024); } while (0)
#define PG8_LDB(dst, b, h) do { _Pragma("unroll") for (int n = 0; n < 2; ++n) _Pragma("unroll") for (int k = 0; k < 2; ++k) dst[n][k] = *(const LAS bf16x8*)(lds + PG8_SB(b, h) + boff + n * 2048 + k * 1024); } while (0)
#define PG8_MMA(ai, bj, At, Bt) do { __builtin_amdgcn_s_setprio(1); _Pragma("unroll") for (int m = 0; m < 4; ++m) _Pragma("unroll") for (int n = 0; n < 2; ++n) _Pragma("unroll") for (int k = 0; k < 2; ++k) \
        acc[ai][bj][m][n] = __builtin_amdgcn_mfma_f32_16x16x32_bf16(Bt[n][k], At[m][k], acc[ai][bj][m][n], 0, 0, 0); __builtin_amdgcn_s_setprio(0); } while (0)
#define PG8_WAIT_V(n) asm volatile("s_waitcnt vmcnt(" #n ")" ::: "memory")
#define PG8_WAIT_L(n) asm volatile("s_waitcnt lgkmcnt(" #n ")" ::: "memory")
#define PG8_BAR __builtin_amdgcn_s_barrier()
#define PG8_SCHED __builtin_amdgcn_sched_barrier(0)
    Unit cur, nxt; int ui = 0;
    if (!S.next(0, cur)) return;
    f32x4 acc[2][2][4][2];
#pragma unroll
    for (int a = 0; a < 2; ++a)
#pragma unroll
        for (int b = 0; b < 2; ++b)
#pragma unroll
            for (int m = 0; m < 4; ++m)
#pragma unroll
                for (int n = 0; n < 2; ++n) acc[a][b][m][n] = (f32x4){0.f, 0.f, 0.f, 0.f};
    bf16x8 At[4][2], B0[2][2], B1[2][2];
    const char* A0 = (const char*)g.A;
    const char* cA = A0 + (GATHER ? (size_t)0 : (size_t)cur.pm * tstep); const char* cB = (const char*)g.Bt + (size_t)cur.pn * tstep;
    unsigned gc[2][2], gn[2][2];
#pragma unroll
    for (int hh = 0; hh < 2; ++hh)
#pragma unroll
        for (int i = 0; i < 2; ++i) { gc[hh][i] = GATHER ? S.arow(cur, hh * HALF + RA[i]) + voffA[i] : 0u; gn[hh][i] = gc[hh][i]; }
    PG8_STAGE(PG8_SB(0, 0), cB, voffB); PG8_STAGE(PG8_SB(0, 1), cB + hstep, voffB); PG8_STAGE_A(PG8_SA(0, 0), cA, 0, A0, gc); PG8_STAGE_A(PG8_SA(0, 1), cA, 1, A0, gc);
    if (wr == 1) PG8_BAR;
    PG8_WAIT_V(2); PG8_BAR;
    PG8_STAGE(PG8_SB(1, 0), cB + kstep, voffB); PG8_STAGE_A(PG8_SA(1, 0), cA + kstep, 0, A0 + kstep, gc); PG8_STAGE(PG8_SB(1, 1), cB + hstep + kstep, voffB);
    PG8_WAIT_V(6); PG8_BAR;
    for (;;) {
        const bool has_next = S.next(ui + 1, nxt);
        const char* nA = has_next ? A0 + (GATHER ? (size_t)0 : (size_t)nxt.pm * tstep) : cA; const char* nB = has_next ? (const char*)g.Bt + (size_t)nxt.pn * tstep : cB;
        if constexpr (GATHER) {
#pragma unroll
            for (int hh = 0; hh < 2; ++hh)
#pragma unroll
                for (int i = 0; i < 2; ++i) gn[hh][i] = has_next ? S.arow(nxt, hh * HALF + RA[i]) + voffA[i] : gc[hh][i];
        }
        for (int t = 0; t < nt; t += 2) {
            if constexpr (Epi::MID) { if (t == (nt >> 1)) { const int l2 = lane_id(); E.mid(acc, cur, wr, wc, l2 & 15, l2 >> 4); } }
            const bool last = (t == nt - 2);
            const char* a1 = cA + (size_t)(t + 1) * kstep;
            const char* a2 = last ? nA : cA + (size_t)(t + 2) * kstep; const char* b2 = last ? nB : cB + (size_t)(t + 2) * kstep;
            const char* a3 = a2 + kstep; const char* b3 = b2 + kstep;
            const char* k1 = A0 + (size_t)(t + 1) * kstep; const char* k2 = A0 + (last ? (size_t)0 : (size_t)(t + 2) * kstep); const char* k3 = k2 + kstep;
            unsigned g2[2][2];
#pragma unroll
            for (int hh = 0; hh < 2; ++hh)
#pragma unroll
                for (int i = 0; i < 2; ++i) g2[hh][i] = last ? gn[hh][i] : gc[hh][i];
            PG8_LDB(B0, 0, 0); PG8_LDB(B1, 0, 1); PG8_SCHED; PG8_LDA(At, 0, 0); PG8_STAGE_A(PG8_SA(1, 1), a1, 1, k1, gc);
            PG8_WAIT_V(8); PG8_WAIT_L(0); PG8_BAR; PG8_MMA(0, 0, At, B0); PG8_MMA(0, 1, At, B1); PG8_BAR; PG8_SCHED;
            PG8_LDA(At, 0, 1); PG8_STAGE(PG8_SB(0, 0), b2, voffB); PG8_STAGE(PG8_SB(0, 1), b2 + hstep, voffB); PG8_STAGE_A(PG8_SA(0, 0), a2, 0, k2, g2);
            PG8_WAIT_V(8); PG8_WAIT_L(0); PG8_BAR; PG8_MMA(1, 0, At, B0); PG8_MMA(1, 1, At, B1); PG8_BAR; PG8_SCHED;
            PG8_LDB(B0, 1, 0); PG8_LDB(B1, 1, 1); PG8_SCHED; PG8_LDA(At, 1, 0); PG8_STAGE_A(PG8_SA(0, 1), a2, 1, k2, g2);
            PG8_WAIT_V(8); PG8_WAIT_L(0); PG8_BAR; PG8_MMA(0, 0, At, B0); PG8_MMA(0, 1, At, B1); PG8_BAR; PG8_SCHED;
            PG8_LDA(At, 1, 1); PG8_STAGE(PG8_SB(1, 0), b3, voffB); PG8_STAGE(PG8_SB(1, 1), b3 + hstep, voffB); PG8_STAGE_A(PG8_SA(1, 0), a3, 0, k3, g2);
            PG8_WAIT_V(8); PG8_WAIT_L(0); PG8_BAR; PG8_MMA(1, 0, At, B0); PG8_MMA(1, 1, At, B1); PG8_BAR; PG8_SCHED;
        }
        if constexpr (ALIGN_EPI) { if (wr == 0) PG8_BAR; }
        { const int l2 = lane_id(); E(acc, cur, wr, wc, l2 & 15, l2 >> 4); }
        if (!has_next) break;
#pragma unroll
        for (int a = 0; a < 2; ++a)
#pragma unroll
            for (int b = 0; b < 2; ++b)
#pragma unroll
                for (int m = 0; m < 4; ++m)
#pragma unroll
                    for (int n = 0; n < 2; ++n) acc[a][b][m][n] = (f32x4){0.f, 0.f, 0.f, 0.f};
        cur = nxt; cA = nA; cB = nB; ++ui;
#pragma unroll
        for (int hh = 0; hh < 2; ++hh)
#pragma unroll
            for (int i = 0; i < 2; ++i) gc[hh][i] = gn[hh][i];
        if constexpr (ALIGN_EPI) { if (wr == 1) PG8_BAR; }
    }
    PG8_WAIT_V(0);
    if constexpr (!ALIGN_EPI) { if (wr == 0) PG8_BAR; }
    PG8_BAR;
#undef PG8_SA
#undef PG8_SB
#undef PG8_STAGE
#undef PG8_STAGE_A
#undef PG8_LDA
#undef PG8_LDB
#undef PG8_MMA
#undef PG8_WAIT_V
#undef PG8_WAIT_L
#undef PG8_BAR
#undef PG8_SCHED
}
}
using pg8::Unit;

struct Args { const void* in[27]; float* out; unsigned char* ws; int ph_lo, ph_hi; };
struct Ctx {
    const float *x, *ln0_g, *ln0_b, *w_in, *q_norm_g, *w_uq, *kv_norm_g, *w_uk, *w_uv, *rel_bias, *w_up_a, *w_up_b, *w_gate, *b_gate, *w_o, *ln1_g, *ln1_b,
                *w_grp, *b_grp, *w_rt, *b_rt, *w_eg, *w_eu, *w_ed, *ln2_g, *ln2_b;
    const int* pos;
    float* out; unsigned char* ws;
    LAS unsigned char* lds;
    int G, bid, wid;
};
constexpr int LDS_RING = 131072;
constexpr int LDS_MISC = LDS_RING;
constexpr int LDS_LG = LDS_RING + 4096;
constexpr int LDS_RT = LDS_LG + 8192;
constexpr int LDS_BYTES = LDS_RING + 4096 + 8192 + 5120;
template <class T> DI T* wsp(const Ctx& X, size_t off) { return (T*)(X.ws + off); }

DI void tr_item(const float* W, int ld, int K, int ncols, bf16_t* WT, const float* scale, LAS float* scr, int item, int lane, int ldd = 0) {
    if (ldd == 0) ldd = K;
    const int nblk = (ncols + 31) >> 5, kb = item / nblk, nb = item - kb * nblk, k0 = 64 * kb, n0 = 32 * nb;
    const int n4 = 4 * (lane & 7), kr = lane >> 3;
    f32x4 v[8];
#pragma unroll
    for (int i = 0; i < 8; ++i) { const int kk = 8 * i + kr; v[i] = (n0 + n4 + 3 < ncols) ? *(const f32x4*)(W + (size_t)(k0 + kk) * ld + n0 + n4) : (f32x4){0.f, 0.f, 0.f, 0.f}; }
#pragma unroll
    for (int i = 0; i < 8; ++i) { const int kk = 8 * i + kr; f32x4 t = v[i]; if (scale) t = t * scale[k0 + kk];
        scr[kk * 33 + n4] = t[0]; scr[kk * 33 + n4 + 1] = t[1]; scr[kk * 33 + n4 + 2] = t[2]; scr[kk * 33 + n4 + 3] = t[3]; }
    asm volatile("s_waitcnt lgkmcnt(0)" ::: "memory");
    const int c = lane & 7;
#pragma unroll
    for (int j = 0; j < 4; ++j) { const int n = (lane >> 3) + 8 * j; const LAS float* s = scr + (8 * c) * 33 + n;
        u32x4 o; o.x = pk2(s[0 * 33], s[1 * 33]); o.y = pk2(s[2 * 33], s[3 * 33]); o.z = pk2(s[4 * 33], s[5 * 33]); o.w = pk2(s[6 * 33], s[7 * 33]);
        if (n0 + n < ncols) *(u32x4*)(WT + (size_t)(n0 + n) * ldd + k0 + 8 * c) = o; }
    asm volatile("s_waitcnt lgkmcnt(0)" ::: "memory");
}
constexpr int tr_items(int K, int ncols) { return (K / 64) * ((ncols + 31) / 32); }

DI void p0_prologue(const Ctx& X) {
    const int lane = lane_id(), wave = X.wid, tid = wave * 64 + lane;
    LAS float* scr = (LAS float*)(X.lds + wave * 16384);
    const int gw = X.bid * 8 + wave, NGW = X.G * 8;
    bf16_t* WT1 = wsp<bf16_t>(X, WS_WT1);
    {
        constexpr int seg_c0[9] = {0, 256, 384, 1312, 928, 416, 1056, 992, 1344};
        constexpr int seg_nc[9] = {256, 128, 32, 32, 64, 512, 256, 64, 8};
        constexpr int seg_d0[9] = {0, 256, 384, 416, 448, 512, 1024, 1280, 1344};
        constexpr int N_GU = 128 * tr_items(1024, 128), N_DN = 32 * tr_items(256, 1024);
        constexpr int N_IN = tr_items(1024, 256) + tr_items(1024, 128) + tr_items(1024, 32) * 2 + tr_items(1024, 64) * 2 + tr_items(1024, 512) + tr_items(1024, 256) + tr_items(1024, 8);
        constexpr int N_NAMED = N_IN + tr_items(1024, 2048) + tr_items(256, 768) + 2 * tr_items(128, 512) + 2 * tr_items(512, 1024) + tr_items(1024, 1024);
        constexpr int N_ALL = N_GU + N_DN + N_NAMED;
        for (int it = gw; it < N_ALL; it += NGW) {
            int r = it;
            if (r < N_GU) { constexpr int per = tr_items(1024, 128); const int job = r / per, rr = r - job * per, e = job >> 2, pn = (job >> 1) & 1, bj = job & 1;
                tr_item((bj ? X.w_eu : X.w_eg) + (size_t)e * 1024 * 256 + 128 * pn, 256, 1024, 128, wsp<bf16_t>(X, WS_WEGUT) + ((size_t)e * 512 + 256 * pn + 128 * bj) * 1024, nullptr, scr, rr, lane); continue; }
            r -= N_GU;
            if (r < N_DN) { constexpr int per = tr_items(256, 1024); const int e = r / per, rr = r - e * per;
                tr_item(X.w_ed + (size_t)e * 256 * 1024, 1024, 256, 1024, wsp<bf16_t>(X, WS_WEDT) + (size_t)e * 1024 * 256, nullptr, scr, rr, lane); continue; }
            r -= N_DN;
            bool done = false;
#pragma unroll
            for (int sg = 0; sg < 9; ++sg) { const int n = tr_items(1024, seg_nc[sg]);
                if (!done && r < n) { tr_item(X.w_in + seg_c0[sg], 1352, 1024, seg_nc[sg], WT1 + (size_t)seg_d0[sg] * 1024, nullptr, scr, r, lane); done = true; }
                if (!done) r -= n; }
            if (done) continue;
            if (r < tr_items(1024, 2048)) { tr_item(X.w_gate, 2048, 1024, 2048, WT1 + (size_t)1536 * 1024, nullptr, scr, r, lane); continue; } r -= tr_items(1024, 2048);
            if (r < tr_items(256, 768)) { tr_item(X.w_uq, 768, 256, 768, wsp<bf16_t>(X, WS_WUQT), X.q_norm_g, scr, r, lane); continue; } r -= tr_items(256, 768);
            if (r < tr_items(128, 512)) { tr_item(X.w_uk, 512, 128, 512, wsp<bf16_t>(X, WS_WUKVT), X.kv_norm_g, scr, r, lane); continue; } r -= tr_items(128, 512);
            if (r < tr_items(128, 512)) { tr_item(X.w_uv, 512, 128, 512, wsp<bf16_t>(X, WS_WUKVT) + 512 * 128, X.kv_norm_g, scr, r, lane); continue; } r -= tr_items(128, 512);
            if (r < tr_items(512, 1024)) { tr_item(X.w_up_a, 1024, 512, 1024, wsp<bf16_t>(X, WS_WUPT), nullptr, scr, r, lane, 1024); continue; } r -= tr_items(512, 1024);
            if (r < tr_items(512, 1024)) { tr_item(X.w_up_b, 1024, 512, 1024, wsp<bf16_t>(X, WS_WUPT) + 512, nullptr, scr, r, lane, 1024); continue; } r -= tr_items(512, 1024);
            tr_item(X.w_o, 1024, 1024, 1024, wsp<bf16_t>(X, WS_WOT), nullptr, scr, r, lane);
        }
    }
    { const int gt = X.bid * 512 + tid, NT = X.G * 512; u32x4 z = {0u, 0u, 0u, 0u};
      for (int i = gt; i < 184 * 1024 / 8; i += NT) *(u32x4*)(WT1 + (size_t)1352 * 1024 + (size_t)i * 8) = z; }
    { const int gt = X.bid * 512 + tid, NT = X.G * 512; bf16_t* WR = wsp<bf16_t>(X, WS_WRT);
      for (int i = gt; i < 64 * 1024; i += NT) { const int j = i >> 10, k = i & 1023;
          const float v = (j < 4) ? X.w_grp[k * 4 + j] : (j < 36 ? X.w_rt[k * 32 + (j - 4)] : 0.f);
          const unsigned hi = pk2(v, 0.f) & 0xffffu; const float lo = v - bf2f((unsigned short)hi);
          WR[(size_t)j * 1024 + k] = (bf16_t)hi; WR[(size_t)(64 + j) * 1024 + k] = (bf16_t)(pk2(lo, 0.f) & 0xffffu); } }
    { const int gt = X.bid * 512 + tid, NT = X.G * 512; float* RT = wsp<float>(X, WS_ROPE);
      for (int i = gt; i < M * 16; i += NT) { const int row = i >> 4, j = i & 15; float sn, cs; rope_sincos(X.pos[row], j, sn, cs); RT[(size_t)row * 32 + j] = cs; RT[(size_t)row * 32 + 16 + j] = sn; } }
    { int* TS = wsp<int>(X, WS_TSTAT);
      for (int t = gw; t < M / 64; t += NGW) { const int p = X.pos[t * 64 + lane]; const int pmin = wave_min_i(p), pmax = wave_max_i(p);
          if (lane == 0) { TS[t * 4 + 0] = pmin >> 6; TS[t * 4 + 1] = pmax >> 6; TS[t * 4 + 2] = pmin; TS[t * 4 + 3] = pmax; } } }
    { bf16_t* XN = wsp<bf16_t>(X, WS_B); float* ST = wsp<float>(X, WS_STATS0);
      f32x4 gv[4], bv[4];
#pragma unroll
      for (int j = 0; j < 4; ++j) { gv[j] = *(const f32x4*)(X.ln0_g + 4 * lane + 256 * j); bv[j] = *(const f32x4*)(X.ln0_b + 4 * lane + 256 * j); }
      f32x4 nx[4];
      if (gw < M) { const f32x4* xr = (const f32x4*)(X.x + (size_t)gw * D) + lane;
#pragma unroll
          for (int j = 0; j < 4; ++j) nx[j] = xr[64 * j]; }
      for (int m = gw; m < M; m += NGW) {
          f32x4 v[4]; float s = 0.f;
#pragma unroll
          for (int j = 0; j < 4; ++j) { v[j] = nx[j]; s += (v[j].x + v[j].y) + (v[j].z + v[j].w); }
          if (m + NGW < M) { const f32x4* xr = (const f32x4*)(X.x + (size_t)(m + NGW) * D) + lane;
#pragma unroll
              for (int j = 0; j < 4; ++j) nx[j] = xr[64 * j]; }
          const float mean = wave_sum(s) * (1.f / D); float s2 = 0.f;
#pragma unroll
          for (int j = 0; j < 4; ++j) { v[j] = v[j] - mean; s2 += (v[j].x * v[j].x + v[j].y * v[j].y) + (v[j].z * v[j].z + v[j].w * v[j].w); }
          const float rstd = 1.f / sqrtf(wave_sum(s2) * (1.f / D) + LN_EPS);
          if (lane == 0) { ST[2 * m] = mean; ST[2 * m + 1] = rstd; }
          u32x2* o8 = (u32x2*)(XN + (size_t)m * D) + lane;
#pragma unroll
          for (int j = 0; j < 4; ++j) { const f32x4 y = v[j] * rstd * gv[j] + bv[j]; u32x2 o; o.x = pk2(y.x, y.y); o.y = pk2(y.z, y.w); o8[64 * j] = o;
          }
      } }
}

DI void store8(bf16_t* p, const f32x4& a, const f32x4& b) { u32x4 w; w.x = pk2(a[0], a[1]); w.y = pk2(a[2], a[3]); w.z = pk2(b[0], b[1]); w.w = pk2(b[2], b[3]); *(u32x4*)p = w; }
DI void rope8(f32x4& v0, f32x4& v1, const float* tab, int fq) {
    const float sg = (fq < 2) ? -1.f : 1.f; const int j0 = 8 * (fq & 1);
    const f32x4 c0 = *(const f32x4*)(tab + j0), c1 = *(const f32x4*)(tab + j0 + 4), s0 = *(const f32x4*)(tab + 16 + j0), s1 = *(const f32x4*)(tab + 16 + j0 + 4);
#pragma unroll
    for (int e = 0; e < 4; ++e) {
        const float o0 = __shfl_xor(v0[e], 32), o1 = __shfl_xor(v1[e], 32);
        v0[e] = v0[e] * c0[e] + sg * o0 * s0[e];
        v1[e] = v1[e] * c1[e] + sg * o1 * s1[e];
    }
}
struct Epi1 {
    static constexpr bool PERM = true, MID = false;
    bf16_t *CQ, *CKV, *KR, *KI, *KB, *VB, *QB, *QI, *G; float *WI, *SSQ; const float* rope; const float* bgate;
    DI void operator()(const f32x4 (&acc)[2][2][4][2], const Unit& u, int wr, int wc, int fr_, int fq_) const {
        int fr = fr_, fq = fq_; asm volatile("" : "+v"(fr), "+v"(fq));
        const int pn = u.pn; const int row0 = u.pm * 256 + wr * 64 + fr;
        if (pn >= 6) {
            const int gc0 = (pn - 6) * 256 + 32 * wc + 8 * fq;
#pragma unroll
            for (int bj = 0; bj < 2; ++bj) { const f32x4 b0 = *(const f32x4*)(bgate + gc0 + 128 * bj), b1 = *(const f32x4*)(bgate + gc0 + 128 * bj + 4);
#pragma unroll
                for (int ai = 0; ai < 2; ++ai)
#pragma unroll
                    for (int m = 0; m < 4; ++m) { f32x4 v0 = acc[ai][bj][m][0] + b0, v1 = acc[ai][bj][m][1] + b1;
#pragma unroll
                        for (int e = 0; e < 4; ++e) { v0[e] = sigmoidf_fast(v0[e]); v1[e] = sigmoidf_fast(v1[e]); }
                        store8(G + (size_t)(row0 + ai * 128 + m * 16) * 2048 + gc0 + 128 * bj, v0, v1); } }
        } else if (pn == 0 || pn == 4) {
            bf16_t* O = pn == 0 ? CQ : QI;
#pragma unroll
            for (int ai = 0; ai < 2; ++ai)
#pragma unroll
                for (int m = 0; m < 4; ++m) { const int row = row0 + ai * 128 + m * 16; float s = 0.f;
#pragma unroll
                    for (int bj = 0; bj < 2; ++bj) { const f32x4 v0 = acc[ai][bj][m][0], v1 = acc[ai][bj][m][1];
                        store8(O + (size_t)row * 256 + 128 * bj + 32 * wc + 8 * fq, v0, v1);
                        s += (v0[0] * v0[0] + v0[1] * v0[1]) + (v0[2] * v0[2] + v0[3] * v0[3]) + (v1[0] * v1[0] + v1[1] * v1[1]) + (v1[2] * v1[2] + v1[3] * v1[3]); }
                    if (pn == 0) { s += __shfl_xor(s, 16); s += __shfl_xor(s, 32); if (fq == 0) SSQ[(size_t)row * 8 + wc] = s; } }
        } else if (pn == 2 || pn == 3) {
            const float sc = 0.125f * LOG2E;
#pragma unroll
            for (int ai = 0; ai < 2; ++ai)
#pragma unroll
                for (int m = 0; m < 4; ++m) { const int row = row0 + ai * 128 + m * 16;
#pragma unroll
                    for (int bj = 0; bj < 2; ++bj) store8(QB + (size_t)row * 512 + (pn - 2) * 256 + 128 * bj + 32 * wc + 8 * fq, acc[ai][bj][m][0] * sc, acc[ai][bj][m][1] * sc); }
        } else if (pn == 1) {
#pragma unroll
            for (int ai = 0; ai < 2; ++ai)
#pragma unroll
                for (int m = 0; m < 4; ++m) { const int row = row0 + ai * 128 + m * 16;
                    { const f32x4 v0 = acc[ai][0][m][0], v1 = acc[ai][0][m][1];
                      store8(CKV + (size_t)row * 128 + 32 * wc + 8 * fq, v0, v1);
                      float s = (v0[0] * v0[0] + v0[1] * v0[1]) + (v0[2] * v0[2] + v0[3] * v0[3]) + (v1[0] * v1[0] + v1[1] * v1[1]) + (v1[2] * v1[2] + v1[3] * v1[3]);
                      s += __shfl_xor(s, 16); s += __shfl_xor(s, 32); if (fq == 0) SSQ[(size_t)row * 8 + 4 + wc] = s; }
                    f32x4 v0 = acc[ai][1][m][0], v1 = acc[ai][1][m][1];
                    if (wc == 0) { rope8(v0, v1, rope + (size_t)row * 32, fq); store8(KR + (size_t)row * 32 + 8 * fq, v0, v1); }
                    else if (wc == 1) store8(KI + (size_t)row * 32 + 8 * fq, v0, v1);
                    else store8(KB + (size_t)row * 64 + 32 * (wc - 2) + 8 * fq, v0, v1); }
        } else {
            const float wsc = 0.35355339059327373f * 0.17677669529663687f;
#pragma unroll
            for (int ai = 0; ai < 2; ++ai)
#pragma unroll
                for (int m = 0; m < 4; ++m) { const int row = row0 + ai * 128 + m * 16;
                    if (wc < 2) store8(VB + (size_t)row * 64 + 32 * wc + 8 * fq, acc[ai][0][m][0], acc[ai][0][m][1]);
                    else if (wc == 2 && fq == 0) { *(f32x4*)(WI + (size_t)row * 8) = acc[ai][0][m][0] * wsc; *(f32x4*)(WI + (size_t)row * 8 + 4) = acc[ai][0][m][1] * wsc; } }
        }
    }
};
struct Epi2 {
    static constexpr bool PERM = true, MID = false;
    bf16_t* QM; const float* SSQ; const float* rope;
    DI void operator()(const f32x4 (&acc)[2][2][4][2], const Unit& u, int wr, int wc, int fr_, int fq_) const {
        int fr = fr_, fq = fq_; asm volatile("" : "+v"(fr), "+v"(fq));
        const int row0 = u.pm * 256 + wr * 64 + fr; const float sc = 0.10206207261596575f * LOG2E;
#pragma unroll
        for (int ai = 0; ai < 2; ++ai)
#pragma unroll
            for (int m = 0; m < 4; ++m) { const int row = row0 + ai * 128 + m * 16;
                const f32x4 q4 = *(const f32x4*)(SSQ + (size_t)row * 8); const float rs = sc / sqrtf(((q4[0] + q4[1]) + (q4[2] + q4[3])) * (1.f / 256.f) + RMS_EPS);
#pragma unroll
                for (int bj = 0; bj < 2; ++bj) { const int g32 = 8 * u.pn + 4 * bj + wc; f32x4 v0 = acc[ai][bj][m][0] * rs, v1 = acc[ai][bj][m][1] * rs;
                    if (g32 % 3 == 2) rope8(v0, v1, rope + (size_t)row * 32, fq);
                    store8(QM + (size_t)row * 768 + 32 * g32 + 8 * fq, v0, v1); } }
    }
};
struct Epi3 {
    static constexpr bool PERM = true, MID = false;
    bf16_t *KN, *VM; const float* SSQ;
    DI void operator()(const f32x4 (&acc)[2][2][4][2], const Unit& u, int wr, int wc, int fr_, int fq_) const {
        int fr = fr_, fq = fq_; asm volatile("" : "+v"(fr), "+v"(fq));
        const int row0 = u.pm * 256 + wr * 64 + fr; bf16_t* O = u.pn < 2 ? KN : VM; const int c0 = (u.pn & 1) * 256 + 32 * wc + 8 * fq;
#pragma unroll
        for (int ai = 0; ai < 2; ++ai)
#pragma unroll
            for (int m = 0; m < 4; ++m) { const int row = row0 + ai * 128 + m * 16;
                const f32x4 q4 = *(const f32x4*)(SSQ + (size_t)row * 8 + 4); const float rs = 1.f / sqrtf(((q4[0] + q4[1]) + (q4[2] + q4[3])) * (1.f / 128.f) + RMS_EPS);
#pragma unroll
                for (int bj = 0; bj < 2; ++bj) store8(O + (size_t)row * 512 + c0 + 128 * bj, acc[ai][bj][m][0] * rs, acc[ai][bj][m][1] * rs); }
    }
};
struct Epi4 {
    static constexpr bool PERM = true, MID = true;
    bf16_t* MIX; const bf16_t* G;
    DI void mid(f32x4 (&acc)[2][2][4][2], const Unit& u, int wr, int wc, int fr, int fq) const {
        const int row0 = u.pm * 256 + wr * 64 + fr, c0 = u.pn * 256 + 32 * wc + 8 * fq;
#pragma unroll
        for (int ai = 0; ai < 2; ++ai) {
            u32x4 ga[4][2], gb[4][2];
#pragma unroll
            for (int m = 0; m < 4; ++m)
#pragma unroll
                for (int bj = 0; bj < 2; ++bj) { const size_t o = (size_t)(row0 + ai * 128 + m * 16) * 2048 + c0 + 128 * bj; ga[m][bj] = *(const u32x4*)(G + o); gb[m][bj] = *(const u32x4*)(G + o + 1024); }
#pragma unroll
            for (int m = 0; m < 4; ++m)
#pragma unroll
                for (int bj = 0; bj < 2; ++bj) {
                    const unsigned gaw[4] = {ga[m][bj].x, ga[m][bj].y, ga[m][bj].z, ga[m][bj].w}, gbw[4] = {gb[m][bj].x, gb[m][bj].y, gb[m][bj].z, gb[m][bj].w};
#pragma unroll
                    for (int q = 0; q < 4; ++q) {
                        const float a0 = __uint_as_float(gaw[q] << 16), a1 = __uint_as_float(gaw[q] & 0xffff0000u), b0 = __uint_as_float(gbw[q] << 16), b1 = __uint_as_float(gbw[q] & 0xffff0000u);
                        const float r0 = a0 * fast_rcp(fmaxf(b0, 1e-30f)), r1 = a1 * fast_rcp(fmaxf(b1, 1e-30f));
                        acc[ai][bj][m][q >> 1][2 * (q & 1)] *= r0; acc[ai][bj][m][q >> 1][2 * (q & 1) + 1] *= r1; }
                }
            asm volatile("" ::: "memory");
        }
    }
    DI void operator()(const f32x4 (&acc)[2][2][4][2], const Unit& u, int wr, int wc, int fr_, int fq_) const {
        int fr = fr_, fq = fq_; asm volatile("" : "+v"(fr), "+v"(fq));
        const int row0 = u.pm * 256 + wr * 64 + fr, c0 = u.pn * 256 + 32 * wc + 8 * fq;
#pragma unroll
        for (int ai = 0; ai < 2; ++ai)
#pragma unroll
            for (int m = 0; m < 4; ++m) { const int row = row0 + ai * 128 + m * 16;
#pragma unroll
                for (int bj = 0; bj < 2; ++bj) { const int c = c0 + 128 * bj;
                    const u32x4 gw = *(const u32x4*)(G + (size_t)row * 2048 + 1024 + c);
                    f32x4 v0 = acc[ai][bj][m][0], v1 = acc[ai][bj][m][1];
                    v0[0] *= __uint_as_float(gw.x << 16); v0[1] *= __uint_as_float(gw.x & 0xffff0000u); v0[2] *= __uint_as_float(gw.y << 16); v0[3] *= __uint_as_float(gw.y & 0xffff0000u);
                    v1[0] *= __uint_as_float(gw.z << 16); v1[1] *= __uint_as_float(gw.z & 0xffff0000u); v1[2] *= __uint_as_float(gw.w << 16); v1[3] *= __uint_as_float(gw.w & 0xffff0000u);
                    store8(MIX + (size_t)row * 1024 + c, v0, v1); } }
    }
};
struct Epi5 {
    static constexpr bool PERM = false, MID = false;
    float* Y1; const float *x, *ST, *g0, *b0;
    DI void operator()(const f32x4 (&acc)[2][2][4][2], const Unit& u, int wr, int wc, int fr_, int fq_) const {
        int fr = fr_, fq = fq_; asm volatile("" : "+v"(fr), "+v"(fq));
        const int row0 = u.pm * 256 + wr * 64 + fr, c0 = u.pn * 256 + 32 * wc + 4 * fq;
        f32x4 gv[2][2], bv[2][2];
#pragma unroll
        for (int bj = 0; bj < 2; ++bj)
#pragma unroll
            for (int n = 0; n < 2; ++n) { gv[bj][n] = *(const f32x4*)(g0 + c0 + 128 * bj + 16 * n) * ALPHA; bv[bj][n] = *(const f32x4*)(b0 + c0 + 128 * bj + 16 * n) * ALPHA; }
#pragma unroll
        for (int ai = 0; ai < 2; ++ai)
#pragma unroll
            for (int m = 0; m < 4; ++m) { const int row = row0 + ai * 128 + m * 16; const float mean = ST[2 * row], rstd = ST[2 * row + 1];
#pragma unroll
                for (int bj = 0; bj < 2; ++bj)
#pragma unroll
                    for (int n = 0; n < 2; ++n) { const size_t off = (size_t)row * 1024 + c0 + 128 * bj + 16 * n;
                        const f32x4 xv = *(const f32x4*)(x + off);
                        *(f32x4*)(Y1 + off) = (xv - mean) * rstd * gv[bj][n] + bv[bj][n] + acc[ai][bj][m][n]; } }
    }
};
struct MoeOrder {
    const LAS int* tstart;
    const LAS int* scnt;
    const int* LIST; int K2;
    int NT, G, c, ntiles;
    DI bool next(int i, Unit& u) const {
        const long L = (long)i * G + c; if (L >= (long)ntiles * NT) return false;
        const int tile = (int)(L / NT), pn = (int)(L - (long)tile * NT);
        int lo = 0, hi = NSEG;
#pragma unroll
        for (int s = 0; s < 6; ++s) { const int mid = (lo + hi) >> 1; if (tstart[mid] <= tile) lo = mid; else hi = mid; }
        const int ts = tstart[lo];
        u.pm = tile; u.pn = __builtin_amdgcn_readfirstlane((lo & 31) * NT + pn); u.a0 = __builtin_amdgcn_readfirstlane(lo); u.a1 = __builtin_amdgcn_readfirstlane(tile - ts); return true;
    }
    DI unsigned arow(const Unit& u, int r) const { const int idx = u.a1 * 256 + r; const int tok = LIST[(size_t)u.a0 * M + (idx < scnt[u.a0] ? idx : 0)]; return (unsigned)tok * (unsigned)K2; }
};
struct Epi7 {
    static constexpr bool PERM = true, MID = false;
    bf16_t* HID; const float* LISTW; const LAS int* scnt;
    DI void operator()(const f32x4 (&acc)[2][2][4][2], const Unit& u, int wr, int wc, int fr_, int fq_) const {
        int fr = fr_, fq = fq_; asm volatile("" : "+v"(fr), "+v"(fq));
        const int c0 = (u.pn & 1) * 128 + 32 * wc + 8 * fq, cnt = scnt[u.a0];
#pragma unroll
        for (int ai = 0; ai < 2; ++ai)
#pragma unroll
            for (int m = 0; m < 4; ++m) { const int r = ai * 128 + wr * 64 + m * 16 + fr, idx = u.a1 * 256 + r;
                const float w = idx < cnt ? LISTW[(size_t)u.a0 * M + idx] : 0.f;
                f32x4 v0, v1;
#pragma unroll
                for (int e = 0; e < 4; ++e) { const float a0 = acc[ai][0][m][0][e], a1 = acc[ai][0][m][1][e];
                    v0[e] = a0 * sigmoidf_fast(a0) * acc[ai][1][m][0][e] * w; v1[e] = a1 * sigmoidf_fast(a1) * acc[ai][1][m][1][e] * w; }
                store8(HID + ((size_t)u.pm * 256 + r) * 256 + c0, v0, v1); }
    }
};
struct Epi8 {
    static constexpr bool PERM = true, MID = false;
    bf16_t* PP; const int* LIST; const LAS int* scnt;
    DI void operator()(const f32x4 (&acc)[2][2][4][2], const Unit& u, int wr, int wc, int fr_, int fq_) const {
        int fr = fr_, fq = fq_; asm volatile("" : "+v"(fr), "+v"(fq));
        const int c0 = (u.pn & 3) * 256 + 32 * wc + 8 * fq, cnt = scnt[u.a0]; bf16_t* O = PP + (size_t)(u.a0 >> 5) * M * 1024;
        int tok[2][4];
#pragma unroll
        for (int ai = 0; ai < 2; ++ai)
#pragma unroll
            for (int m = 0; m < 4; ++m) { const int r = ai * 128 + wr * 64 + m * 16 + fr, idx = u.a1 * 256 + r; tok[ai][m] = idx < cnt ? LIST[(size_t)u.a0 * M + idx] : -1; }
#pragma unroll
        for (int ai = 0; ai < 2; ++ai)
#pragma unroll
            for (int m = 0; m < 4; ++m) {
                if (tok[ai][m] >= 0) {
#pragma unroll
                    for (int bj = 0; bj < 2; ++bj) store8(O + (size_t)tok[ai][m] * 1024 + c0 + 128 * bj, acc[ai][bj][m][0], acc[ai][bj][m][1]); } }
    }
};


DI void p6_ln1_router(const Ctx& X) {
    const int lane = lane_id(), wave = X.wid, tid = wave * 64 + lane, r = lane & 31, hh = lane >> 5;
    LAS unsigned char* HI = X.lds; LAS unsigned char* LO = X.lds + 65536;
    LAS float* LG = (LAS float*)(X.lds + LDS_LG);
    const float* Y1 = wsp<float>(X, WS_A); float* ST1 = wsp<float>(X, WS_STATS1); bf16_t* HB = wsp<bf16_t>(X, WS_B);
    const bf16_t* WR = wsp<bf16_t>(X, WS_WRT);
    unsigned* CNT = wsp<unsigned>(X, WS_CTL) + CW_CNT; int* LIST = wsp<int>(X, WS_LIST); float* LISTW = wsp<float>(X, WS_LISTW);
    f32x4 gv[4], bv[4];
#pragma unroll
    for (int j = 0; j < 4; ++j) { gv[j] = *(const f32x4*)(X.ln1_g + 4 * lane + 256 * j); bv[j] = *(const f32x4*)(X.ln1_b + 4 * lane + 256 * j); }
    LAS unsigned* RT_SP = (LAS unsigned*)(X.lds + LDS_RT); LAS float* RT_W = (LAS float*)(X.lds + LDS_RT + 2048); LAS int* RT_TOK = (LAS int*)(X.lds + LDS_RT + 4096 - 0);
    LAS unsigned* RT_CNT = (LAS unsigned*)(X.lds + LDS_MISC + 1024); LAS unsigned* RT_BASE = (LAS unsigned*)(X.lds + LDS_MISC + 1280);
    if (tid < NSEG) RT_CNT[tid] = 0u;
    int nbatch = 0;
    __syncthreads();
    for (int unit = X.bid; unit < M / 32; unit += X.G) {
        *(LAS f32x4*)(LG + tid * 4) = (f32x4){0.f, 0.f, 0.f, 0.f};
        f32x4 vv[4][4];
#pragma unroll
        for (int rr = 0; rr < 4; ++rr) { const f32x4* yr = (const f32x4*)(Y1 + (size_t)(unit * 32 + wave * 4 + rr) * D) + lane;
#pragma unroll
            for (int j = 0; j < 4; ++j) vv[rr][j] = yr[64 * j]; }
#pragma unroll
        for (int rr = 0; rr < 4; ++rr) {
            const int rl = wave * 4 + rr, m = unit * 32 + rl;
            f32x4 v[4]; float s = 0.f;
#pragma unroll
            for (int j = 0; j < 4; ++j) { v[j] = vv[rr][j]; s += (v[j].x + v[j].y) + (v[j].z + v[j].w); }
            const float mean = wave_sum(s) * (1.f / D); float s2 = 0.f;
#pragma unroll
            for (int j = 0; j < 4; ++j) { v[j] = v[j] - mean; s2 += (v[j].x * v[j].x + v[j].y * v[j].y) + (v[j].z * v[j].z + v[j].w * v[j].w); }
            const float rstd = 1.f / sqrtf(wave_sum(s2) * (1.f / D) + LN_EPS);
            if (lane == 0) { ST1[2 * m] = mean; ST1[2 * m + 1] = rstd; }
#pragma unroll
            for (int j = 0; j < 4; ++j) {
                const f32x4 y = v[j] * rstd * gv[j] + bv[j];
                u32x2 hi; hi.x = pk2(y.x, y.y); hi.y = pk2(y.z, y.w);
                *((u32x2*)(HB + (size_t)m * D) + lane + 64 * j) = hi;
                const float l0 = y.x - __uint_as_float(hi.x << 16), l1 = y.y - __uint_as_float(hi.x & 0xffff0000u), l2 = y.z - __uint_as_float(hi.y << 16), l3 = y.w - __uint_as_float(hi.y & 0xffff0000u);
                u32x2 lo; lo.x = pk2(l0, l1); lo.y = pk2(l2, l3);
                const int chunk = (lane >> 1) + 32 * j; const unsigned byte = (unsigned)rl * 2048u + (unsigned)((chunk ^ (rl & 15)) * 16) + 8u * (lane & 1);
                *(LAS u32x2*)(HI + byte) = hi; *(LAS u32x2*)(LO + byte) = lo;
            }
        }
        __syncthreads();
        {
            f32x16 a0, a1;
#pragma unroll
            for (int e = 0; e < 16; ++e) { a0[e] = 0.f; a1[e] = 0.f; }
#pragma unroll
            for (int ks = 0; ks < 8; ++ks) {
                const int ch = 16 * wave + 2 * ks + hh; const unsigned byte = (unsigned)r * 2048u + (unsigned)((ch ^ (r & 15)) * 16);
                const bf16x8 ahi = *(const LAS bf16x8*)(HI + byte), alo = *(const LAS bf16x8*)(LO + byte);
                const size_t ko = (size_t)(128 * wave + 16 * ks + 8 * hh);
                const bf16x8 bh0 = *(const bf16x8*)(WR + (size_t)r * 1024 + ko), bh1 = *(const bf16x8*)(WR + (size_t)(32 + r) * 1024 + ko);
                const bf16x8 bl0 = *(const bf16x8*)(WR + (size_t)(64 + r) * 1024 + ko), bl1 = *(const bf16x8*)(WR + (size_t)(96 + r) * 1024 + ko);
                a0 = __builtin_amdgcn_mfma_f32_32x32x16_bf16(ahi, bh0, a0, 0, 0, 0); a0 = __builtin_amdgcn_mfma_f32_32x32x16_bf16(ahi, bl0, a0, 0, 0, 0); a0 = __builtin_amdgcn_mfma_f32_32x32x16_bf16(alo, bh0, a0, 0, 0, 0);
                a1 = __builtin_amdgcn_mfma_f32_32x32x16_bf16(ahi, bh1, a1, 0, 0, 0); a1 = __builtin_amdgcn_mfma_f32_32x32x16_bf16(ahi, bl1, a1, 0, 0, 0); a1 = __builtin_amdgcn_mfma_f32_32x32x16_bf16(alo, bh1, a1, 0, 0, 0);
            }
#pragma unroll
            for (int e = 0; e < 16; ++e) { const int row = (e & 3) + 8 * (e >> 2) + 4 * hh;
                __hip_atomic_fetch_add(LG + row * 64 + r, a0[e], __ATOMIC_RELAXED, __HIP_MEMORY_SCOPE_WORKGROUP);
                if (r < 4) __hip_atomic_fetch_add(LG + row * 64 + 32 + r, a1[e], __ATOMIC_RELAXED, __HIP_MEMORY_SCOPE_WORKGROUP); }
        }
        __syncthreads();
        if (tid < 32) {
            const LAS float* lg = LG + tid * 64;
            float gl[4]; float gmax = -3.4e38f; int gsel = 0;
#pragma unroll
            for (int j = 0; j < 4; ++j) { gl[j] = lg[j] + X.b_grp[j]; if (gl[j] > gmax) { gmax = gl[j]; gsel = j; } }
            float gz = 0.f;
#pragma unroll
            for (int j = 0; j < 4; ++j) gz += expf(gl[j] - gmax);
            const float gw = 1.f / gz;
            float e0 = -3.4e38f, e1 = -3.4e38f; int i0 = 0, i1 = 0;
#pragma unroll
            for (int j = 0; j < 8; ++j) { const float v = lg[4 + gsel * 8 + j] + X.b_rt[gsel * 8 + j];
                if (v > e0) { e1 = e0; i1 = i0; e0 = v; i0 = j; } else if (v > e1) { e1 = v; i1 = j; } }
            const float t = expf(e1 - e0), c0 = gw / (1.f + t), c1 = gw * t / (1.f + t);
            const int s0 = gsel * 8 + i0, s1 = 32 + gsel * 8 + i1;
            const unsigned l0 = __hip_atomic_fetch_add(RT_CNT + s0, 1u, __ATOMIC_RELAXED, __HIP_MEMORY_SCOPE_WORKGROUP), l1 = __hip_atomic_fetch_add(RT_CNT + s1, 1u, __ATOMIC_RELAXED, __HIP_MEMORY_SCOPE_WORKGROUP);
            const int slot = nbatch * 32 + tid;
            RT_SP[slot * 2] = ((unsigned)s0 << 16) | l0; RT_SP[slot * 2 + 1] = ((unsigned)s1 << 16) | l1; RT_W[slot * 2] = c0; RT_W[slot * 2 + 1] = c1; RT_TOK[slot] = unit * 32 + tid;
        }
        ++nbatch;
        __syncthreads();
        if (nbatch == 8 || unit + X.G >= M / 32) {
            if (tid < NSEG) { const unsigned n = RT_CNT[tid]; RT_BASE[tid] = n ? __hip_atomic_fetch_add(CNT + tid, n, __ATOMIC_RELAXED, __HIP_MEMORY_SCOPE_AGENT) : 0u; }
            __syncthreads();
            if (tid < nbatch * 32) {
#pragma unroll
                for (int k = 0; k < 2; ++k) { const unsigned sp = RT_SP[tid * 2 + k], sg = sp >> 16, ps = RT_BASE[sg] + (sp & 0xffffu);
                    LIST[(size_t)sg * M + ps] = RT_TOK[tid]; LISTW[(size_t)sg * M + ps] = RT_W[tid * 2 + k]; }
            }
            __syncthreads();
            if (tid < NSEG) RT_CNT[tid] = 0u;
            nbatch = 0;
            __syncthreads();
        }
    }
}

DI void moe_prep(const Ctx& X) {
    const int tid = X.wid * 64 + lane_id();
    LAS int* tstart = (LAS int*)(X.lds + LDS_MISC + 64); LAS int* scnt = (LAS int*)(X.lds + LDS_MISC + 512);
    unsigned* CNT = wsp<unsigned>(X, WS_CTL) + CW_CNT;
    if (tid < NSEG) {
        const int c = (int)__hip_atomic_load(CNT + tid, __ATOMIC_RELAXED, __HIP_MEMORY_SCOPE_AGENT); scnt[tid] = c;
        const int nt = (c + 255) >> 8; int inc = nt;
#pragma unroll
        for (int d = 1; d < 64; d <<= 1) { const int t = __shfl_up(inc, d); if (tid >= d) inc += t; }
        tstart[tid] = inc - nt; if (tid == NSEG - 1) tstart[NSEG] = inc;
    }
    __syncthreads();
}

DI void p9_ln2(const Ctx& X) {
    const int lane = lane_id(), wave = X.wid;
    const int gw = X.bid * 8 + wave, NGW = X.G * 8;
    const float* Y1 = wsp<float>(X, WS_A); const float* ST1 = wsp<float>(X, WS_STATS1); const bf16_t* PP0 = wsp<bf16_t>(X, WS_C); const bf16_t* PP1 = PP0 + (size_t)M * 1024;
    f32x4 gv[4], bv[4], g1[4], b1[4];
#pragma unroll
    for (int j = 0; j < 4; ++j) { gv[j] = *(const f32x4*)(X.ln2_g + 4 * lane + 256 * j); bv[j] = *(const f32x4*)(X.ln2_b + 4 * lane + 256 * j);
        g1[j] = *(const f32x4*)(X.ln1_g + 4 * lane + 256 * j) * ALPHA; b1[j] = *(const f32x4*)(X.ln1_b + 4 * lane + 256 * j) * ALPHA; }
    f32x4 ny[4]; u32x2 na[4], nb[4]; float nmean = 0.f, nrstd = 0.f;
#define P9_LOAD(mm) do { _Pragma("unroll") for (int j = 0; j < 4; ++j) { ny[j] = *((const f32x4*)(Y1 + (size_t)(mm) * D) + lane + 64 * j); \
        na[j] = *((const u32x2*)(PP0 + (size_t)(mm) * D) + lane + 64 * j); nb[j] = *((const u32x2*)(PP1 + (size_t)(mm) * D) + lane + 64 * j); } nmean = ST1[2 * (mm)]; nrstd = ST1[2 * (mm) + 1]; } while (0)
    if (gw < M) P9_LOAD(gw);
    for (int m = gw; m < M; m += NGW) {
        f32x4 v[4]; float s = 0.f; const float mean1 = nmean, rstd1 = nrstd;
        f32x4 yv4[4]; u32x2 a4[4], b4[4];
#pragma unroll
        for (int j = 0; j < 4; ++j) { yv4[j] = ny[j]; a4[j] = na[j]; b4[j] = nb[j]; }
        if (m + NGW < M) P9_LOAD(m + NGW);
#pragma unroll
        for (int j = 0; j < 4; ++j) {
            const f32x4 yv = yv4[j]; const u32x2 a = a4[j], b = b4[j];
            f32x4 y = (yv - mean1) * rstd1 * g1[j] + b1[j];
            y.x += __uint_as_float(a.x << 16) + __uint_as_float(b.x << 16); y.y += __uint_as_float(a.x & 0xffff0000u) + __uint_as_float(b.x & 0xffff0000u);
            y.z += __uint_as_float(a.y << 16) + __uint_as_float(b.y << 16); y.w += __uint_as_float(a.y & 0xffff0000u) + __uint_as_float(b.y & 0xffff0000u);
            v[j] = y; s += (y.x + y.y) + (y.z + y.w);
        }
        const float mean = wave_sum(s) * (1.f / D); float s2 = 0.f;
#pragma unroll
        for (int j = 0; j < 4; ++j) { v[j] = v[j] - mean; s2 += (v[j].x * v[j].x + v[j].y * v[j].y) + (v[j].z * v[j].z + v[j].w * v[j].w); }
        const float rstd = 1.f / sqrtf(wave_sum(s2) * (1.f / D) + LN_EPS);
#pragma unroll
        for (int j = 0; j < 4; ++j) *((f32x4*)(X.out + (size_t)m * D) + lane + 64 * j) = v[j] * rstd * gv[j] + bv[j];
    }
#undef P9_LOAD
}

#define MFMA32(a, b, c) __builtin_amdgcn_mfma_f32_32x32x16_bf16((a), (b), (c), 0, 0, 0)
DI bf16x8 pack8(const f32x16& x, int s) {
    u32x4 p; p.x = pk2(x[8 * s + 0], x[8 * s + 1]); p.y = pk2(x[8 * s + 2], x[8 * s + 3]); p.z = pk2(x[8 * s + 4], x[8 * s + 5]); p.w = pk2(x[8 * s + 6], x[8 * s + 7]);
    return __builtin_bit_cast(bf16x8, p);
}
struct TrRegs { s16x4 t0, t1, t2, t3, t4, t5, t6, t7; };
DI void tr_issue8(unsigned addr, TrRegs& T) {
    asm volatile("ds_read_b64_tr_b16 %0, %8\n\tds_read_b64_tr_b16 %1, %8 offset:1024\n\tds_read_b64_tr_b16 %2, %8 offset:2048\n\tds_read_b64_tr_b16 %3, %8 offset:3072\n\t"
                 "ds_read_b64_tr_b16 %4, %8 offset:4096\n\tds_read_b64_tr_b16 %5, %8 offset:5120\n\tds_read_b64_tr_b16 %6, %8 offset:6144\n\tds_read_b64_tr_b16 %7, %8 offset:7168"
                 : "=&v"(T.t0), "=&v"(T.t1), "=&v"(T.t2), "=&v"(T.t3), "=&v"(T.t4), "=&v"(T.t5), "=&v"(T.t6), "=&v"(T.t7) : "v"(addr) : "memory");
}
DI void tr_wait(TrRegs& A, TrRegs& B) {
    asm volatile("s_waitcnt lgkmcnt(0)" : "+v"(A.t0), "+v"(A.t1), "+v"(A.t2), "+v"(A.t3), "+v"(A.t4), "+v"(A.t5), "+v"(A.t6), "+v"(A.t7),
                 "+v"(B.t0), "+v"(B.t1), "+v"(B.t2), "+v"(B.t3), "+v"(B.t4), "+v"(B.t5), "+v"(B.t6), "+v"(B.t7) :: "memory");
}
DI void tr_frags(const TrRegs& T, bf16x8 (&vf)[4]) {
    vf[0] = __builtin_shufflevector(T.t0, T.t1, 0, 1, 2, 3, 4, 5, 6, 7); vf[1] = __builtin_shufflevector(T.t2, T.t3, 0, 1, 2, 3, 4, 5, 6, 7);
    vf[2] = __builtin_shufflevector(T.t4, T.t5, 0, 1, 2, 3, 4, 5, 6, 7); vf[3] = __builtin_shufflevector(T.t6, T.t7, 0, 1, 2, 3, 4, 5, 6, 7);
}
DI float xhalf_max(float x) {
    const unsigned u = __float_as_uint(x);
    const auto r = __builtin_amdgcn_permlane32_swap(u, u, false, false);
    return fmaxf(__uint_as_float(r[0]), __uint_as_float(r[1]));
}
constexpr float M_FLOOR = -64.f, SM_THR = 4.f;
DI void softmax_tile(f32x16& s0, f32x16& s1, float& meff, float& lrun, f32x16& o0, f32x16& o1, bf16x8 (&pf)[4]) {
    float mx = fmaxf(s0[0], s1[0]);
#pragma unroll
    for (int e = 1; e < 16; ++e) mx = fmaxf(mx, fmaxf(s0[e], s1[e]));
    mx = xhalf_max(mx);
    if (__any(mx > SM_THR)) {
        const float delta = fmaxf(mx, 0.f), alpha = fast_exp2(-delta);
#pragma unroll
        for (int e = 0; e < 16; ++e) { s0[e] -= delta; s1[e] -= delta; o0[e] *= alpha; o1[e] *= alpha; }
        lrun *= alpha; meff += delta;
    }
    float ls = 0.f;
#pragma unroll
    for (int e = 0; e < 16; ++e) { s0[e] = fast_exp2(s0[e]); s1[e] = fast_exp2(s1[e]); ls += s0[e] + s1[e]; }
    lrun += ls;
    pf[0] = pack8(s0, 0); pf[1] = pack8(s0, 1); pf[2] = pack8(s1, 0); pf[3] = pack8(s1, 1);
}

DI i32x4 tile_stats(const Ctx& X, int b, int lane, int tid) {
    LAS int* TSL = (LAS int*)(X.lds + LDS_MISC + 2048); LAS int* tag = (LAS int*)(X.lds + LDS_MISC + 48);
    if (*tag != b + 1) {
        if (tid < 32) *(LAS i32x4*)(TSL + 4 * tid) = *(const i32x4*)(wsp<int>(X, WS_TSTAT) + (size_t)b * 128 + 4 * tid);
        __syncthreads();
        if (tid == 0) *tag = b + 1;
        __syncthreads();
    }
    return *(const LAS i32x4*)(TSL + 4 * (lane & 31));
}

DI void mla_unit(const Ctx& X, int b, int h, int qb) {
    const int lane = lane_id(), w = X.wid, tid = w * 64 + lane, r = lane & 31, hh = lane >> 5;
    LAS unsigned char* lds = X.lds; const unsigned ldsb = (unsigned)(uintptr_t)lds;
    const int tok0 = b * SEQ;
    const bf16_t* QM = wsp<bf16_t>(X, WS_QM); const bf16_t* KN = wsp<bf16_t>(X, WS_KN); const bf16_t* VM = wsp<bf16_t>(X, WS_VM); const bf16_t* KR = wsp<bf16_t>(X, WS_KR);
    bf16_t* OA = wsp<bf16_t>(X, WS_B);
    const int* TS = wsp<int>(X, WS_TSTAT) + (size_t)b * 32 * 4;
    const int qrow = tok0 + qb * 256 + w * 32 + r;
    bf16x8 qf[6];
#pragma unroll
    for (int s = 0; s < 6; ++s) qf[s] = *(const bf16x8*)(QM + (size_t)qrow * 768 + h * 96 + 16 * s + 8 * hh);
    const int qc = X.pos[qrow] >> 6;
    const i32x4 tsv = tile_stats(X, b, lane, tid);
    int qmin = 0x7fffffff, qmax = -0x7fffffff - 1;
#pragma unroll
    for (int t = 0; t < 4; ++t) { const int a = __builtin_amdgcn_readlane(tsv[0], qb * 4 + t), c = __builtin_amdgcn_readlane(tsv[1], qb * 4 + t); qmin = a < qmin ? a : qmin; qmax = c > qmax ? c : qmax; }
    unsigned procm = (unsigned)__ballot(lane < 32 && tsv[0] <= qmax);
    const unsigned maskm = (unsigned)__ballot(lane < 32 && tsv[1] > qmin);
    f32x16 o0, o1;
#pragma unroll
    for (int e = 0; e < 16; ++e) { o0[e] = 0.f; o1[e] = 0.f; }
    float mrun = M_FLOOR, lrun = 0.f;
    const int key_a = tid >> 3, ch_a = tid & 7, key_r = (tid >> 2) & 63, ch_r = tid & 3;
    const unsigned kdst = 192u * key_a + 16u * (ch_a ^ ((key_a >> 2) & 3)), vdst = 12288u + 128u * key_a + 16u * (ch_a ^ (((key_a >> 1) & 1) << 2));
    const unsigned rdst = 192u * key_r + 16u * ((8 + ch_r) ^ ((key_r >> 2) & 3));
    constexpr unsigned BUFB = 20736u;
    const int q4 = (lane & 15) >> 2, p4 = lane & 3, blk = (lane >> 4) & 1, sw = (q4 >> 1) & 1;
    const unsigned vbase = ldsb + 12288u + 128u * (4 * hh + q4) + 16u * (2 * blk + (p4 >> 1)) + 8u * (p4 & 1);
    const unsigned va0 = vbase + 64u * sw, va1 = vbase + 64u * (1 - sw);
    u32x4 rk, rv, rr = {0u, 0u, 0u, 0u}; int rkc = 0;
#define MLA_LOAD(j) do { const size_t t0_ = (size_t)tok0 + (size_t)(j) * 64; rk = *(const u32x4*)(KN + (t0_ + key_a) * 512 + h * 64 + ch_a * 8); rv = *(const u32x4*)(VM + (t0_ + key_a) * 512 + h * 64 + ch_a * 8); \
        if (tid < 256) rr = *(const u32x4*)(KR + (t0_ + key_r) * 32 + ch_r * 8); if (tid < 64) rkc = X.pos[t0_ + tid]; } while (0)
#define MLA_STORE(bo) do { *(LAS u32x4*)(lds + (bo) + kdst) = rk; *(LAS u32x4*)(lds + (bo) + vdst) = rv; if (tid < 256) *(LAS u32x4*)(lds + (bo) + rdst) = rr; if (tid < 64) *(LAS int*)(lds + (bo) + 20480u + 4u * tid) = rkc >> 6; } while (0)
    asm volatile("" :: "v"(qf[0]), "v"(qf[1]), "v"(qf[2]), "v"(qf[3]), "v"(qf[4]), "v"(qf[5]));
    int j = procm ? __builtin_ctz(procm) : 32; procm &= procm - 1u;
    unsigned cur = 0;
    if (j < 32) { MLA_LOAD(j); MLA_STORE(0u); }
    __syncthreads();
    f32x16 s0, s1; bf16x8 pf[4];
#define MLA_QK(bo_, j_) do { const float nm = -mrun; \
        if ((maskm >> (j_)) & 1u) { _Pragma("unroll") for (int g = 0; g < 4; ++g) { \
                const i32x4 c0 = *(const LAS i32x4*)(lds + (bo_) + 20480u + 4u * (8 * g + 4 * hh)), c1 = *(const LAS i32x4*)(lds + (bo_) + 20480u + 4u * (32 + 8 * g + 4 * hh)); \
                _Pragma("unroll") for (int e = 0; e < 4; ++e) { s0[4 * g + e] = c0[e] > qc ? NEGF : nm; s1[4 * g + e] = c1[e] > qc ? NEGF : nm; } } } \
        else { _Pragma("unroll") for (int e = 0; e < 16; ++e) { s0[e] = nm; s1[e] = nm; } } \
        _Pragma("unroll") for (int ks = 0; ks < 6; ++ks) { const unsigned ko = 192u * r + 16u * ((2 * ks + hh) ^ ((r >> 2) & 3)); \
            const bf16x8 a0 = *(const LAS bf16x8*)(lds + (bo_) + ko), a1 = *(const LAS bf16x8*)(lds + (bo_) + ko + 192u * 32u); \
            s0 = MFMA32(a0, qf[ks], s0); s1 = MFMA32(a1, qf[ks], s1); } } while (0)
#define MLA_PV(bo_) do { TrRegs TA, TB; tr_issue8(va0 + (bo_), TA); tr_issue8(va1 + (bo_), TB); tr_wait(TA, TB); bf16x8 vf[4]; tr_frags(TA, vf); \
        _Pragma("unroll") for (int k = 0; k < 4; ++k) o0 = MFMA32(vf[k], pf[k], o0); tr_frags(TB, vf); \
        _Pragma("unroll") for (int k = 0; k < 4; ++k) o1 = MFMA32(vf[k], pf[k], o1); } while (0)
    if (w < 4) {
        while (j < 32) {
            const int jn = procm ? __builtin_ctz(procm) : 32; procm &= procm - 1u;
            if (jn < 32) MLA_LOAD(jn);
            const unsigned bo = cur * BUFB;
            MLA_QK(bo, j);
            softmax_tile(s0, s1, mrun, lrun, o0, o1, pf);
            MLA_PV(bo);
            cur = cur == 2u ? 0u : cur + 1u;
            if (jn < 32) MLA_STORE(cur * BUFB);
            __syncthreads();
            j = jn;
        }
    } else {
        bool have = false; unsigned pbo = 0u;
        while (j < 32) {
            const int jn = procm ? __builtin_ctz(procm) : 32; procm &= procm - 1u;
            if (jn < 32) MLA_LOAD(jn);
            const unsigned bo = cur * BUFB;
            if (have) MLA_PV(pbo);
            MLA_QK(bo, j);
            softmax_tile(s0, s1, mrun, lrun, o0, o1, pf);
            pbo = bo; have = true;
            cur = cur == 2u ? 0u : cur + 1u;
            if (jn < 32) MLA_STORE(cur * BUFB);
            __syncthreads();
            j = jn;
        }
        if (have) MLA_PV(pbo);
    }
    __syncthreads();
#undef MLA_QK
#undef MLA_PV
#undef MLA_LOAD
#undef MLA_STORE
    const float inv = 1.f / (lrun + __shfl_xor(lrun, 32));
    bf16_t* op = OA + (size_t)qrow * 1024 + h * 64 + 4 * hh;
#pragma unroll
    for (int g = 0; g < 4; ++g) {
        u32x2 a, c; a.x = pk2(o0[4 * g] * inv, o0[4 * g + 1] * inv); a.y = pk2(o0[4 * g + 2] * inv, o0[4 * g + 3] * inv);
        c.x = pk2(o1[4 * g] * inv, o1[4 * g + 1] * inv); c.y = pk2(o1[4 * g + 2] * inv, o1[4 * g + 3] * inv);
        *(u32x2*)(op + 8 * g) = a; *(u32x2*)(op + 32 + 8 * g) = c;
    }
}

DI int t5_bucket(int rel) { const int n = rel < 0 ? -rel : rel;
    const int large = 8 + (n >= 12) + (n >= 16) + (n >= 23) + (n >= 32) + (n >= 46) + (n >= 64) + (n >= 91);
    return (rel > 0 ? 16 : 0) + (n < 8 ? n : large); }
DI void dsa_scan(LAS unsigned char* lds, int p, int lane, int w) {
    constexpr unsigned L_HIST = 17408u, L_PRE = 58368u, L_NEED = 58496u, L_ACT = 66944u;
    const int shift = 24 - 8 * p;
    const int ql = lane >> 4, part = lane & 15, q = 4 * w + ql;
    unsigned c[16]; unsigned sum = 0u;
#pragma unroll
    for (int t = 0; t < 16; ++t) { c[t] = *(const LAS unsigned*)(lds + L_HIST + 4u * ((16 * part + t) * 32 + q)); sum += c[t]; }
    unsigned sfx = sum;
#pragma unroll
    for (int d = 1; d < 16; d <<= 1) { const unsigned t = __shfl_down(sfx, d, 16); if (part + d < 16) sfx += t; }
    const unsigned total = __shfl(sfx, lane & ~15);
    const unsigned nd = *(const LAS unsigned*)(lds + L_NEED + 4u * q), pold = *(const LAS unsigned*)(lds + L_PRE + 4u * q);
    const unsigned excl = sfx - sum;
    if (nd != 0u && nd != 0xFFFFFFFFu) {
        if (total < nd) { if (part == 0) *(LAS unsigned*)(lds + L_NEED + 4u * q) = 0u; }
        else if (excl < nd && nd <= sfx) {
            unsigned run = excl, bsel = 0u, ndn = 0u, cb = 0u; bool found = false;
#pragma unroll
            for (int t = 15; t >= 0; --t) { if (!found && run + c[t] >= nd) { found = true; bsel = (unsigned)(16 * part + t); ndn = nd - run; cb = c[t]; } if (!found) run += c[t]; }
            const bool resolved = (ndn == cb);
            *(LAS unsigned*)(lds + L_PRE + 4u * q) = pold | (bsel << shift); *(LAS unsigned*)(lds + L_NEED + 4u * q) = resolved ? 0xFFFFFFFFu : ndn;
            if (!resolved) __hip_atomic_fetch_add((LAS unsigned*)(lds + L_ACT) + p, 1u, __ATOMIC_RELAXED, __HIP_MEMORY_SCOPE_WORKGROUP);
        }
    }
}
DI void dsa_attend(const Ctx& X, int b, int qt, int tid, unsigned proc);
template <bool ATTEND>
DI void dsa_unit(const Ctx& X, int b, int qt) {
    const int lane = lane_id(), w = X.wid, tid = w * 64 + lane, r = lane & 31, hh = lane >> 5;
    LAS unsigned char* lds = X.lds; const unsigned ldsb = (unsigned)(uintptr_t)lds;
    constexpr unsigned L_QIT = 0u  , L_HIST = 17408u, L_MSK = 50176u, L_PRE = 58368u, L_NEED = 58496u, L_BT = 58624u, L_KV = 67072u, KVB = 16640u;
    const int tok0 = b * SEQ, q0 = tok0 + qt * 32;
    const bf16_t* QI = wsp<bf16_t>(X, WS_QI); const bf16_t* KI = wsp<bf16_t>(X, WS_KI); const bf16_t* QB = wsp<bf16_t>(X, WS_QB);
    const bf16_t* KB = wsp<bf16_t>(X, WS_KB); const bf16_t* VB = wsp<bf16_t>(X, WS_VB); const float* WI = wsp<float>(X, WS_WI);
    const int* TS = wsp<int>(X, WS_TSTAT) + (size_t)b * 32 * 4;
    const i32x4 tsv = tile_stats(X, b, lane, tid);
    const int qmax = __builtin_amdgcn_readlane(tsv[1], qt >> 1);
    const unsigned proc = (unsigned)__ballot(lane < 32 && tsv[0] <= qmax);
#pragma unroll
    for (int i = 0; i < 2; ++i) { const int c = tid + 512 * i, row = c >> 5, ch = c & 31;
        *(LAS u32x4*)(lds + L_QIT + row * 528 + ch * 16) = *(const u32x4*)(QI + (size_t)(q0 + row) * 256 + ch * 8); }
    if (tid < 257) { const int bk = t5_bucket(tid - 128);
#pragma unroll
        for (int hd = 0; hd < 8; ++hd) *(LAS float*)(lds + L_BT + 4u * (hd * 260 + tid)) = LOG2E * (X.rel_bias[bk * 8 + hd] - X.rel_bias[15 * 8 + hd]); }
    if (tid < 32) { *(LAS unsigned*)(lds + L_PRE + 4u * tid) = 0u; *(LAS unsigned*)(lds + L_NEED + 4u * tid) = 256u; }
    if (tid < 4) *(LAS unsigned*)(lds + 66944u + 4u * tid) = 0u;
#pragma unroll
    for (int i = 0; i < 4; ++i) *(LAS u32x4*)(lds + L_HIST + 16u * (tid + 512 * i)) = (u32x4){0u, 0u, 0u, 0u};
    const int pos_q = X.pos[q0 + r], qc = pos_q >> 6;
    float wq[8];
    { const f32x4 wa = *(const f32x4*)(WI + (size_t)(q0 + r) * 8), wb = *(const f32x4*)(WI + (size_t)(q0 + r) * 8 + 4);
      wq[0] = wa[0]; wq[1] = wa[1]; wq[2] = wa[2]; wq[3] = wa[3]; wq[4] = wb[0]; wq[5] = wb[1]; wq[6] = wb[2]; wq[7] = wb[3]; }
    __syncthreads();
    unsigned keys[8][16];
    bf16x8 nka0, nka1; i32x4 npk[4];
#define DSA_PREF(i_) do { const int jt_ = w + 8 * (i_); if ((proc >> (jt_ >> 1)) & 1u) { const size_t kr_ = (size_t)tok0 + jt_ * 32; \
        nka0 = *(const bf16x8*)(KI + (kr_ + r) * 32 + 8 * hh); nka1 = *(const bf16x8*)(KI + (kr_ + r) * 32 + 16 + 8 * hh); \
        _Pragma("unroll") for (int g_ = 0; g_ < 4; ++g_) npk[g_] = *(const i32x4*)(X.pos + kr_ + 8 * g_ + 4 * hh); } } while (0)
    DSA_PREF(0);
#pragma unroll
    for (int i = 0; i < 8; ++i) {
        const int jt = w + 8 * i;
        const bf16x8 ka0 = nka0, ka1 = nka1; i32x4 pk4[4];
#pragma unroll
        for (int g = 0; g < 4; ++g) pk4[g] = npk[g];
        if (i < 7) DSA_PREF(i + 1);
        if ((proc >> (jt >> 1)) & 1u) {
            f32x16 sc;
#pragma unroll
            for (int e = 0; e < 16; ++e) sc[e] = 0.f;
#pragma unroll
            for (int hd = 0; hd < 8; ++hd) {
                f32x16 S;
#pragma unroll
                for (int e = 0; e < 16; ++e) S[e] = 0.f;
                const bf16x8 b0 = *(const LAS bf16x8*)(lds + L_QIT + r * 528 + hh * 16 + hd * 64), b1 = *(const LAS bf16x8*)(lds + L_QIT + r * 528 + hh * 16 + hd * 64 + 32);
                S = MFMA32(ka0, b0, S); S = MFMA32(ka1, b1, S);
#pragma unroll
                for (int e = 0; e < 16; ++e) sc[e] += wq[hd] * __builtin_amdgcn_fmed3f(S[e], 0.f, 3.0e38f);
                asm volatile("" : "+v"(sc));
            }
#pragma unroll
            for (int g = 0; g < 4; ++g) {
#pragma unroll
                for (int e = 0; e < 4; ++e) { const int sidx = jt * 32 + 8 * g + 4 * hh + e; const unsigned u = __float_as_uint(sc[4 * g + e]);
                    const unsigned srt = u ^ ((unsigned)((int)u >> 31) | 0x80000000u);
                    unsigned kk = (srt & 0xFFFFF800u) | (unsigned)(2047 - sidx); kk = ((pk4[g][e] >> 6) <= qc) ? kk : 0u; keys[i][4 * g + e] = kk;
                    __hip_atomic_fetch_add((LAS unsigned*)(lds + L_HIST) + r + (kk >> 24) * 32u, 1u, __ATOMIC_RELAXED, __HIP_MEMORY_SCOPE_WORKGROUP); }
            }
        } else {
#pragma unroll
            for (int e = 0; e < 16; ++e) keys[i][e] = 0u;
        }
        __builtin_amdgcn_sched_barrier(0);
    }
#undef DSA_PREF
    __syncthreads();
    dsa_scan(lds, 0, lane, w);
    __syncthreads();
#pragma unroll 1
    for (int p = 1; p < 4; ++p) {
        if (*(const LAS unsigned*)(lds + 66944u + 4u * (p - 1)) == 0u) break;
        const int shift = 24 - 8 * p;
#pragma unroll
        for (int i = 0; i < 4; ++i) *(LAS u32x4*)(lds + L_HIST + 16u * (tid + 512 * i)) = (u32x4){0u, 0u, 0u, 0u};
        __syncthreads();
        {
            const unsigned pre = *(const LAS unsigned*)(lds + L_PRE + 4u * r), ndq = *(const LAS unsigned*)(lds + L_NEED + 4u * r);
            unsigned P = pre, lim = (ndq == 0u || ndq == 0xFFFFFFFFu) ? 0u : (1u << (shift + 8));
            asm volatile("" : "+v"(P), "+v"(lim));
            LAS unsigned* hq = (LAS unsigned*)(lds + L_HIST) + r;
#pragma unroll
            for (int i = 0; i < 8; ++i) {
                if ((proc >> ((w + 8 * i) >> 1)) & 1u) {
                    unsigned mn = 0xFFFFFFFFu;
#pragma unroll
                    for (int e = 0; e < 16; ++e) { const unsigned x = keys[i][e] ^ P; mn = x < mn ? x : mn; }
                    if (__any(mn < lim)) {
                        unsigned P2 = P; asm volatile("" : "+v"(P2));
#pragma unroll
                        for (int e = 0; e < 16; ++e) { const unsigned x = keys[i][e] ^ P2;
                            if (x < lim) __hip_atomic_fetch_add(hq + ((x >> shift) & 255u) * 32u, 1u, __ATOMIC_RELAXED, __HIP_MEMORY_SCOPE_WORKGROUP); }
                    }
                }
                __builtin_amdgcn_sched_barrier(0);
            }
        }
        __syncthreads();
        dsa_scan(lds, p, lane, w);
        __syncthreads();
    }
    {
        const unsigned nd = *(const LAS unsigned*)(lds + L_NEED + 4u * r), pr = *(const LAS unsigned*)(lds + L_PRE + 4u * r);
        const unsigned T = nd == 0u ? 0u : pr, thr = T > 2048u ? T : 2048u;
#pragma unroll
        for (int i = 0; i < 8; ++i) { const int jt = w + 8 * i; unsigned bits = 0u;
#pragma unroll
            for (int e = 0; e < 16; ++e) bits |= (keys[i][e] >= thr ? 1u : 0u) << e;
            *(LAS unsigned short*)(lds + L_MSK + 2u * ((jt * 2 + hh) * 32 + r)) = (unsigned short)bits; }
    }
    __syncthreads();
    if constexpr (ATTEND) dsa_attend(X, b, qt, X.wid * 64 + lane_id(), proc); else __syncthreads();
}
DI void dsa_attend(const Ctx& X, int b, int qt, int tid, unsigned proc) {
    const int lane = tid & 63, w = X.wid, r = lane & 31, hh = lane >> 5;
    LAS unsigned char* lds = X.lds; const unsigned ldsb = (unsigned)(uintptr_t)lds;
    constexpr unsigned L_MSK = 50176u, L_BT = 58624u, L_KV = 67072u, KVB = 16640u;
    const int tok0 = b * SEQ, q0 = tok0 + qt * 32;
    const bf16_t* QB = wsp<bf16_t>(X, WS_QB); const bf16_t* KB = wsp<bf16_t>(X, WS_KB); const bf16_t* VB = wsp<bf16_t>(X, WS_VB);
    bf16_t* OB = wsp<bf16_t>(X, WS_B) + 512;
    const int* TS = wsp<int>(X, WS_TSTAT) + (size_t)b * 32 * 4;
    const i32x4 tsv = *(const LAS i32x4*)((LAS int*)(X.lds + LDS_MISC + 2048) + 4 * (lane & 31));
    const int posmin_q = __builtin_amdgcn_readlane(tsv[2], qt >> 1);
    const unsigned nearm = (unsigned)__ballot(lane < 32 && tsv[3] - posmin_q > -128);
    unsigned procm = proc;
    const int pos_q = X.pos[q0 + r];
    bf16x8 qf[4];
#pragma unroll
    for (int s = 0; s < 4; ++s) qf[s] = *(const bf16x8*)(QB + (size_t)(q0 + r) * 512 + w * 64 + 16 * s + 8 * hh);
    f32x16 o0, o1;
#pragma unroll
    for (int e = 0; e < 16; ++e) { o0[e] = 0.f; o1[e] = 0.f; }
    float mrun = M_FLOOR, lrun = 0.f;
    const int key_a = tid >> 3, ch_a = tid & 7;
    const unsigned kdst = 128u * key_a + 16u * (ch_a ^ ((key_a >> 1) & 7)), vdst = 8192u + 128u * key_a + 16u * (ch_a ^ (((key_a >> 1) & 1) << 2));
    const int q4 = (lane & 15) >> 2, p4 = lane & 3, blk = (lane >> 4) & 1, sw = (q4 >> 1) & 1;
    const unsigned vbase = ldsb + L_KV + 8192u + 128u * (4 * hh + q4) + 16u * (2 * blk + (p4 >> 1)) + 8u * (p4 & 1);
    const unsigned va0 = vbase + 64u * sw, va1 = vbase + 64u * (1 - sw);
    u32x4 rk, rv; int rp = 0;
#define DSA_LOAD(j) do { const size_t t0_ = (size_t)tok0 + (size_t)(j) * 64; rk = *(const u32x4*)(KB + (t0_ + key_a) * 64 + ch_a * 8); rv = *(const u32x4*)(VB + (t0_ + key_a) * 64 + ch_a * 8); \
        if (tid < 64) rp = X.pos[t0_ + tid]; } while (0)
#define DSA_STORE(bo) do { *(LAS u32x4*)(lds + L_KV + (bo) + kdst) = rk; *(LAS u32x4*)(lds + L_KV + (bo) + vdst) = rv; if (tid < 64) *(LAS int*)(lds + L_KV + (bo) + 16384u + 4u * tid) = rp; } while (0)
    asm volatile("" :: "v"(qf[0]), "v"(qf[1]), "v"(qf[2]), "v"(qf[3]), "v"(pos_q));
    int j = procm ? __builtin_ctz(procm) : 32; procm &= procm - 1u;
    unsigned cur = 0;
    if (j < 32) { DSA_LOAD(j); DSA_STORE(0u); }
    __syncthreads();
    f32x16 s0, s1; bf16x8 pf[4];
#define DSA_QK(bo_, j_) do { const float nm = -mrun; \
        const unsigned m0 = *(const LAS unsigned short*)(lds + L_MSK + 2u * (((2 * (j_)) * 2 + hh) * 32 + r)), m1 = *(const LAS unsigned short*)(lds + L_MSK + 2u * (((2 * (j_) + 1) * 2 + hh) * 32 + r)); \
        if ((nearm >> (j_)) & 1u) { _Pragma("unroll") for (int g = 0; g < 4; ++g) { \
                const i32x4 c0 = *(const LAS i32x4*)(lds + L_KV + (bo_) + 16384u + 4u * (8 * g + 4 * hh)), c1 = *(const LAS i32x4*)(lds + L_KV + (bo_) + 16384u + 4u * (32 + 8 * g + 4 * hh)); \
                _Pragma("unroll") for (int e = 0; e < 4; ++e) { \
                    int d0 = c0[e] - pos_q, d1 = c1[e] - pos_q; d0 = d0 < -128 ? -128 : (d0 > 128 ? 128 : d0); d1 = d1 < -128 ? -128 : (d1 > 128 ? 128 : d1); \
                    const float b0 = *(const LAS float*)(lds + L_BT + 4u * (w * 260 + d0 + 128)) + nm, b1 = *(const LAS float*)(lds + L_BT + 4u * (w * 260 + d1 + 128)) + nm; \
                    s0[4 * g + e] = ((m0 >> (4 * g + e)) & 1u) ? b0 : NEGF; s1[4 * g + e] = ((m1 >> (4 * g + e)) & 1u) ? b1 : NEGF; } } } \
        else { _Pragma("unroll") for (int e = 0; e < 16; ++e) { s0[e] = ((m0 >> e) & 1u) ? nm : NEGF; s1[e] = ((m1 >> e) & 1u) ? nm : NEGF; } } \
        _Pragma("unroll") for (int ks = 0; ks < 4; ++ks) { const unsigned ko = 128u * r + 16u * ((2 * ks + hh) ^ ((r >> 1) & 7)); \
            const bf16x8 a0 = *(const LAS bf16x8*)(lds + L_KV + (bo_) + ko), a1 = *(const LAS bf16x8*)(lds + L_KV + (bo_) + ko + 128u * 32u); \
            s0 = MFMA32(a0, qf[ks], s0); s1 = MFMA32(a1, qf[ks], s1); } } while (0)
#define DSA_PV(bo_) do { TrRegs TA, TB; tr_issue8(va0 + (bo_), TA); tr_issue8(va1 + (bo_), TB); tr_wait(TA, TB); bf16x8 vf[4]; tr_frags(TA, vf); \
        _Pragma("unroll") for (int k = 0; k < 4; ++k) o0 = MFMA32(vf[k], pf[k], o0); tr_frags(TB, vf); \
        _Pragma("unroll") for (int k = 0; k < 4; ++k) o1 = MFMA32(vf[k], pf[k], o1); } while (0)
    if (w < 4) {
        while (j < 32) {
            const int jn = procm ? __builtin_ctz(procm) : 32; procm &= procm - 1u;
            if (jn < 32) DSA_LOAD(jn);
            const unsigned bo = cur * KVB;
            DSA_QK(bo, j);
            softmax_tile(s0, s1, mrun, lrun, o0, o1, pf);
            DSA_PV(bo);
            cur = cur == 2u ? 0u : cur + 1u;
            if (jn < 32) DSA_STORE(cur * KVB);
            __syncthreads();
            j = jn;
        }
    } else {
        bool have = false; unsigned pbo = 0u;
        while (j < 32) {
            const int jn = procm ? __builtin_ctz(procm) : 32; procm &= procm - 1u;
            if (jn < 32) DSA_LOAD(jn);
            const unsigned bo = cur * KVB;
            if (have) DSA_PV(pbo);
            DSA_QK(bo, j);
            softmax_tile(s0, s1, mrun, lrun, o0, o1, pf);
            pbo = bo; have = true;
            cur = cur == 2u ? 0u : cur + 1u;
            if (jn < 32) DSA_STORE(cur * KVB);
            __syncthreads();
            j = jn;
        }
        if (have) DSA_PV(pbo);
    }
#undef DSA_QK
#undef DSA_PV
#undef DSA_LOAD
#undef DSA_STORE
    const float inv = 1.f / (lrun + __shfl_xor(lrun, 32));
    bf16_t* op = OB + (size_t)(q0 + r) * 1024 + w * 64 + 4 * hh;
#pragma unroll
    for (int g = 0; g < 4; ++g) {
        u32x2 a, c; a.x = pk2(o0[4 * g] * inv, o0[4 * g + 1] * inv); a.y = pk2(o0[4 * g + 2] * inv, o0[4 * g + 3] * inv);
        c.x = pk2(o1[4 * g] * inv, o1[4 * g + 1] * inv); c.y = pk2(o1[4 * g + 2] * inv, o1[4 * g + 3] * inv);
        *(u32x2*)(op + 8 * g) = a; *(u32x2*)(op + 32 + 8 * g) = c;
    }
    __syncthreads();
}

constexpr int N_PHASES = 10;
template <int PHM>
__global__ void __launch_bounds__(512, 2) fwd_kernel(Args args) {
    extern __shared__ __attribute__((aligned(16))) unsigned char lds_raw[];
    Ctx X;
    X.x = (const float*)args.in[0]; X.pos = (const int*)args.in[1]; X.ln0_g = (const float*)args.in[2]; X.ln0_b = (const float*)args.in[3]; X.w_in = (const float*)args.in[4];
    X.q_norm_g = (const float*)args.in[5]; X.w_uq = (const float*)args.in[6]; X.kv_norm_g = (const float*)args.in[7]; X.w_uk = (const float*)args.in[8]; X.w_uv = (const float*)args.in[9];
    X.rel_bias = (const float*)args.in[10]; X.w_up_a = (const float*)args.in[11]; X.w_up_b = (const float*)args.in[12]; X.w_gate = (const float*)args.in[13]; X.b_gate = (const float*)args.in[14];
    X.w_o = (const float*)args.in[15]; X.ln1_g = (const float*)args.in[16]; X.ln1_b = (const float*)args.in[17]; X.w_grp = (const float*)args.in[18]; X.b_grp = (const float*)args.in[19];
    X.w_rt = (const float*)args.in[20]; X.b_rt = (const float*)args.in[21]; X.w_eg = (const float*)args.in[22]; X.w_eu = (const float*)args.in[23]; X.w_ed = (const float*)args.in[24];
    X.ln2_g = (const float*)args.in[25]; X.ln2_b = (const float*)args.in[26];
    X.out = args.out; X.ws = args.ws; X.lds = (LAS unsigned char*)lds_raw; X.G = gridDim.x; X.bid = blockIdx.x; X.wid = __builtin_amdgcn_readfirstlane((int)(threadIdx.x >> 6));
    if (threadIdx.x < 16) ((LAS unsigned*)(X.lds + LDS_MISC))[threadIdx.x] = 0u;
    __syncthreads();
    const int lo = args.ph_lo, hi = args.ph_hi;
    XcdBarrier bar; bar.bar = wsp<unsigned>(X, WS_CTL) + CW_BAR; bar.x = 0; bar.st = nullptr;
    if (hi - lo > 1) bar = xcd_barrier_post(wsp<unsigned>(X, WS_CTL) + CW_BAR, (volatile LAS unsigned*)(X.lds + LDS_MISC));
#define IN(k) (((PHM >> (k)) & 1) && lo <= (k) && (k) < hi)
#define SEAM(k) do { if (IN(k) && IN((k) + 1)) xcd_barrier(bar); } while (0)

    if (IN(0)) { p0_prologue(X); }
    SEAM(0);
    if (IN(1)) {
        pg8::Gemm g{wsp<bf16_t>(X, WS_B), wsp<bf16_t>(X, WS_WT1), 1024}; pg8::StaticOrder S; S.init(M, NW1, X.G, X.bid);
        Epi1 E{wsp<bf16_t>(X, WS_CQ), wsp<bf16_t>(X, WS_CKV), wsp<bf16_t>(X, WS_KR), wsp<bf16_t>(X, WS_KI), wsp<bf16_t>(X, WS_KB), wsp<bf16_t>(X, WS_VB), wsp<bf16_t>(X, WS_QB), wsp<bf16_t>(X, WS_QI),
               wsp<bf16_t>(X, WS_A), wsp<float>(X, WS_WI), wsp<float>(X, WS_SSQ), wsp<float>(X, WS_ROPE), X.b_gate};
        pg8::gemm_phase<Epi1, pg8::StaticOrder, true, false>(X.lds, g, S, E, X.wid);
    }
    SEAM(1);
    if (IN(2)) {
        { pg8::Gemm g{wsp<bf16_t>(X, WS_CKV), wsp<bf16_t>(X, WS_WUKVT), 128}; pg8::StaticOrder S; S.init(M, 1024, X.G, X.bid);
          Epi3 E{wsp<bf16_t>(X, WS_KN), wsp<bf16_t>(X, WS_VM), wsp<float>(X, WS_SSQ)};
          pg8::gemm_phase<Epi3, pg8::StaticOrder, true, false>(X.lds, g, S, E, X.wid); }
        { pg8::Gemm g{wsp<bf16_t>(X, WS_CQ), wsp<bf16_t>(X, WS_WUQT), 256}; pg8::StaticOrder S; S.init(M, 768, X.G, X.bid);
          Epi2 E{wsp<bf16_t>(X, WS_QM), wsp<float>(X, WS_SSQ), wsp<float>(X, WS_ROPE)};
          pg8::gemm_phase<Epi2, pg8::StaticOrder, true, false>(X.lds, g, S, E, X.wid); }
    }
    SEAM(2);
    if (IN(3)) {
        for (int i = 0;; ++i) { const long L = (long)i * X.G + X.bid; if (L >= 1024) break; const int c = (int)(L & 255), ii = (int)(L >> 8);
            const int bh = c >> 1; const int tab[2][4] = {{7, 0, 5, 2}, {6, 1, 4, 3}}; int qb = tab[0][0];
#pragma unroll
            for (int a = 0; a < 2; ++a)
#pragma unroll
                for (int t = 0; t < 4; ++t) if (a == (c & 1) && t == ii) qb = tab[a][t];
            mla_unit(X, bh >> 3, bh & 7, qb);
        }
        for (int i = 0;; ++i) { const long L = (long)i * X.G + X.bid; if (L >= 1024) break; const int c = (int)(L & 255), ii = (int)(L >> 8);
            const int b = c >> 4, idx = c & 15; const int qt = ii == 0 ? 63 - idx : (ii == 1 ? idx : (ii == 2 ? 47 - idx : 16 + idx));
            dsa_unit<true>(X, b, qt);
        }
    }
    SEAM(3);
    if (IN(4)) {
        pg8::Gemm g{wsp<bf16_t>(X, WS_B), wsp<bf16_t>(X, WS_WUPT), 1024}; pg8::StaticOrder S; S.init(M, 1024, X.G, X.bid);
        Epi4 E{wsp<bf16_t>(X, WS_MIXPRE), wsp<bf16_t>(X, WS_A)};
        pg8::gemm_phase<Epi4, pg8::StaticOrder, true, false>(X.lds, g, S, E, X.wid);
    }
    SEAM(4);
    if (IN(5)) {
        pg8::Gemm g{wsp<bf16_t>(X, WS_MIXPRE), wsp<bf16_t>(X, WS_WOT), 1024}; pg8::StaticOrder S; S.init(M, 1024, X.G, X.bid);
        Epi5 E{wsp<float>(X, WS_A), X.x, wsp<float>(X, WS_STATS0), X.ln0_g, X.ln0_b};
        pg8::gemm_phase<Epi5, pg8::StaticOrder, true, false>(X.lds, g, S, E, X.wid);
    }
    SEAM(5);
    if (IN(6)) { p6_ln1_router(X); }
    SEAM(6);
    if (IN(7)) {
        moe_prep(X);
        const LAS int* tstart = (const LAS int*)(X.lds + LDS_MISC + 64); const LAS int* scnt = (const LAS int*)(X.lds + LDS_MISC + 512);
        pg8::Gemm g{wsp<bf16_t>(X, WS_B), wsp<bf16_t>(X, WS_WEGUT), 1024}; MoeOrder S{tstart, scnt, wsp<int>(X, WS_LIST), 2048, 2, X.G, X.bid, __builtin_amdgcn_readfirstlane(tstart[NSEG])};
        Epi7 E{wsp<bf16_t>(X, WS_HID), wsp<float>(X, WS_LISTW), scnt};
        pg8::gemm_phase<Epi7, MoeOrder, true, true>(X.lds, g, S, E, X.wid);
    }
    SEAM(7);
    if (IN(8)) {
        moe_prep(X);
        const LAS int* tstart = (const LAS int*)(X.lds + LDS_MISC + 64); const LAS int* scnt = (const LAS int*)(X.lds + LDS_MISC + 512);
        pg8::Gemm g{wsp<bf16_t>(X, WS_HID), wsp<bf16_t>(X, WS_WEDT), 256}; MoeOrder S{tstart, scnt, wsp<int>(X, WS_LIST), 0, 4, X.G, X.bid, __builtin_amdgcn_readfirstlane(tstart[NSEG])};
        Epi8 E{wsp<bf16_t>(X, WS_C), wsp<int>(X, WS_LIST), scnt};
        pg8::gemm_phase<Epi8, MoeOrder, true, false>(X.lds, g, S, E, X.wid);
    }
    SEAM(8);
    if (IN(9)) { p9_ln2(X); }
#undef IN
#undef SEAM
}

#ifndef PH_MASK
#define PH_MASK 0x3ff
#endif
template <int PHM> static bool setup_kernel(int& per_cu) {
    if (hipFuncSetAttribute((const void*)fwd_kernel<PHM>, hipFuncAttributeMaxDynamicSharedMemorySize, LDS_BYTES) != hipSuccess) return false;
    if (hipOccupancyMaxActiveBlocksPerMultiprocessor(&per_cu, (const void*)fwd_kernel<PHM>, 512, LDS_BYTES) != hipSuccess) per_cu = 0;
    (void)hipGetLastError(); return true;
}
template <int P> static void launch_phase(int grid, hipStream_t stream, Args a) {
    if (!((PH_MASK >> P) & 1)) return;
    a.ph_lo = P; a.ph_hi = P + 1;
    hipLaunchKernelGGL(fwd_kernel<(1 << P)>, dim3(grid), dim3(512), LDS_BYTES, stream, a);
}
extern "C" void kernel_launch(void* const* d_in, const int* in_sizes, int n_in, void* d_out, int out_size, void* d_ws, size_t ws_size, hipStream_t stream) {
    static int grid = 0;
    if (grid == 0) {
        if (n_in != 27 || in_sizes[0] != M * D || out_size != M * D || ws_size < WS_END) { fprintf(stderr, "kernel_launch: unexpected shapes (n_in %d, ws %zu); nothing launched\n", n_in, ws_size); grid = -1; return; }
        int dev = 0, cus = 0, per_cu = 0; bool ok = true;
        if (hipGetDevice(&dev) != hipSuccess || hipDeviceGetAttribute(&cus, hipDeviceAttributeMultiprocessorCount, dev) != hipSuccess) { grid = -1; return; }
#if N_LAUNCH_MODE == 1
        ok = setup_kernel<PH_MASK>(per_cu);
#else
        ok = setup_kernel<1>(per_cu) && setup_kernel<2>(per_cu) && setup_kernel<4>(per_cu) && setup_kernel<8>(per_cu) && setup_kernel<16>(per_cu) && setup_kernel<32>(per_cu) &&
             setup_kernel<64>(per_cu) && setup_kernel<128>(per_cu) && setup_kernel<256>(per_cu) && setup_kernel<512>(per_cu);
#endif
        if (!ok) { fprintf(stderr, "kernel_launch: hipFuncSetAttribute failed\n"); grid = -1; return; }
        if (per_cu < 1) fprintf(stderr, "kernel_launch: occupancy query says %d\n", per_cu);
        grid = cus;
    }
    if (grid < 0) return;
    if (hipMemsetAsync((char*)d_ws + WS_CTL, 0, CTL_ZERO_BYTES, stream) != hipSuccess) return;
    Args a{};
    for (int i = 0; i < 27; ++i) a.in[i] = d_in[i];
    a.out = (float*)d_out; a.ws = (unsigned char*)d_ws;
#if N_LAUNCH_MODE == 1
    a.ph_lo = 0; a.ph_hi = N_PHASES;
    hipLaunchKernelGGL(fwd_kernel<PH_MASK>, dim3(grid), dim3(512), LDS_BYTES, stream, a);
#else
    launch_phase<0>(grid, stream, a);
    launch_phase<1>(grid, stream, a); launch_phase<2>(grid, stream, a); launch_phase<3>(grid, stream, a); launch_phase<4>(grid, stream, a); launch_phase<5>(grid, stream, a);
    launch_phase<6>(grid, stream, a); launch_phase<7>(grid, stream, a); launch_phase<8>(grid, stream, a); launch_phase<9>(grid, stream, a);
#endif
}
```
